# Optimizing an MI355X kernel written in HIP

```python
import math
import jax, jax.numpy as jnp
from jax import lax
import numpy as np

D_MODEL = 1024
BATCH = 4
SEQ = 8192
DEPTH = 1
DEC_BATCH = 32
DEC_SEQ = 32
PAST_LEN = 2048

CHUNK = 64
N_HEADS = 8
HEAD_DIM = 64
SB_WIDTH = N_HEADS * HEAD_DIM
CONV_WIDTH = 512
CONV_K = 3
PLE_DIM = 256
D_FF = 4 * D_MODEL
Q_BLOCK = 128
EPS = 1e-6
SPLITS = tuple(int(s) for s in np.cumsum([SB_WIDTH, SB_WIDTH, SB_WIDTH, CONV_WIDTH, CONV_WIDTH, CONV_WIDTH, D_MODEL]))
N_PROJ = 3 * SB_WIDTH + 3 * CONV_WIDTH + 2 * D_MODEL

kernel_name = "stick_breaking_shortconv_griffin_step"


def rmsnorm(x, g):
    xf = x.astype(jnp.float32)
    y = xf * lax.rsqrt(jnp.mean(xf * xf, axis=-1, keepdims=True) + EPS)
    return y.astype(x.dtype) * g


def stick_breaking(q, k, v, q_pos, k_pos):
    scale = 1.0 / math.sqrt(HEAD_DIM)
    z = jnp.einsum('bqhd,bkhd->bhqk', q.astype(jnp.float32), k.astype(jnp.float32)) * scale
    mask = k_pos[None, :] < q_pos[:, None]
    log_1m = jnp.where(mask, jax.nn.log_sigmoid(-z), 0.0)
    tail = lax.cumsum(log_1m, axis=3, reverse=True) - log_1m
    a = jnp.where(mask, jnp.exp(jax.nn.log_sigmoid(z) + tail), 0.0)
    out = jnp.einsum('bhqk,bkhd->bqhd', a, v.astype(jnp.float32))
    return out.astype(v.dtype)


def sb_prompt(q, k, v):
    b, t, h, d = q.shape
    nb = t // Q_BLOCK
    qb = q.reshape(b, nb, Q_BLOCK, h, d).swapaxes(0, 1)
    pos = jnp.arange(t, dtype=jnp.int32).reshape(nb, Q_BLOCK)
    kpos = jnp.arange(t, dtype=jnp.int32)
    out = lax.map(lambda a: stick_breaking(a[0], k, v, a[1], kpos), (qb, pos))
    return out.swapaxes(0, 1).reshape(b, t, h, d)


def causal_conv(u, buf, w):
    t = u.shape[1]
    up = jnp.concatenate([buf, u], axis=1)
    y = sum(w[j] * up[:, j:j + t] for j in range(CONV_K))
    return y, up[:, -(CONV_K - 1):]


def layer(x, p, attend, conv_buf, g_mix, w_in, conv_w, w_attn_out, w_conv_out, w_o,
          g_ffn, w_up, w_down, g_ple, w_ple_gate, w_ple):
    b, t, _ = x.shape
    h = rmsnorm(x, g_mix)
    proj = h @ w_in
    q, k, v, cb, cc, cx, ga, gc = jnp.split(proj, SPLITS, axis=-1)
    q = q.reshape(b, t, N_HEADS, HEAD_DIM)
    k = k.reshape(b, t, N_HEADS, HEAD_DIM)
    v = v.reshape(b, t, N_HEADS, HEAD_DIM)
    y_attn = attend(q, k, v).reshape(b, t, SB_WIDTH) @ w_attn_out
    conv_out, new_buf = causal_conv(cc * cx, conv_buf, conv_w)
    y_conv = (cb * conv_out) @ w_conv_out
    merged = jax.nn.sigmoid(ga) * y_attn + jax.nn.sigmoid(gc) * y_conv
    x = x + merged @ w_o
    f = jnp.square(jax.nn.relu(rmsnorm(x, g_ffn) @ w_up)) @ w_down
    x = x + f
    x = x + jax.nn.sigmoid(rmsnorm(x, g_ple) @ w_ple_gate) * (p @ w_ple)
    return x, k, v, new_buf


def setup_inputs(seed: int = 0) -> dict:
    key = jax.random.key(seed)
    ks = jax.random.split(key, 24)
    f32 = jnp.float32
    n = lambda k, shape, s: jax.random.normal(k, shape, f32) * s
    return {
        "x_prompt": n(ks[0], (BATCH, SEQ, D_MODEL), 1.0),
        "x_sample": n(ks[1], (DEC_BATCH, DEC_SEQ, D_MODEL), 1.0),
        "p_prompt": n(ks[2], (DEPTH, BATCH, SEQ, PLE_DIM), 1.0),
        "p_sample": n(ks[3], (DEPTH, DEC_BATCH, DEC_SEQ, PLE_DIM), 1.0),
        "cache_k": n(ks[4], (DEPTH, DEC_BATCH, PAST_LEN, N_HEADS, HEAD_DIM), 1.0),
        "cache_v": n(ks[5], (DEPTH, DEC_BATCH, PAST_LEN, N_HEADS, HEAD_DIM), 1.0),
        "cache_conv": n(ks[6], (DEPTH, DEC_BATCH, CONV_K - 1, CONV_WIDTH), 1.0),
        "g_mix": 1.0 + n(ks[7], (DEPTH, D_MODEL), 0.02),
        "w_in": n(ks[8], (DEPTH, D_MODEL, N_PROJ), D_MODEL ** -0.5),
        "conv_w": n(ks[9], (DEPTH, CONV_K, CONV_WIDTH), CONV_K ** -0.5),
        "w_attn_out": n(ks[10], (DEPTH, SB_WIDTH, D_MODEL), SB_WIDTH ** -0.5),
        "w_conv_out": n(ks[11], (DEPTH, CONV_WIDTH, D_MODEL), CONV_WIDTH ** -0.5),
        "w_o": n(ks[12], (DEPTH, D_MODEL, D_MODEL), D_MODEL ** -0.5),
        "g_ffn": 1.0 + n(ks[13], (DEPTH, D_MODEL), 0.02),
        "w_up": n(ks[14], (DEPTH, D_MODEL, D_FF), D_MODEL ** -0.5),
        "w_down": n(ks[15], (DEPTH, D_FF, D_MODEL), D_FF ** -0.5),
        "g_ple": 1.0 + n(ks[16], (DEPTH, D_MODEL), 0.02),
        "w_ple_gate": n(ks[17], (DEPTH, D_MODEL, D_MODEL), D_MODEL ** -0.5),
        "w_ple": n(ks[18], (DEPTH, PLE_DIM, D_MODEL), PLE_DIM ** -0.5),
        "g_final": 1.0 + n(ks[19], (D_MODEL,), 0.02),
    }


def reference(x_prompt, x_sample, p_prompt, p_sample, cache_k, cache_v, cache_conv,
              g_mix, w_in, conv_w, w_attn_out, w_conv_out, w_o,
              g_ffn, w_up, w_down, g_ple, w_ple_gate, w_ple, g_final):
    xp, xs = x_prompt, x_sample
    kp_l, vp_l, cp_l, ks_l, vs_l, cs_l = [], [], [], [], [], []
    for i in range(DEPTH):
        w = (g_mix[i], w_in[i], conv_w[i], w_attn_out[i], w_conv_out[i], w_o[i],
             g_ffn[i], w_up[i], w_down[i], g_ple[i], w_ple_gate[i], w_ple[i])
        buf0 = jnp.zeros((xp.shape[0], CONV_K - 1, CONV_WIDTH), xp.dtype)
        xp, kp, vp, cp = layer(xp, p_prompt[i], sb_prompt, buf0, *w)
        ck, cv = cache_k[i], cache_v[i]
        past = ck.shape[1]

        def sb_sample(q, k, v, ck=ck, cv=cv, past=past):
            t = q.shape[1]
            kk = jnp.concatenate([ck, k], axis=1)
            vv = jnp.concatenate([cv, v], axis=1)
            q_pos = past + jnp.arange(t, dtype=jnp.int32)
            k_pos = jnp.arange(past + t, dtype=jnp.int32)
            return stick_breaking(q, kk, vv, q_pos, k_pos)

        xs, ks_, vs_, cs = layer(xs, p_sample[i], sb_sample, cache_conv[i], *w)
        kp_l.append(kp); vp_l.append(vp); cp_l.append(cp)
        ks_l.append(ks_); vs_l.append(vs_); cs_l.append(cs)
    y_prompt = rmsnorm(xp, g_final)
    y_sample = rmsnorm(xs, g_final)
    return (y_prompt, y_sample,
            jnp.stack(kp_l), jnp.stack(vp_l), jnp.stack(cp_l),
            jnp.stack(ks_l), jnp.stack(vs_l), jnp.stack(cs_l))
```

```cpp
#include <hip/hip_runtime.h>
#include <hip/hip_cooperative_groups.h>
#include <cstdio>
#include <cstdint>
namespace cg = cooperative_groups;

#define DI __device__ __forceinline__
typedef unsigned short bf16_t;
typedef short bf16x8 __attribute__((ext_vector_type(8)));
typedef float f32x4 __attribute__((ext_vector_type(4)));
typedef float f32x2 __attribute__((ext_vector_type(2)));
typedef float f32x16 __attribute__((ext_vector_type(16)));
typedef unsigned u32x4 __attribute__((ext_vector_type(4)));
typedef unsigned u32x2 __attribute__((ext_vector_type(2)));
typedef __bf16 bf16v2 __attribute__((ext_vector_type(2)));

constexpr int D = 1024, NPROJ = 5120, MP = 32768, MS = 1024, M = MP + MS, SEQ = 8192, DSEQ = 32, PAST = 2048;
constexpr int NH = 8, HD = 64, SBW = 512, CW = 512, PLE = 256, DFF = 4096, P4W = 4096;
constexpr float EPS = 1e-6f;
constexpr size_t O_Y = 0, O_KP = (size_t)M * D, O_VP = O_KP + (size_t)MP * SBW, O_CP = O_VP + (size_t)MP * SBW,
                 O_KS = O_CP + 4 * 2 * CW, O_VS = O_KS + (size_t)MS * SBW, O_CS = O_VS + (size_t)MS * SBW;
constexpr size_t W_IN = 0, W_AO = W_IN + (size_t)NPROJ * D * 2, W_CO = W_AO + (size_t)D * SBW * 2, W_O = W_CO + (size_t)D * CW * 2,
                 W_UP = W_O + (size_t)D * D * 2, W_DN = W_UP + (size_t)DFF * D * 2, W_PG = W_DN + (size_t)D * DFF * 2,
                 W_PL = W_PG + (size_t)D * D * 2, W_RS0 = W_PL + (size_t)D * PLE * 2, W_SS = W_RS0 + (size_t)M * 4,
                 W_PB = W_SS + (size_t)3 * M * 4, W_RA = W_PB + (size_t)M * PLE * 2, W_RB = W_RA + (size_t)M * D * 2,
                 W_RC = W_RB + (size_t)M * D * 2, W_END = W_RC + (size_t)M * P4W * 2;

struct Params {
  const float *x_p, *x_s, *p_p, *p_s, *cache_k, *cache_v, *cache_conv;
  const float *g_mix, *w_in, *conv_w, *w_ao, *w_co, *w_o, *g_ffn, *w_up, *w_dn, *g_ple, *w_pg, *w_pl, *g_final;
  float* out; unsigned char* ws;
};

extern __shared__ __attribute__((aligned(16))) unsigned char dyn_lds[];

DI unsigned pk2(float lo, float hi) { f32x2 f = {lo, hi}; bf16v2 b = __builtin_convertvector(f, bf16v2); return __builtin_bit_cast(unsigned, b); }
DI float bf2f(unsigned h16) { return __uint_as_float(h16 << 16); }
DI float bflo(unsigned u) { return __uint_as_float(u << 16); }
DI float bfhi(unsigned u) { return __uint_as_float(u & 0xffff0000u); }
DI bf16x8 cvt8(f32x4 a, f32x4 b) { u32x4 u = {pk2(a.x, a.y), pk2(a.z, a.w), pk2(b.x, b.y), pk2(b.z, b.w)}; return __builtin_bit_cast(bf16x8, u); }
DI float sigmoidf_(float v) { return 1.f / (1.f + __expf(-v)); }
DI float wave_sum(float v) {
#pragma unroll
  for (int o = 1; o < 64; o <<= 1) v += __shfl_xor(v, o);
  return v;
}

constexpr int BM = 256, BK = 64, HALF = 128, NXCD = 8, WGM = 8, HT = HALF * BK, SHM_B = 8 * HT * 2;
DI int lds_byte(int r, int c) { int st = (r >> 4) * 2 + (c >> 5), rr = r & 15, cc = c & 31, ob = rr * 64 + cc * 2; return st * 1024 + (ob ^ (((ob >> 9) & 1) << 5)); }
DI void stage_rc(int b, int& R, int& C) { int st = b / 1024, sb = b % 1024, swz = sb ^ (((sb >> 9) & 1) << 5); R = (st >> 1) * 16 + swz / 64; C = (st & 1) * 32 + (swz % 64) / 2; }

DI bool tile_order(int i, int G, int c, int nM, int nN, int& pm, int& pn) {
  const int nwg = nM * nN; const long L = (long)i * G + c; if (L >= nwg) return false;
  int wgid = (int)L; { const int q = nwg / NXCD, r = nwg % NXCD, xcd = wgid % NXCD, off = wgid / NXCD; wgid = (xcd < r ? xcd * (q + 1) : r * (q + 1) + (xcd - r) * q) + off; }
  const int nig = WGM * nN, gid = wgid / nig, fm = gid * WGM, gsz = (nM - fm) < WGM ? (nM - fm) : WGM;
  pm = fm + ((wgid % nig) % gsz); pn = (wgid % nig) / gsz; return true;
}

template <class Epi>
DI void gemm_tile(const bf16_t* __restrict__ A, const bf16_t* __restrict__ Bt, const int K, const int brow, const int bcol, const Epi& epi) {
  bf16_t* shm = (bf16_t*)dyn_lds;
  int tid = threadIdx.x; asm volatile("" : "+v"(tid));
#define SA(b, h) (shm + ((b) * 2 + (h)) * HT)
#define SB(b, h) (shm + (4 + (b) * 2 + (h)) * HT)
#define STAGE(P, BASE, br, kt) do { const char* _ub = (const char*)(BASE) + ((size_t)(br) * K + (size_t)(kt) * BK) * 2; \
    __builtin_amdgcn_global_load_lds((const unsigned*)(_ub + voff0), (unsigned*)((char*)(P) + wbase), 16, 0, 0); \
    __builtin_amdgcn_global_load_lds((const unsigned*)(_ub + voff1), (unsigned*)((char*)(P) + wbase + 8192), 16, 0, 0); } while (0)
#define LDA(dst, b, h) for (int m = 0; m < 4; ++m) for (int k = 0; k < 2; ++k) \
    dst[m][k] = *reinterpret_cast<const bf16x8*>((char*)SA(b, h) + lds_byte(wr * 64 + m * 16 + fr, k * 32 + fq * 8))
#define LDB(dst, b, h) for (int n = 0; n < 2; ++n) for (int k = 0; k < 2; ++k) \
    dst[n][k] = *reinterpret_cast<const bf16x8*>((char*)SB(b, h) + lds_byte(wc * 32 + n * 16 + fr, k * 32 + fq * 8))
#define MMA(ai, bj, At_, Bt_) do { __builtin_amdgcn_s_setprio(1); \
    for (int m = 0; m < 4; ++m) for (int n = 0; n < 2; ++n) for (int k = 0; k < 2; ++k) \
      acc[ai][bj][m][n] = __builtin_amdgcn_mfma_f32_16x16x32_bf16(Bt_[n][k], At_[m][k], acc[ai][bj][m][n], 0, 0, 0); \
    __builtin_amdgcn_s_setprio(0); } while (0)
#define WAIT_V(n) asm volatile("s_waitcnt vmcnt(" #n ")" ::: "memory")
#define WAIT_L(n) asm volatile("s_waitcnt lgkmcnt(" #n ")" ::: "memory")
#define BAR __builtin_amdgcn_s_barrier()
#define SCHED __builtin_amdgcn_sched_barrier(0)
  const int wid = tid >> 6, lane = tid & 63, wr = wid >> 2, wc = wid & 3, fr = lane & 15, fq = lane >> 4;
  f32x4 acc[2][2][4][2] = {};
  bf16x8 At[4][2], B0[2][2], B1[2][2];
  const int nt = K / BK;
  const int wbase = __builtin_amdgcn_readfirstlane((tid & ~63) * 16);
  unsigned voff0, voff1;
  { int r_, c_; stage_rc(tid * 16, r_, c_); voff0 = (unsigned)(r_ * K + c_) * 2u; stage_rc(tid * 16 + 8192, r_, c_); voff1 = (unsigned)(r_ * K + c_) * 2u; }
  STAGE(SB(0, 0), Bt, bcol, 0); STAGE(SA(0, 0), A, brow, 0);
  STAGE(SB(0, 1), Bt, bcol + HALF, 0); STAGE(SA(0, 1), A, brow + HALF, 0);
  if (wr == 1) BAR;
  WAIT_V(4); BAR;
  STAGE(SB(1, 0), Bt, bcol, 1); STAGE(SA(1, 0), A, brow, 1); STAGE(SB(1, 1), Bt, bcol + HALF, 1);
  WAIT_V(6); BAR;
  for (int t = 0; t < nt - 2; t += 2) {
    LDB(B0, 0, 0); SCHED; LDA(At, 0, 0); STAGE(SA(1, 1), A, brow + HALF, t + 1);
    WAIT_L(8); BAR; WAIT_L(0); MMA(0, 0, At, B0); BAR; SCHED;
    LDB(B1, 0, 1); STAGE(SB(0, 0), Bt, bcol, t + 2);
    BAR; WAIT_L(0); MMA(0, 1, At, B1); BAR;
    LDA(At, 0, 1); STAGE(SA(0, 0), A, brow, t + 2);
    BAR; WAIT_L(0); MMA(1, 0, At, B0); BAR; SCHED;
    STAGE(SB(0, 1), Bt, bcol + HALF, t + 2);
    WAIT_V(6); BAR; MMA(1, 1, At, B1); BAR;
    LDB(B0, 1, 0); SCHED; LDA(At, 1, 0); STAGE(SA(0, 1), A, brow + HALF, t + 2);
    WAIT_L(8); BAR; WAIT_L(0); MMA(0, 0, At, B0); BAR; SCHED;
    LDB(B1, 1, 1); STAGE(SB(1, 0), Bt, bcol, t + 3);
    BAR; WAIT_L(0); MMA(0, 1, At, B1); BAR;
    LDA(At, 1, 1); STAGE(SA(1, 0), A, brow, t + 3);
    BAR; WAIT_L(0); MMA(1, 0, At, B0); BAR; SCHED;
    STAGE(SB(1, 1), Bt, bcol + HALF, t + 3);
    WAIT_V(6); BAR; MMA(1, 1, At, B1); BAR;
  }
  { LDB(B0, 0, 0); LDA(At, 0, 0); STAGE(SA(1, 1), A, brow + HALF, nt - 1);
    BAR; WAIT_L(0); MMA(0, 0, At, B0); BAR;
    LDB(B1, 0, 1); BAR; WAIT_L(0); MMA(0, 1, At, B1); BAR;
    LDA(At, 0, 1); WAIT_V(4); BAR; WAIT_L(0); MMA(1, 0, At, B0); MMA(1, 1, At, B1); BAR; }
  { LDB(B0, 1, 0); LDA(At, 1, 0); WAIT_V(2); BAR; WAIT_L(0); MMA(0, 0, At, B0); BAR;
    LDB(B1, 1, 1); WAIT_V(0); BAR; WAIT_L(0); MMA(0, 1, At, B1); BAR;
    LDA(At, 1, 1); BAR; WAIT_L(0); MMA(1, 0, At, B0); MMA(1, 1, At, B1); BAR; }
  if (wr == 0) BAR;
  int tid2 = tid, brow2 = brow, bcol2 = bcol;
  asm volatile("" : "+v"(tid2), "+s"(brow2), "+s"(bcol2));
  const int wid2 = tid2 >> 6, lane2 = tid2 & 63;
  epi(acc, brow2, bcol2, wid2 >> 2, wid2 & 3, lane2 & 15, lane2 >> 4);
}

template <class Epi>
DI void gemm_phase(const bf16_t* A, const bf16_t* Bt, int Mrows, int N, int K, const Epi& epi) {
  const int nM = Mrows / BM, nN = N / BM;
  for (int i = 0;; ++i) {
    int pm, pn; if (!tile_order(i, gridDim.x, blockIdx.x, nM, nN, pm, pn)) break;
    gemm_tile(A, Bt, K, pm * BM, pn * BM, epi);
  }
}

DI void st_bf16x4(bf16_t* p, f32x4 v) { u32x2 u = {pk2(v.x, v.y), pk2(v.z, v.w)}; *(u32x2*)p = u; }
DI f32x4 ld_bf16x4(const bf16_t* p) { u32x2 u = *(const u32x2*)p; f32x4 v = {bflo(u.x), bfhi(u.x), bflo(u.y), bfhi(u.y)}; return v; }

#define EPI_ROWS for (int ai = 0; ai < 2; ++ai) for (int m = 0; m < 4; ++m)
#define EPI_COLS for (int bj = 0; bj < 2; ++bj) for (int n = 0; n < 2; ++n)
#define EPI_ROW (brow + ai * HALF + wr * 64 + m * 16 + fr)
#define EPI_COL (bcol + bj * HALF + wc * 32 + n * 16 + fq * 4)
typedef f32x4 acc_t[2][2][4][2];

struct EpiIn {
  const float* rs0; bf16_t* proj4; float* out;
  DI void operator()(const acc_t& acc, int brow, int bcol, int wr, int wc, int fr, int fq) const {
#pragma unroll
    EPI_ROWS { const int row = EPI_ROW; const float r = rs0[row];
#pragma unroll
      EPI_COLS { const int col = EPI_COL; f32x4 v = acc[ai][bj][m][n] * r;
        if (bcol < 512) { st_bf16x4(proj4 + (size_t)row * P4W + col, v * 0.125f); }
        else if (bcol < 1536) {
          const int isv = bcol >= 1024; const int c = col - (isv ? 1024 : 512);
          float* dst = (row < MP) ? out + (isv ? O_VP : O_KP) + (size_t)row * SBW + c : out + (isv ? O_VS : O_KS) + (size_t)(row - MP) * SBW + c;
          *(f32x4*)dst = v; }
        else if (bcol < 3072) { st_bf16x4(proj4 + (size_t)row * P4W + (col - 1024), v); }
        else { f32x4 s = {sigmoidf_(v.x), sigmoidf_(v.y), sigmoidf_(v.z), sigmoidf_(v.w)}; st_bf16x4(proj4 + (size_t)row * P4W + (col - 1024), s); }
      } }
  }
};
struct EpiMa {
  const bf16_t* proj4; bf16_t* merged;
  DI void operator()(const acc_t& acc, int brow, int bcol, int wr, int wc, int fr, int fq) const {
#pragma unroll
    EPI_ROWS { const int row = EPI_ROW;
#pragma unroll
      EPI_COLS { const int col = EPI_COL; f32x4 g = ld_bf16x4(proj4 + (size_t)row * P4W + 2048 + col);
        st_bf16x4(merged + (size_t)row * D + col, acc[ai][bj][m][n] * g); } }
  }
};
struct EpiMb {
  const bf16_t* proj4; bf16_t* merged;
  DI void operator()(const acc_t& acc, int brow, int bcol, int wr, int wc, int fr, int fq) const {
#pragma unroll
    EPI_ROWS { const int row = EPI_ROW;
#pragma unroll
      EPI_COLS { const int col = EPI_COL; f32x4 g = ld_bf16x4(proj4 + (size_t)row * P4W + 3072 + col);
        f32x4 t = ld_bf16x4(merged + (size_t)row * D + col);
        st_bf16x4(merged + (size_t)row * D + col, t + acc[ai][bj][m][n] * g); } }
  }
};
template <int MODE>
struct EpiRes {
  const float *x_p, *x_s; float* y; bf16_t* xb; float* ss; const float* ssprev; const bf16_t* pe;
  DI void operator()(const acc_t& acc, int brow, int bcol, int wr, int wc, int fr, int fq) const {
#pragma unroll
    EPI_ROWS { const int row = EPI_ROW; float part = 0.f; float r = 0.f;
      if (MODE == 2) r = rsqrtf(ssprev[row] * (1.f / D) + EPS);
#pragma unroll
      EPI_COLS { const int col = EPI_COL; f32x4 a = acc[ai][bj][m][n]; f32x4 res;
        float* yp = y + (size_t)row * D + col;
        if (MODE == 0) res = *(const f32x4*)((row < MP) ? x_p + (size_t)row * D + col : x_s + (size_t)(row - MP) * D + col);
        else res = *(const f32x4*)yp;
        if (MODE == 2) { f32x4 e = ld_bf16x4(pe + (size_t)row * D + col); a = a * r;
          f32x4 s = {sigmoidf_(a.x), sigmoidf_(a.y), sigmoidf_(a.z), sigmoidf_(a.w)}; a = s * e; }
        f32x4 o = res + a; *(f32x4*)yp = o;
        if (MODE != 2) st_bf16x4(xb + (size_t)row * D + col, o);
        part += o.x * o.x + o.y * o.y + o.z * o.z + o.w * o.w; }
      part += __shfl_xor(part, 16); part += __shfl_xor(part, 32);
      if (fq == 0) atomicAdd(ss + row, part); }
  }
};
struct EpiUp {
  const float* ss1; bf16_t* u;
  DI void operator()(const acc_t& acc, int brow, int bcol, int wr, int wc, int fr, int fq) const {
#pragma unroll
    EPI_ROWS { const int row = EPI_ROW; const float r = rsqrtf(ss1[row] * (1.f / D) + EPS);
#pragma unroll
      EPI_COLS { const int col = EPI_COL; f32x4 a = acc[ai][bj][m][n] * r;
        f32x4 z = {fmaxf(a.x, 0.f), fmaxf(a.y, 0.f), fmaxf(a.z, 0.f), fmaxf(a.w, 0.f)};
        st_bf16x4(u + (size_t)row * DFF + col, z * z); } }
  }
};
struct EpiPe {
  bf16_t* pe;
  DI void operator()(const acc_t& acc, int brow, int bcol, int wr, int wc, int fr, int fq) const {
#pragma unroll
    EPI_ROWS { const int row = EPI_ROW;
#pragma unroll
      EPI_COLS { const int col = EPI_COL; st_bf16x4(pe + (size_t)row * D + col, acc[ai][bj][m][n]); } }
  }
};

DI void transpose_item(const float* __restrict__ W, const float* __restrict__ g, int K, int N, bf16_t* __restrict__ WT, float* scr, int item, int lane) {
  const int nblk = N / 32, kb = item / nblk, nb = item % nblk, k0 = 64 * kb, n0 = 32 * nb;
#pragma unroll 8
  for (int i = 0; i < 32; ++i) { const int kk = 2 * i + (lane >> 5); float w = W[(size_t)(k0 + kk) * N + n0 + (lane & 31)]; if (g) w *= g[k0 + kk]; scr[kk * 33 + (lane & 31)] = w; }
  asm volatile("s_waitcnt lgkmcnt(0)" ::: "memory");
  const int c = lane & 7;
#pragma unroll
  for (int j = 0; j < 4; ++j) { const int n = (lane >> 3) + 8 * j; const float* s = scr + (8 * c) * 33 + n;
    u32x4 o = {pk2(s[0 * 33], s[1 * 33]), pk2(s[2 * 33], s[3 * 33]), pk2(s[4 * 33], s[5 * 33]), pk2(s[6 * 33], s[7 * 33])};
    *(u32x4*)(WT + (size_t)(n0 + n) * K + k0 + 8 * c) = o; }
  asm volatile("s_waitcnt lgkmcnt(0)" ::: "memory");
}

#define MFMA32(a, b, c) __builtin_amdgcn_mfma_f32_32x32x16_bf16((a), (b), (c), 0, 0, 0)
DI void attn_task(const Params& p, int task, int lane) {
  const bf16_t* proj4 = (const bf16_t*)(p.ws + W_RC);
  bf16_t* attn = (bf16_t*)(p.ws + W_RB);
  const int qb = task >> 3, h = task & 7, i = lane & 31, half = lane >> 5;
  int qtok0, nblk; const float *k0p, *v0p, *k1p, *v1p;
  if (qb < MP / 32) { const int b = qb >> 8, t0 = (qb & 255) * 32; qtok0 = b * SEQ + t0; nblk = (t0 >> 5) + 1;
    k0p = p.out + O_KP + (size_t)qtok0 * SBW; v0p = p.out + O_VP + (size_t)qtok0 * SBW; k1p = k0p; v1p = v0p; }
  else { const int b = qb - MP / 32; qtok0 = MP + b * DSEQ; nblk = 1 + PAST / 32;
    k0p = p.out + O_KS + (size_t)(b * DSEQ) * SBW; v0p = p.out + O_VS + (size_t)(b * DSEQ) * SBW;
    k1p = p.cache_k + (size_t)(b * PAST + PAST) * SBW; v1p = p.cache_v + (size_t)(b * PAST + PAST) * SBW; }
  bf16x8 qf[4];
  { const bf16_t* qp = proj4 + (size_t)(qtok0 + i) * P4W + h * HD + 8 * half;
#pragma unroll
    for (int s = 0; s < 4; ++s) qf[s] = *(const bf16x8*)(qp + 16 * s); }
  f32x16 o0 = {}, o1 = {};
  float C = 0.f;
  for (int it = 0; it < nblk; ++it) {
    const float* Kp = (it == 0 ? k0p : k1p - (size_t)it * 32 * SBW) + h * HD;
    const float* Vp = (it == 0 ? v0p : v1p - (size_t)it * 32 * SBW) + h * HD;
    f32x16 sacc = {};
#pragma unroll
    for (int s = 0; s < 4; ++s) { const f32x4* kp = (const f32x4*)(Kp + (size_t)i * SBW + 16 * s + 8 * half);
      sacc = MFMA32(cvt8(kp[0], kp[1]), qf[s], sacc); }
    float vv[2][2][8];
#pragma unroll
    for (int s = 0; s < 2; ++s)
#pragma unroll
      for (int jj = 0; jj < 8; ++jj) { const int key = 16 * s + 8 * (jj >> 2) + 4 * half + (jj & 3);
        vv[s][0][jj] = Vp[(size_t)key * SBW + i]; vv[s][1][jj] = Vp[(size_t)key * SBW + 32 + i]; }
    float lm[16], lp[16];
#pragma unroll
    for (int r = 0; r < 16; ++r) { const float z = sacc[r]; const int key = (r & 3) + 8 * (r >> 2) + 4 * half;
      const float sp = fmaxf(z, 0.f) + __logf(1.f + __expf(-fabsf(z)));
      const bool valid = (it != 0) || (key < i);
      lm[r] = valid ? -sp : 0.f; lp[r] = valid ? (z - sp) : -1e30f; }
    float G[4], Pn[4];
#pragma unroll
    for (int g = 0; g < 4; ++g) { G[g] = (lm[4 * g] + lm[4 * g + 1]) + (lm[4 * g + 2] + lm[4 * g + 3]); Pn[g] = __shfl_xor(G[g], 32); }
    float run = C; float a[16];
#pragma unroll
    for (int g = 3; g >= 0; --g) { float t = half ? run : run + Pn[g];
#pragma unroll
      for (int u = 3; u >= 0; --u) { a[4 * g + u] = __expf(lp[4 * g + u] + t); t += lm[4 * g + u]; }
      run += G[g] + Pn[g]; }
    C = run;
#pragma unroll
    for (int s = 0; s < 2; ++s) {
      u32x4 pu = {pk2(a[8 * s], a[8 * s + 1]), pk2(a[8 * s + 2], a[8 * s + 3]), pk2(a[8 * s + 4], a[8 * s + 5]), pk2(a[8 * s + 6], a[8 * s + 7])};
      const bf16x8 pf = __builtin_bit_cast(bf16x8, pu);
      u32x4 v0 = {pk2(vv[s][0][0], vv[s][0][1]), pk2(vv[s][0][2], vv[s][0][3]), pk2(vv[s][0][4], vv[s][0][5]), pk2(vv[s][0][6], vv[s][0][7])};
      u32x4 v1 = {pk2(vv[s][1][0], vv[s][1][1]), pk2(vv[s][1][2], vv[s][1][3]), pk2(vv[s][1][4], vv[s][1][5]), pk2(vv[s][1][6], vv[s][1][7])};
      o0 = MFMA32(__builtin_bit_cast(bf16x8, v0), pf, o0);
      o1 = MFMA32(__builtin_bit_cast(bf16x8, v1), pf, o1); }
    if (__all(C < -104.f)) break;
  }
  bf16_t* op = attn + (size_t)(qtok0 + i) * SBW + h * HD + 4 * half;
#pragma unroll
  for (int g = 0; g < 4; ++g) {
    f32x4 a0 = {o0[4 * g], o0[4 * g + 1], o0[4 * g + 2], o0[4 * g + 3]}; st_bf16x4(op + 8 * g, a0);
    f32x4 a1 = {o1[4 * g], o1[4 * g + 1], o1[4 * g + 2], o1[4 * g + 3]}; st_bf16x4(op + 32 + 8 * g, a1); }
}

DI void conv_items(const Params& p) {
  const bf16_t* proj4 = (const bf16_t*)(p.ws + W_RC);
  bf16_t* convg = (bf16_t*)(p.ws + W_RB) + (size_t)M * SBW;
  const int total = M * (CW / 8);
  for (int idx = blockIdx.x * blockDim.x + threadIdx.x; idx < total; idx += gridDim.x * blockDim.x) {
    const int tok = idx >> 6, c0 = (idx & 63) * 8;
    int b, t, T; const float* buf; float* nb;
    if (tok < MP) { b = tok >> 13; t = tok & (SEQ - 1); T = SEQ; buf = nullptr; nb = p.out + O_CP + (size_t)b * 2 * CW; }
    else { const int s = tok - MP; b = s >> 5; t = s & (DSEQ - 1); T = DSEQ; buf = p.cache_conv + (size_t)b * 2 * CW; nb = p.out + O_CS + (size_t)b * 2 * CW; }
    const bf16_t* row = proj4 + (size_t)tok * P4W + c0;
    float u0[8], u1[8], u2[8], cbv[8];
    { u32x4 a = *(const u32x4*)(row + 1024), x = *(const u32x4*)(row + 1536), bb = *(const u32x4*)(row + 512);
#pragma unroll
      for (int e = 0; e < 4; ++e) { u0[2 * e] = bflo(a[e]) * bflo(x[e]); u0[2 * e + 1] = bfhi(a[e]) * bfhi(x[e]); cbv[2 * e] = bflo(bb[e]); cbv[2 * e + 1] = bfhi(bb[e]); } }
    if (t >= 1) { u32x4 a = *(const u32x4*)(row - P4W + 1024), x = *(const u32x4*)(row - P4W + 1536);
#pragma unroll
      for (int e = 0; e < 4; ++e) { u1[2 * e] = bflo(a[e]) * bflo(x[e]); u1[2 * e + 1] = bfhi(a[e]) * bfhi(x[e]); } }
    else {
#pragma unroll
      for (int e = 0; e < 8; ++e) u1[e] = buf ? buf[CW + c0 + e] : 0.f; }
    if (t >= 2) { u32x4 a = *(const u32x4*)(row - 2 * P4W + 1024), x = *(const u32x4*)(row - 2 * P4W + 1536);
#pragma unroll
      for (int e = 0; e < 4; ++e) { u2[2 * e] = bflo(a[e]) * bflo(x[e]); u2[2 * e + 1] = bfhi(a[e]) * bfhi(x[e]); } }
    else {
#pragma unroll
      for (int e = 0; e < 8; ++e) u2[e] = buf ? buf[t * CW + c0 + e] : 0.f; }
    float o[8];
#pragma unroll
    for (int e = 0; e < 8; ++e) { const int c = c0 + e; o[e] = cbv[e] * (p.conv_w[c] * u2[e] + p.conv_w[CW + c] * u1[e] + p.conv_w[2 * CW + c] * u0[e]); }
    u32x4 ov = {pk2(o[0], o[1]), pk2(o[2], o[3]), pk2(o[4], o[5]), pk2(o[6], o[7])};
    *(u32x4*)(convg + (size_t)tok * CW + c0) = ov;
    if (t >= T - 2) { float* d = nb + (size_t)(t - (T - 2)) * CW + c0;
#pragma unroll
      for (int e = 0; e < 8; ++e) d[e] = u0[e]; }
  }
}

__global__ void __launch_bounds__(512, 2) fwd_megakernel(Params p) {
  cg::grid_group grid = cg::this_grid();
  const int lane = threadIdx.x & 63, wave = threadIdx.x >> 6;
  const int gw = blockIdx.x * 8 + wave, NGW = gridDim.x * 8;
  const int gtid = blockIdx.x * blockDim.x + threadIdx.x, NT = gridDim.x * blockDim.x;
  unsigned char* ws = p.ws;
  bf16_t *wInT = (bf16_t*)(ws + W_IN), *wAoT = (bf16_t*)(ws + W_AO), *wCoT = (bf16_t*)(ws + W_CO), *wOT = (bf16_t*)(ws + W_O),
         *wUpT = (bf16_t*)(ws + W_UP), *wDnT = (bf16_t*)(ws + W_DN), *wPgT = (bf16_t*)(ws + W_PG), *wPlT = (bf16_t*)(ws + W_PL);
  float* rs0 = (float*)(ws + W_RS0); float* ss = (float*)(ws + W_SS);
  bf16_t *pb = (bf16_t*)(ws + W_PB), *RA = (bf16_t*)(ws + W_RA), *RB = (bf16_t*)(ws + W_RB), *RC = (bf16_t*)(ws + W_RC);
  float* y = p.out + O_Y;

  {
    float* scr = (float*)dyn_lds + wave * (64 * 33);
    constexpr int I0 = (D / 64) * (NPROJ / 32), I1 = (SBW / 64) * (D / 32), I2 = I1, I3 = (D / 64) * (D / 32), I4 = (D / 64) * (DFF / 32),
                  I5 = (DFF / 64) * (D / 32), I6 = I3, I7 = (PLE / 64) * (D / 32), NI = I0 + I1 + I2 + I3 + I4 + I5 + I6 + I7;
    for (int it = gw; it < NI; it += NGW) {
      int r = it;
      if (r < I0) { transpose_item(p.w_in, p.g_mix, D, NPROJ, wInT, scr, r, lane); continue; } r -= I0;
      if (r < I1) { transpose_item(p.w_ao, nullptr, SBW, D, wAoT, scr, r, lane); continue; } r -= I1;
      if (r < I2) { transpose_item(p.w_co, nullptr, CW, D, wCoT, scr, r, lane); continue; } r -= I2;
      if (r < I3) { transpose_item(p.w_o, nullptr, D, D, wOT, scr, r, lane); continue; } r -= I3;
      if (r < I4) { transpose_item(p.w_up, p.g_ffn, D, DFF, wUpT, scr, r, lane); continue; } r -= I4;
      if (r < I5) { transpose_item(p.w_dn, nullptr, DFF, D, wDnT, scr, r, lane); continue; } r -= I5;
      if (r < I6) { transpose_item(p.w_pg, p.g_ple, D, D, wPgT, scr, r, lane); continue; } r -= I6;
      transpose_item(p.w_pl, nullptr, PLE, D, wPlT, scr, r, lane);
    }
    for (int row = gw; row < M; row += NGW) {
      const float* xr = (row < MP) ? p.x_p + (size_t)row * D : p.x_s + (size_t)(row - MP) * D;
      const f32x4* x4 = (const f32x4*)xr + lane; f32x4 v[4]; float s = 0.f;
#pragma unroll
      for (int j = 0; j < 4; ++j) { v[j] = x4[64 * j]; s += (v[j].x * v[j].x + v[j].y * v[j].y) + (v[j].z * v[j].z + v[j].w * v[j].w); }
      s = wave_sum(s);
      if (lane == 0) rs0[row] = rsqrtf(s * (1.f / D) + EPS);
      u32x2* o8 = (u32x2*)(RA + (size_t)row * D) + lane;
#pragma unroll
      for (int j = 0; j < 4; ++j) { u32x2 o = {pk2(v[j].x, v[j].y), pk2(v[j].z, v[j].w)}; o8[64 * j] = o; }
    }
    for (int idx = gtid; idx < M * PLE / 4; idx += NT) {
      const size_t e = (size_t)idx * 4; const float* src = (e < (size_t)MP * PLE) ? p.p_p + e : p.p_s + (e - (size_t)MP * PLE);
      f32x4 v = *(const f32x4*)src; st_bf16x4(pb + e, v);
    }
    for (int idx = gtid; idx < 3 * M; idx += NT) ss[idx] = 0.f;
  }
  grid.sync();
  { EpiIn e{rs0, RC, p.out}; gemm_phase(RA, wInT, M, NPROJ, D, e); }
  grid.sync();
  for (int task = gw; task < (M / 32) * NH; task += NGW) attn_task(p, task, lane);
  conv_items(p);
  grid.sync();
  {
    const int nM = M / BM, nN = D / BM;
    for (int i = 0;; ++i) { int pm, pn; if (!tile_order(i, gridDim.x, blockIdx.x, nM, nN, pm, pn)) break;
      { EpiMa e{RC, RA}; gemm_tile(RB, wAoT, SBW, pm * BM, pn * BM, e); }
      { EpiMb e{RC, RA}; gemm_tile(RB + (size_t)M * SBW, wCoT, CW, pm * BM, pn * BM, e); } }
  }
  grid.sync();
  { EpiRes<0> e{p.x_p, p.x_s, y, RB, ss, nullptr, nullptr}; gemm_phase(RA, wOT, M, D, D, e); }
  grid.sync();
  { EpiUp e{ss, RC}; gemm_phase(RB, wUpT, M, DFF, D, e); }
  grid.sync();
  { EpiRes<1> e{nullptr, nullptr, y, RA, ss + M, nullptr, nullptr}; gemm_phase(RC, wDnT, M, D, DFF, e); }
  grid.sync();
  {
    const int nM = M / BM, nN = D / BM;
    for (int i = 0;; ++i) { int pm, pn; if (!tile_order(i, gridDim.x, blockIdx.x, nM, nN, pm, pn)) break;
      { EpiPe e{RB}; gemm_tile(pb, wPlT, PLE, pm * BM, pn * BM, e); }
      { EpiRes<2> e{nullptr, nullptr, y, nullptr, ss + 2 * M, ss + M, RB}; gemm_tile(RA, wPgT, D, pm * BM, pn * BM, e); } }
  }
  grid.sync();
  for (int idx = gtid; idx < M * (D / 4); idx += NT) {
    const int row = idx >> 8, c = (idx & 255) * 4; const float r = rsqrtf(ss[2 * M + row] * (1.f / D) + EPS);
    f32x4 v = *(f32x4*)(y + (size_t)row * D + c); const f32x4 g = *(const f32x4*)(p.g_final + c);
    *(f32x4*)(y + (size_t)row * D + c) = v * r * g;
  }
}

extern "C" void kernel_launch(void* const* d_in, const int* in_sizes, int n_in, void* d_out, int out_size, void* d_ws, size_t ws_size, hipStream_t stream) {
  static int grid_blocks = 0;
  if (grid_blocks == 0) {
    if (ws_size < W_END) { fprintf(stderr, "kernel_launch: workspace too small (%zu < %zu)\n", ws_size, (size_t)W_END); grid_blocks = -1; return; }
    int dev = 0, cus = 0, per_cu = 0;
    hipGetDevice(&dev);
    hipDeviceGetAttribute(&cus, hipDeviceAttributeMultiprocessorCount, dev);
    hipFuncSetAttribute((const void*)fwd_megakernel, hipFuncAttributeMaxDynamicSharedMemorySize, SHM_B);
    hipOccupancyMaxActiveBlocksPerMultiprocessor(&per_cu, (const void*)fwd_megakernel, 512, SHM_B);
    if (per_cu < 1) { fprintf(stderr, "kernel_launch: occupancy query says %d blocks/CU\n", per_cu); per_cu = 1; }
    grid_blocks = cus;
  }
  if (grid_blocks < 0) return;
  Params p{};
  p.x_p = (const float*)d_in[0]; p.x_s = (const float*)d_in[1]; p.p_p = (const float*)d_in[2]; p.p_s = (const float*)d_in[3];
  p.cache_k = (const float*)d_in[4]; p.cache_v = (const float*)d_in[5]; p.cache_conv = (const float*)d_in[6];
  p.g_mix = (const float*)d_in[7]; p.w_in = (const float*)d_in[8]; p.conv_w = (const float*)d_in[9]; p.w_ao = (const float*)d_in[10];
  p.w_co = (const float*)d_in[11]; p.w_o = (const float*)d_in[12]; p.g_ffn = (const float*)d_in[13]; p.w_up = (const float*)d_in[14];
  p.w_dn = (const float*)d_in[15]; p.g_ple = (const float*)d_in[16]; p.w_pg = (const float*)d_in[17]; p.w_pl = (const float*)d_in[18];
  p.g_final = (const float*)d_in[19];
  p.out = (float*)d_out; p.ws = (unsigned char*)d_ws;
  void* args[] = {&p};
  hipError_t e = hipLaunchCooperativeKernel((const void*)fwd_megakernel, dim3(grid_blocks), dim3(512), args, SHM_B, stream);
  if (e != hipSuccess) fprintf(stderr, "cooperative launch failed: %s (grid %d)\n", hipGetErrorString(e), grid_blocks);
}
```

```cpp
#include <hip/hip_runtime.h>
#include <hip/hip_cooperative_groups.h>
#include <cstdio>
#include <cstdint>
namespace cg = cooperative_groups;

#define DI __device__ __forceinline__
typedef unsigned short bf16_t;
typedef short bf16x8 __attribute__((ext_vector_type(8)));
typedef float f32x4 __attribute__((ext_vector_type(4)));
typedef float f32x2 __attribute__((ext_vector_type(2)));
typedef float f32x16 __attribute__((ext_vector_type(16)));
typedef unsigned u32x4 __attribute__((ext_vector_type(4)));
typedef unsigned u32x2 __attribute__((ext_vector_type(2)));
typedef __bf16 bf16v2 __attribute__((ext_vector_type(2)));

constexpr int D = 1024, NPROJ = 5120, MP = 32768, MS = 1024, M = MP + MS, SEQ = 8192, DSEQ = 32, PAST = 2048;
constexpr int NH = 8, HD = 64, SBW = 512, CW = 512, PLE = 256, DFF = 4096, P4W = 4096;
constexpr float EPS = 1e-6f;
constexpr size_t O_Y = 0, O_KP = (size_t)M * D, O_VP = O_KP + (size_t)MP * SBW, O_CP = O_VP + (size_t)MP * SBW,
                 O_KS = O_CP + 4 * 2 * CW, O_VS = O_KS + (size_t)MS * SBW, O_CS = O_VS + (size_t)MS * SBW;
constexpr size_t W_IN = 0, W_AO = W_IN + (size_t)NPROJ * D * 2, W_CO = W_AO + (size_t)D * SBW * 2, W_O = W_CO + (size_t)D * CW * 2,
                 W_UP = W_O + (size_t)D * D * 2, W_DN = W_UP + (size_t)DFF * D * 2, W_PG = W_DN + (size_t)D * DFF * 2,
                 W_PL = W_PG + (size_t)D * D * 2, W_RS0 = W_PL + (size_t)D * PLE * 2, W_SS = W_RS0 + (size_t)M * 4,
                 W_PB = W_SS + (size_t)3 * M * 4, W_RA = W_PB + (size_t)M * PLE * 2, W_RB = W_RA + (size_t)M * D * 2,
                 W_RC = W_RB + (size_t)M * D * 2, W_END = W_RC + (size_t)M * P4W * 2;

struct Params {
  const float *x_p, *x_s, *p_p, *p_s, *cache_k, *cache_v, *cache_conv;
  const float *g_mix, *w_in, *conv_w, *w_ao, *w_co, *w_o, *g_ffn, *w_up, *w_dn, *g_ple, *w_pg, *w_pl, *g_final;
  float* out; unsigned char* ws;
};

extern __shared__ __attribute__((aligned(16))) unsigned char dyn_lds[];

DI unsigned pk2(float lo, float hi) { f32x2 f = {lo, hi}; bf16v2 b = __builtin_convertvector(f, bf16v2); return __builtin_bit_cast(unsigned, b); }
DI float bf2f(unsigned h16) { return __uint_as_float(h16 << 16); }
DI float bflo(unsigned u) { return __uint_as_float(u << 16); }
DI float bfhi(unsigned u) { return __uint_as_float(u & 0xffff0000u); }
DI bf16x8 cvt8(f32x4 a, f32x4 b) { u32x4 u = {pk2(a.x, a.y), pk2(a.z, a.w), pk2(b.x, b.y), pk2(b.z, b.w)}; return __builtin_bit_cast(bf16x8, u); }
DI float sigmoidf_(float v) { return 1.f / (1.f + __expf(-v)); }
DI float wave_sum(float v) {
#pragma unroll
  for (int o = 1; o < 64; o <<= 1) v += __shfl_xor(v, o);
  return v;
}

constexpr int BM = 256, BK = 64, HALF = 128, NXCD = 8, WGM = 8, HT = HALF * BK, SHM_B = 8 * HT * 2;
DI int lds_byte(int r, int c) { int st = (r >> 4) * 2 + (c >> 5), rr = r & 15, cc = c & 31, ob = rr * 64 + cc * 2; return st * 1024 + (ob ^ (((ob >> 9) & 1) << 5)); }
DI void stage_rc(int b, int& R, int& C) { int st = b / 1024, sb = b % 1024, swz = sb ^ (((sb >> 9) & 1) << 5); R = (st >> 1) * 16 + swz / 64; C = (st & 1) * 32 + (swz % 64) / 2; }

DI bool tile_order(int i, int G, int c, int nM, int nN, int& pm, int& pn) {
  const int nwg = nM * nN; const long L = (long)i * G + c; if (L >= nwg) return false;
  int wgid = (int)L; { const int q = nwg / NXCD, r = nwg % NXCD, xcd = wgid % NXCD, off = wgid / NXCD; wgid = (xcd < r ? xcd * (q + 1) : r * (q + 1) + (xcd - r) * q) + off; }
  const int nig = WGM * nN, gid = wgid / nig, fm = gid * WGM, gsz = (nM - fm) < WGM ? (nM - fm) : WGM;
  pm = fm + ((wgid % nig) % gsz); pn = (wgid % nig) / gsz; return true;
}

typedef f32x4 acc_t[2][2][4][2];
DI void gemm_kloop(const bf16_t* __restrict__ A, const bf16_t* __restrict__ Bt, const int K, const int brow, const int bcol, acc_t& acc) {
  bf16_t* shm = (bf16_t*)dyn_lds;
  int tid = threadIdx.x; asm volatile("" : "+v"(tid));
#define SA(b, h) (shm + ((b) * 2 + (h)) * HT)
#define SB(b, h) (shm + (4 + (b) * 2 + (h)) * HT)
#define STAGE(P, BASE, br, kt) do { const char* _ub = (const char*)(BASE) + ((size_t)(br) * K + (size_t)(kt) * BK) * 2; \
    __builtin_amdgcn_global_load_lds((const unsigned*)(_ub + voff0), (unsigned*)((char*)(P) + wbase), 16, 0, 0); \
    __builtin_amdgcn_global_load_lds((const unsigned*)(_ub + voff1), (unsigned*)((char*)(P) + wbase + 8192), 16, 0, 0); } while (0)
#define LDA(dst, b, h) for (int m = 0; m < 4; ++m) for (int k = 0; k < 2; ++k) \
    dst[m][k] = *reinterpret_cast<const bf16x8*>((char*)SA(b, h) + lds_byte(wr * 64 + m * 16 + fr, k * 32 + fq * 8))
#define LDB(dst, b, h) for (int n = 0; n < 2; ++n) for (int k = 0; k < 2; ++k) \
    dst[n][k] = *reinterpret_cast<const bf16x8*>((char*)SB(b, h) + lds_byte(wc * 32 + n * 16 + fr, k * 32 + fq * 8))
#define MMA(ai, bj, At_, Bt_) do { __builtin_amdgcn_s_setprio(1); \
    for (int m = 0; m < 4; ++m) for (int n = 0; n < 2; ++n) for (int k = 0; k < 2; ++k) \
      acc[ai][bj][m][n] = __builtin_amdgcn_mfma_f32_16x16x32_bf16(Bt_[n][k], At_[m][k], acc[ai][bj][m][n], 0, 0, 0); \
    __builtin_amdgcn_s_setprio(0); } while (0)
#define WAIT_V(n) asm volatile("s_waitcnt vmcnt(" #n ")" ::: "memory")
#define WAIT_L(n) asm volatile("s_waitcnt lgkmcnt(" #n ")" ::: "memory")
#define BAR __builtin_amdgcn_s_barrier()
#define SCHED __builtin_amdgcn_sched_barrier(0)
  const int wid = tid >> 6, lane = tid & 63, wr = wid >> 2, wc = wid & 3, fr = lane & 15, fq = lane >> 4;
  bf16x8 At[4][2], B0[2][2], B1[2][2];
  const int nt = K / BK;
  const int wbase = __builtin_amdgcn_readfirstlane((tid & ~63) * 16);
  unsigned voff0, voff1;
  { int r_, c_; stage_rc(tid * 16, r_, c_); voff0 = (unsigned)(r_ * K + c_) * 2u; stage_rc(tid * 16 + 8192, r_, c_); voff1 = (unsigned)(r_ * K + c_) * 2u; }
  STAGE(SB(0, 0), Bt, bcol, 0); STAGE(SA(0, 0), A, brow, 0);
  STAGE(SB(0, 1), Bt, bcol + HALF, 0); STAGE(SA(0, 1), A, brow + HALF, 0);
  if (wr == 1) BAR;
  WAIT_V(4); BAR;
  STAGE(SB(1, 0), Bt, bcol, 1); STAGE(SA(1, 0), A, brow, 1); STAGE(SB(1, 1), Bt, bcol + HALF, 1);
  WAIT_V(6); BAR;
  for (int t = 0; t < nt - 2; t += 2) {
    LDB(B0, 0, 0); SCHED; LDA(At, 0, 0); STAGE(SA(1, 1), A, brow + HALF, t + 1);
    WAIT_L(8); BAR; WAIT_L(0); MMA(0, 0, At, B0); BAR; SCHED;
    LDB(B1, 0, 1); STAGE(SB(0, 0), Bt, bcol, t + 2);
    BAR; WAIT_L(0); MMA(0, 1, At, B1); BAR;
    LDA(At, 0, 1); STAGE(SA(0, 0), A, brow, t + 2);
    BAR; WAIT_L(0); MMA(1, 0, At, B0); BAR; SCHED;
    STAGE(SB(0, 1), Bt, bcol + HALF, t + 2);
    WAIT_V(6); BAR; MMA(1, 1, At, B1); BAR;
    LDB(B0, 1, 0); SCHED; LDA(At, 1, 0); STAGE(SA(0, 1), A, brow + HALF, t + 2);
    WAIT_L(8); BAR; WAIT_L(0); MMA(0, 0, At, B0); BAR; SCHED;
    LDB(B1, 1, 1); STAGE(SB(1, 0), Bt, bcol, t + 3);
    BAR; WAIT_L(0); MMA(0, 1, At, B1); BAR;
    LDA(At, 1, 1); STAGE(SA(1, 0), A, brow, t + 3);
    BAR; WAIT_L(0); MMA(1, 0, At, B0); BAR; SCHED;
    STAGE(SB(1, 1), Bt, bcol + HALF, t + 3);
    WAIT_V(6); BAR; MMA(1, 1, At, B1); BAR;
  }
  { LDB(B0, 0, 0); LDA(At, 0, 0); STAGE(SA(1, 1), A, brow + HALF, nt - 1);
    BAR; WAIT_L(0); MMA(0, 0, At, B0); BAR;
    LDB(B1, 0, 1); BAR; WAIT_L(0); MMA(0, 1, At, B1); BAR;
    LDA(At, 0, 1); WAIT_V(4); BAR; WAIT_L(0); MMA(1, 0, At, B0); MMA(1, 1, At, B1); BAR; }
  { LDB(B0, 1, 0); LDA(At, 1, 0); WAIT_V(2); BAR; WAIT_L(0); MMA(0, 0, At, B0); BAR;
    LDB(B1, 1, 1); WAIT_V(0); BAR; WAIT_L(0); MMA(0, 1, At, B1); BAR;
    LDA(At, 1, 1); BAR; WAIT_L(0); MMA(1, 0, At, B0); MMA(1, 1, At, B1); BAR; }
  if (wr == 0) BAR;
}
template <class F>
DI void epi_call(acc_t& acc, const int brow, const int bcol, const F& f) {
  int tid2 = threadIdx.x, brow2 = brow, bcol2 = bcol;
  asm volatile("" : "+v"(tid2), "+s"(brow2), "+s"(bcol2));
  const int wid2 = tid2 >> 6, lane2 = tid2 & 63;
  f(acc, brow2, bcol2, wid2 >> 2, wid2 & 3, lane2 & 15, lane2 >> 4);
}
template <class Epi>
DI void gemm_tile(const bf16_t* __restrict__ A, const bf16_t* __restrict__ Bt, const int K, const int brow, const int bcol, const Epi& epi) {
  acc_t acc = {};
  gemm_kloop(A, Bt, K, brow, bcol, acc);
  epi_call(acc, brow, bcol, epi);
}

template <class Epi>
DI void gemm_phase(const bf16_t* A, const bf16_t* Bt, int Mrows, int N, int K, const Epi& epi) {
  const int nM = Mrows / BM, nN = N / BM;
  for (int i = 0;; ++i) {
    int pm, pn; if (!tile_order(i, gridDim.x, blockIdx.x, nM, nN, pm, pn)) break;
    gemm_tile(A, Bt, K, pm * BM, pn * BM, epi);
  }
}

DI void st_bf16x4(bf16_t* p, f32x4 v) { u32x2 u = {pk2(v.x, v.y), pk2(v.z, v.w)}; *(u32x2*)p = u; }
DI f32x4 ld_bf16x4(const bf16_t* p) { u32x2 u = *(const u32x2*)p; f32x4 v = {bflo(u.x), bfhi(u.x), bflo(u.y), bfhi(u.y)}; return v; }

#define EPI_ROWS for (int ai = 0; ai < 2; ++ai) for (int m = 0; m < 4; ++m)
#define EPI_COLS for (int bj = 0; bj < 2; ++bj) for (int n = 0; n < 2; ++n)
#define EPI_ROW (brow + ai * HALF + wr * 64 + m * 16 + fr)
#define EPI_COL (bcol + bj * HALF + wc * 32 + n * 16 + fq * 4)

struct EpiIn {
  const float* rs0; bf16_t* proj4; float* out;
  DI void operator()(const acc_t& acc, int brow, int bcol, int wr, int wc, int fr, int fq) const {
    float rr[2][4];
#pragma unroll
    EPI_ROWS rr[ai][m] = rs0[EPI_ROW];
    if (bcol < 2048) {
#pragma unroll
      EPI_ROWS { const int row = EPI_ROW; const float r = rr[ai][m];
#pragma unroll
        EPI_COLS { const int col = EPI_COL; f32x4 v = acc[ai][bj][m][n] * r;
          if (bcol < 512) { st_bf16x4(proj4 + (size_t)row * P4W + col, v * 0.125f); }
          else if (bcol < 1536) {
            const int isv = bcol >= 1024; const int c = col - (isv ? 1024 : 512);
            float* dst = (row < MP) ? out + (isv ? O_VP : O_KP) + (size_t)row * SBW + c : out + (isv ? O_VS : O_KS) + (size_t)(row - MP) * SBW + c;
            *(f32x4*)dst = v; }
          else { st_bf16x4(proj4 + (size_t)row * P4W + (col - 1024), v); } } }
    } else {
      const bool gate = bcol >= 3072; const int t = ((bcol - (gate ? 3072 : 2048)) >> 8) * 128;
#pragma unroll
      EPI_ROWS { const int row = EPI_ROW; const float r = rr[ai][m];
#pragma unroll
        for (int n = 0; n < 2; ++n) { const int ch = t + wc * 32 + n * 16 + fq * 4; f32x4 a = acc[ai][0][m][n] * r, b = acc[ai][1][m][n] * r;
          if (!gate) { st_bf16x4(proj4 + (size_t)row * P4W + 1024 + ch, a * b); }
          else { f32x4 rho, sg;
#pragma unroll
            for (int e = 0; e < 4; ++e) { const float ea = __expf(-a[e]), eb = __expf(-fmaxf(b[e], -80.f)); sg[e] = 1.f / (1.f + eb); rho[e] = (1.f + eb) / (1.f + ea); }
            st_bf16x4(proj4 + (size_t)row * P4W + 2048 + ch, rho); st_bf16x4(proj4 + (size_t)row * P4W + 3072 + ch, sg); } } }
    }
  }
};
template <bool FINAL>
struct EpiGate {
  const bf16_t* proj4; int off; bf16_t* merged;
  DI void operator()(acc_t& acc, int brow, int bcol, int wr, int wc, int fr, int fq) const {
    u32x2 g[2][4][2][2];
#pragma unroll
    EPI_ROWS { const int row = EPI_ROW;
#pragma unroll
      EPI_COLS g[ai][m][bj][n] = *(const u32x2*)(proj4 + (size_t)row * P4W + off + EPI_COL); }
#pragma unroll
    EPI_ROWS { const int row = EPI_ROW;
#pragma unroll
      EPI_COLS { const u32x2 u = g[ai][m][bj][n]; const f32x4 gv = {bflo(u.x), bfhi(u.x), bflo(u.y), bfhi(u.y)};
        if (FINAL) st_bf16x4(merged + (size_t)row * D + EPI_COL, acc[ai][bj][m][n] * gv); else acc[ai][bj][m][n] *= gv; } }
  }
};
template <int MODE>
struct EpiRes {
  const float *x_p, *x_s; const bf16_t* resb; bf16_t* outb; float* ss; const float* ssprev; const bf16_t* pe;
  DI void operator()(const acc_t& acc, int brow, int bcol, int wr, int wc, int fr, int fq) const {
#pragma unroll
    for (int ai = 0; ai < 2; ++ai) {
      f32x4 resf[4][2][2]; u32x2 resh[4][2][2], peh[4][2][2]; float rr[4];
#pragma unroll
      for (int m = 0; m < 4; ++m) { const int row = EPI_ROW;
        if (MODE == 2) rr[m] = ssprev[row];
#pragma unroll
        EPI_COLS { const int col = EPI_COL;
          if (MODE == 0) resf[m][bj][n] = *(const f32x4*)((row < MP) ? x_p + (size_t)row * D + col : x_s + (size_t)(row - MP) * D + col);
          else resh[m][bj][n] = *(const u32x2*)(resb + (size_t)row * D + col);
          if (MODE == 2) peh[m][bj][n] = *(const u32x2*)(pe + (size_t)row * D + col); } }
#pragma unroll
      for (int m = 0; m < 4; ++m) { const int row = EPI_ROW; float part = 0.f; float r = 0.f;
        if (MODE == 2) r = rsqrtf(rr[m] * (1.f / D) + EPS);
#pragma unroll
        EPI_COLS { const int col = EPI_COL; f32x4 a = acc[ai][bj][m][n]; f32x4 res;
          if (MODE == 0) res = resf[m][bj][n];
          else { const u32x2 u = resh[m][bj][n]; res = (f32x4){bflo(u.x), bfhi(u.x), bflo(u.y), bfhi(u.y)}; }
          if (MODE == 2) { const u32x2 u = peh[m][bj][n]; const f32x4 e = {bflo(u.x), bfhi(u.x), bflo(u.y), bfhi(u.y)}; a = a * r;
            f32x4 sg = {sigmoidf_(a.x), sigmoidf_(a.y), sigmoidf_(a.z), sigmoidf_(a.w)}; a = sg * e; }
          const f32x4 o = res + a;
          st_bf16x4(outb + (size_t)row * D + col, o);
          part += o.x * o.x + o.y * o.y + o.z * o.z + o.w * o.w; }
        part += __shfl_xor(part, 16); part += __shfl_xor(part, 32);
        if (fq == 0) atomicAdd(ss + row, part); }
    }
  }
};
struct EpiUp {
  const float* ss1; bf16_t* u;
  DI void operator()(const acc_t& acc, int brow, int bcol, int wr, int wc, int fr, int fq) const {
    float rr[2][4];
#pragma unroll
    EPI_ROWS rr[ai][m] = ss1[EPI_ROW];
#pragma unroll
    EPI_ROWS { const int row = EPI_ROW; const float r = rsqrtf(rr[ai][m] * (1.f / D) + EPS);
#pragma unroll
      EPI_COLS { const int col = EPI_COL; f32x4 a = acc[ai][bj][m][n] * r;
        f32x4 z = {fmaxf(a.x, 0.f), fmaxf(a.y, 0.f), fmaxf(a.z, 0.f), fmaxf(a.w, 0.f)};
        st_bf16x4(u + (size_t)row * DFF + col, z * z); } }
  }
};
struct EpiPe {
  bf16_t* pe;
  DI void operator()(const acc_t& acc, int brow, int bcol, int wr, int wc, int fr, int fq) const {
#pragma unroll
    EPI_ROWS { const int row = EPI_ROW;
#pragma unroll
      EPI_COLS { const int col = EPI_COL; st_bf16x4(pe + (size_t)row * D + col, acc[ai][bj][m][n]); } }
  }
};

DI int win_perm(int n) {
  if (n < 2048) return n;
  if (n < 3072) { const int r = n - 2048, c = r & 511; return 2048 + 256 * (c >> 7) + ((r >> 9) ? 128 : 0) + (c & 127); }
  const int r = n - 3072, c = r & 1023; return 3072 + 256 * (c >> 7) + ((r >> 10) ? 128 : 0) + (c & 127);
}
template <bool PERM>
DI void transpose_item(const float* __restrict__ W, const float* __restrict__ g, int K, int N, bf16_t* __restrict__ WT, float* scr, int item, int lane) {
  const int nblk = N / 32, kb = item / nblk, nb = item % nblk, k0 = 64 * kb, n0 = 32 * nb;
  const int n0d = PERM ? win_perm(n0) : n0;
#pragma unroll 8
  for (int i = 0; i < 32; ++i) { const int kk = 2 * i + (lane >> 5); float w = W[(size_t)(k0 + kk) * N + n0 + (lane & 31)]; if (g) w *= g[k0 + kk]; scr[kk * 33 + (lane & 31)] = w; }
  asm volatile("s_waitcnt lgkmcnt(0)" ::: "memory");
  const int c = lane & 7;
#pragma unroll
  for (int j = 0; j < 4; ++j) { const int n = (lane >> 3) + 8 * j; const float* s = scr + (8 * c) * 33 + n;
    u32x4 o = {pk2(s[0 * 33], s[1 * 33]), pk2(s[2 * 33], s[3 * 33]), pk2(s[4 * 33], s[5 * 33]), pk2(s[6 * 33], s[7 * 33])};
    *(u32x4*)(WT + (size_t)(n0d + n) * K + k0 + 8 * c) = o; }
  asm volatile("s_waitcnt lgkmcnt(0)" ::: "memory");
}

#define MFMA32(a, b, c) __builtin_amdgcn_mfma_f32_32x32x16_bf16((a), (b), (c), 0, 0, 0)
DI void attn_task(const Params& p, int task, int lane) {
  const bf16_t* proj4 = (const bf16_t*)(p.ws + W_RC);
  bf16_t* attn = (bf16_t*)(p.ws + W_RB);
  const int qb = task >> 3, h = task & 7, i = lane & 31, half = lane >> 5;
  int qtok0, nblk; const float *k0p, *v0p, *k1p, *v1p;
  if (qb < MP / 32) { const int b = qb >> 8, t0 = (qb & 255) * 32; qtok0 = b * SEQ + t0; nblk = (t0 >> 5) + 1;
    k0p = p.out + O_KP + (size_t)qtok0 * SBW; v0p = p.out + O_VP + (size_t)qtok0 * SBW; k1p = k0p; v1p = v0p; }
  else { const int b = qb - MP / 32; qtok0 = MP + b * DSEQ; nblk = 1 + PAST / 32;
    k0p = p.out + O_KS + (size_t)(b * DSEQ) * SBW; v0p = p.out + O_VS + (size_t)(b * DSEQ) * SBW;
    k1p = p.cache_k + (size_t)(b * PAST + PAST) * SBW; v1p = p.cache_v + (size_t)(b * PAST + PAST) * SBW; }
  bf16x8 qf[4];
  { const bf16_t* qp = proj4 + (size_t)(qtok0 + i) * P4W + h * HD + 8 * half;
#pragma unroll
    for (int s = 0; s < 4; ++s) qf[s] = *(const bf16x8*)(qp + 16 * s); }
  f32x16 o0 = {}, o1 = {};
  float C = 0.f;
  for (int it = 0; it < nblk; ++it) {
    const float* Kp = (it == 0 ? k0p : k1p - (size_t)it * 32 * SBW) + h * HD;
    const float* Vp = (it == 0 ? v0p : v1p - (size_t)it * 32 * SBW) + h * HD;
    f32x16 sacc = {};
#pragma unroll
    for (int s = 0; s < 4; ++s) { const f32x4* kp = (const f32x4*)(Kp + (size_t)i * SBW + 16 * s + 8 * half);
      sacc = MFMA32(cvt8(kp[0], kp[1]), qf[s], sacc); }
    float vv[2][2][8];
#pragma unroll
    for (int s = 0; s < 2; ++s)
#pragma unroll
      for (int jj = 0; jj < 8; ++jj) { const int key = 16 * s + 8 * (jj >> 2) + 4 * half + (jj & 3);
        vv[s][0][jj] = Vp[(size_t)key * SBW + i]; vv[s][1][jj] = Vp[(size_t)key * SBW + 32 + i]; }
    float lm[16], lp[16];
#pragma unroll
    for (int r = 0; r < 16; ++r) { const float z = sacc[r]; const int key = (r & 3) + 8 * (r >> 2) + 4 * half;
      const float sp = fmaxf(z, 0.f) + __logf(1.f + __expf(-fabsf(z)));
      const bool valid = (it != 0) || (key < i);
      lm[r] = valid ? -sp : 0.f; lp[r] = valid ? (z - sp) : -1e30f; }
    float G[4], Pn[4];
#pragma unroll
    for (int g = 0; g < 4; ++g) { G[g] = (lm[4 * g] + lm[4 * g + 1]) + (lm[4 * g + 2] + lm[4 * g + 3]); Pn[g] = __shfl_xor(G[g], 32); }
    float run = C; float a[16];
#pragma unroll
    for (int g = 3; g >= 0; --g) { float t = half ? run : run + Pn[g];
#pragma unroll
      for (int u = 3; u >= 0; --u) { a[4 * g + u] = __expf(lp[4 * g + u] + t); t += lm[4 * g + u]; }
      run += G[g] + Pn[g]; }
    C = run;
#pragma unroll
    for (int s = 0; s < 2; ++s) {
      u32x4 pu = {pk2(a[8 * s], a[8 * s + 1]), pk2(a[8 * s + 2], a[8 * s + 3]), pk2(a[8 * s + 4], a[8 * s + 5]), pk2(a[8 * s + 6], a[8 * s + 7])};
      const bf16x8 pf = __builtin_bit_cast(bf16x8, pu);
      u32x4 v0 = {pk2(vv[s][0][0], vv[s][0][1]), pk2(vv[s][0][2], vv[s][0][3]), pk2(vv[s][0][4], vv[s][0][5]), pk2(vv[s][0][6], vv[s][0][7])};
      u32x4 v1 = {pk2(vv[s][1][0], vv[s][1][1]), pk2(vv[s][1][2], vv[s][1][3]), pk2(vv[s][1][4], vv[s][1][5]), pk2(vv[s][1][6], vv[s][1][7])};
      o0 = MFMA32(__builtin_bit_cast(bf16x8, v0), pf, o0);
      o1 = MFMA32(__builtin_bit_cast(bf16x8, v1), pf, o1); }
    if (__all(C < -104.f)) break;
  }
  bf16_t* op = attn + (size_t)(qtok0 + i) * SBW + h * HD + 4 * half;
#pragma unroll
  for (int g = 0; g < 4; ++g) {
    f32x4 a0 = {o0[4 * g], o0[4 * g + 1], o0[4 * g + 2], o0[4 * g + 3]}; st_bf16x4(op + 8 * g, a0);
    f32x4 a1 = {o1[4 * g], o1[4 * g + 1], o1[4 * g + 2], o1[4 * g + 3]}; st_bf16x4(op + 32 + 8 * g, a1); }
}

DI void conv_items(const Params& p) {
  const bf16_t* proj4 = (const bf16_t*)(p.ws + W_RC);
  bf16_t* convg = (bf16_t*)(p.ws + W_RB) + (size_t)M * SBW;
  const int total = M * (CW / 8);
  for (int idx = blockIdx.x * blockDim.x + threadIdx.x; idx < total; idx += gridDim.x * blockDim.x) {
    const int tok = idx >> 6, c0 = (idx & 63) * 8;
    int b, t, T; const float* buf; float* nb;
    if (tok < MP) { b = tok >> 13; t = tok & (SEQ - 1); T = SEQ; buf = nullptr; nb = p.out + O_CP + (size_t)b * 2 * CW; }
    else { const int s = tok - MP; b = s >> 5; t = s & (DSEQ - 1); T = DSEQ; buf = p.cache_conv + (size_t)b * 2 * CW; nb = p.out + O_CS + (size_t)b * 2 * CW; }
    const bf16_t* row = proj4 + (size_t)tok * P4W + c0;
    float u0[8], u1[8], u2[8], cbv[8];
    { const u32x4 x = *(const u32x4*)(row + 1024), bb = *(const u32x4*)(row + 512);
#pragma unroll
      for (int e = 0; e < 4; ++e) { u0[2 * e] = bflo(x[e]); u0[2 * e + 1] = bfhi(x[e]); cbv[2 * e] = bflo(bb[e]); cbv[2 * e + 1] = bfhi(bb[e]); } }
    if (t >= 1) { const u32x4 x = *(const u32x4*)(row - P4W + 1024);
#pragma unroll
      for (int e = 0; e < 4; ++e) { u1[2 * e] = bflo(x[e]); u1[2 * e + 1] = bfhi(x[e]); } }
    else {
#pragma unroll
      for (int e = 0; e < 8; ++e) u1[e] = buf ? buf[CW + c0 + e] : 0.f; }
    if (t >= 2) { const u32x4 x = *(const u32x4*)(row - 2 * P4W + 1024);
#pragma unroll
      for (int e = 0; e < 4; ++e) { u2[2 * e] = bflo(x[e]); u2[2 * e + 1] = bfhi(x[e]); } }
    else {
#pragma unroll
      for (int e = 0; e < 8; ++e) u2[e] = buf ? buf[t * CW + c0 + e] : 0.f; }
    float o[8];
#pragma unroll
    for (int e = 0; e < 8; ++e) { const int c = c0 + e; o[e] = cbv[e] * (p.conv_w[c] * u2[e] + p.conv_w[CW + c] * u1[e] + p.conv_w[2 * CW + c] * u0[e]); }
    u32x4 ov = {pk2(o[0], o[1]), pk2(o[2], o[3]), pk2(o[4], o[5]), pk2(o[6], o[7])};
    *(u32x4*)(convg + (size_t)tok * CW + c0) = ov;
    if (t >= T - 2) { float* d = nb + (size_t)(t - (T - 2)) * CW + c0;
#pragma unroll
      for (int e = 0; e < 8; ++e) d[e] = u0[e]; }
  }
}

__global__ void __launch_bounds__(512, 2) fwd_megakernel(Params p) {
  cg::grid_group grid = cg::this_grid();
  const int lane = threadIdx.x & 63, wave = threadIdx.x >> 6;
  const int gw = blockIdx.x * 8 + wave, NGW = gridDim.x * 8;
  const int gtid = blockIdx.x * blockDim.x + threadIdx.x, NT = gridDim.x * blockDim.x;
  unsigned char* ws = p.ws;
  bf16_t *wInT = (bf16_t*)(ws + W_IN), *wAoT = (bf16_t*)(ws + W_AO), *wCoT = (bf16_t*)(ws + W_CO), *wOT = (bf16_t*)(ws + W_O),
         *wUpT = (bf16_t*)(ws + W_UP), *wDnT = (bf16_t*)(ws + W_DN), *wPgT = (bf16_t*)(ws + W_PG), *wPlT = (bf16_t*)(ws + W_PL);
  float* rs0 = (float*)(ws + W_RS0); float* ss = (float*)(ws + W_SS);
  bf16_t *pb = (bf16_t*)(ws + W_PB), *RA = (bf16_t*)(ws + W_RA), *RB = (bf16_t*)(ws + W_RB), *RC = (bf16_t*)(ws + W_RC);
  float* y = p.out + O_Y;

  {
    float* scr = (float*)dyn_lds + wave * (64 * 33);
    constexpr int I0 = (D / 64) * (NPROJ / 32), I1 = (SBW / 64) * (D / 32), I2 = I1, I3 = (D / 64) * (D / 32), I4 = (D / 64) * (DFF / 32),
                  I5 = (DFF / 64) * (D / 32), I6 = I3, I7 = (PLE / 64) * (D / 32), NI = I0 + I1 + I2 + I3 + I4 + I5 + I6 + I7;
    for (int it = gw; it < NI; it += NGW) {
      int r = it;
      if (r < I0) { transpose_item<true>(p.w_in, p.g_mix, D, NPROJ, wInT, scr, r, lane); continue; } r -= I0;
      if (r < I1) { transpose_item<false>(p.w_ao, nullptr, SBW, D, wAoT, scr, r, lane); continue; } r -= I1;
      if (r < I2) { transpose_item<false>(p.w_co, nullptr, CW, D, wCoT, scr, r, lane); continue; } r -= I2;
      if (r < I3) { transpose_item<false>(p.w_o, nullptr, D, D, wOT, scr, r, lane); continue; } r -= I3;
      if (r < I4) { transpose_item<false>(p.w_up, p.g_ffn, D, DFF, wUpT, scr, r, lane); continue; } r -= I4;
      if (r < I5) { transpose_item<false>(p.w_dn, nullptr, DFF, D, wDnT, scr, r, lane); continue; } r -= I5;
      if (r < I6) { transpose_item<false>(p.w_pg, p.g_ple, D, D, wPgT, scr, r, lane); continue; } r -= I6;
      transpose_item<false>(p.w_pl, nullptr, PLE, D, wPlT, scr, r, lane);
    }
    for (int row = gw; row < M; row += NGW) {
      const float* xr = (row < MP) ? p.x_p + (size_t)row * D : p.x_s + (size_t)(row - MP) * D;
      const f32x4* x4 = (const f32x4*)xr + lane; f32x4 v[4]; float s = 0.f;
#pragma unroll
      for (int j = 0; j < 4; ++j) { v[j] = x4[64 * j]; s += (v[j].x * v[j].x + v[j].y * v[j].y) + (v[j].z * v[j].z + v[j].w * v[j].w); }
      s = wave_sum(s);
      if (lane == 0) rs0[row] = rsqrtf(s * (1.f / D) + EPS);
      u32x2* o8 = (u32x2*)(RA + (size_t)row * D) + lane;
#pragma unroll
      for (int j = 0; j < 4; ++j) { u32x2 o = {pk2(v[j].x, v[j].y), pk2(v[j].z, v[j].w)}; o8[64 * j] = o; }
    }
    for (int idx = gtid; idx < M * PLE / 4; idx += NT) {
      const size_t e = (size_t)idx * 4; const float* src = (e < (size_t)MP * PLE) ? p.p_p + e : p.p_s + (e - (size_t)MP * PLE);
      f32x4 v = *(const f32x4*)src; st_bf16x4(pb + e, v);
    }
    for (int idx = gtid; idx < 3 * M; idx += NT) ss[idx] = 0.f;
  }
  grid.sync();
  { EpiIn e{rs0, RC, p.out}; gemm_phase(RA, wInT, M, NPROJ, D, e); }
  grid.sync();
  for (int task = gw; task < (M / 32) * NH; task += NGW) attn_task(p, task, lane);
  conv_items(p);
  grid.sync();
  {
    const int nM = M / BM, nN = D / BM;
    for (int i = 0;; ++i) { int pm, pn; if (!tile_order(i, gridDim.x, blockIdx.x, nM, nN, pm, pn)) break;
      acc_t acc = {};
      gemm_kloop(RB, wAoT, SBW, pm * BM, pn * BM, acc);
      { EpiGate<false> e{RC, 2048, nullptr}; epi_call(acc, pm * BM, pn * BM, e); }
      gemm_kloop(RB + (size_t)M * SBW, wCoT, CW, pm * BM, pn * BM, acc);
      { EpiGate<true> e{RC, 3072, RA}; epi_call(acc, pm * BM, pn * BM, e); } }
  }
  grid.sync();
  { EpiRes<0> e{p.x_p, p.x_s, nullptr, RB, ss, nullptr, nullptr}; gemm_phase(RA, wOT, M, D, D, e); }
  grid.sync();
  { EpiUp e{ss, RC}; gemm_phase(RB, wUpT, M, DFF, D, e); }
  grid.sync();
  { EpiRes<1> e{nullptr, nullptr, RB, RA, ss + M, nullptr, nullptr}; gemm_phase(RC, wDnT, M, D, DFF, e); }
  grid.sync();
  {
    const int nM = M / BM, nN = D / BM;
    for (int i = 0;; ++i) { int pm, pn; if (!tile_order(i, gridDim.x, blockIdx.x, nM, nN, pm, pn)) break;
      { EpiPe e{RB}; gemm_tile(pb, wPlT, PLE, pm * BM, pn * BM, e); }
      { EpiRes<2> e{nullptr, nullptr, RA, RC, ss + 2 * M, ss + M, RB}; gemm_tile(RA, wPgT, D, pm * BM, pn * BM, e); } }
  }
  grid.sync();
  for (int idx = gtid; idx < M * (D / 4); idx += NT) {
    const int row = idx >> 8, c = (idx & 255) * 4; const float r = rsqrtf(ss[2 * M + row] * (1.f / D) + EPS);
    const f32x4 v = ld_bf16x4(RC + (size_t)row * D + c); const f32x4 g = *(const f32x4*)(p.g_final + c);
    *(f32x4*)(y + (size_t)row * D + c) = v * r * g;
  }
}

extern "C" void kernel_launch(void* const* d_in, const int* in_sizes, int n_in, void* d_out, int out_size, void* d_ws, size_t ws_size, hipStream_t stream) {
  static int grid_blocks = 0;
  if (grid_blocks == 0) {
    if (ws_size < W_END) { fprintf(stderr, "kernel_launch: workspace too small (%zu < %zu)\n", ws_size, (size_t)W_END); grid_blocks = -1; return; }
    int dev = 0, cus = 0, per_cu = 0;
    hipGetDevice(&dev);
    hipDeviceGetAttribute(&cus, hipDeviceAttributeMultiprocessorCount, dev);
    hipFuncSetAttribute((const void*)fwd_megakernel, hipFuncAttributeMaxDynamicSharedMemorySize, SHM_B);
    hipOccupancyMaxActiveBlocksPerMultiprocessor(&per_cu, (const void*)fwd_megakernel, 512, SHM_B);
    if (per_cu < 1) { fprintf(stderr, "kernel_launch: occupancy query says %d blocks/CU\n", per_cu); per_cu = 1; }
    grid_blocks = cus;
  }
  if (grid_blocks < 0) return;
  Params p{};
  p.x_p = (const float*)d_in[0]; p.x_s = (const float*)d_in[1]; p.p_p = (const float*)d_in[2]; p.p_s = (const float*)d_in[3];
  p.cache_k = (const float*)d_in[4]; p.cache_v = (const float*)d_in[5]; p.cache_conv = (const float*)d_in[6];
  p.g_mix = (const float*)d_in[7]; p.w_in = (const float*)d_in[8]; p.conv_w = (const float*)d_in[9]; p.w_ao = (const float*)d_in[10];
  p.w_co = (const float*)d_in[11]; p.w_o = (const float*)d_in[12]; p.g_ffn = (const float*)d_in[13]; p.w_up = (const float*)d_in[14];
  p.w_dn = (const float*)d_in[15]; p.g_ple = (const float*)d_in[16]; p.w_pg = (const float*)d_in[17]; p.w_pl = (const float*)d_in[18];
  p.g_final = (const float*)d_in[19];
  p.out = (float*)d_out; p.ws = (unsigned char*)d_ws;
  void* args[] = {&p};
  hipError_t e = hipLaunchCooperativeKernel((const void*)fwd_megakernel, dim3(grid_blocks), dim3(512), args, SHM_B, stream);
  if (e != hipSuccess) fprintf(stderr, "cooperative launch failed: %s (grid %d)\n", hipGetErrorString(e), grid_blocks);
}
```

```cpp
#include <hip/hip_runtime.h>
#include <hip/hip_cooperative_groups.h>
#include <cstdio>
#include <cstdint>
namespace cg = cooperative_groups;

#define DI __device__ __forceinline__
typedef unsigned short bf16_t;
typedef short bf16x8 __attribute__((ext_vector_type(8)));
typedef float f32x4 __attribute__((ext_vector_type(4)));
typedef float f32x2 __attribute__((ext_vector_type(2)));
typedef float f32x16 __attribute__((ext_vector_type(16)));
typedef unsigned u32x4 __attribute__((ext_vector_type(4)));
typedef unsigned u32x2 __attribute__((ext_vector_type(2)));
typedef __bf16 bf16v2 __attribute__((ext_vector_type(2)));

constexpr int D = 1024, NPROJ = 5120, MP = 32768, MS = 1024, M = MP + MS, SEQ = 8192, DSEQ = 32, PAST = 2048;
constexpr int NH = 8, HD = 64, SBW = 512, CW = 512, PLE = 256, DFF = 4096, P4W = 4096;
constexpr float EPS = 1e-6f;
constexpr size_t O_Y = 0, O_KP = (size_t)M * D, O_VP = O_KP + (size_t)MP * SBW, O_CP = O_VP + (size_t)MP * SBW,
                 O_KS = O_CP + 4 * 2 * CW, O_VS = O_KS + (size_t)MS * SBW, O_CS = O_VS + (size_t)MS * SBW;
constexpr size_t W_IN = 0, W_AO = W_IN + (size_t)NPROJ * D * 2, W_CO = W_AO + (size_t)D * SBW * 2, W_O = W_CO + (size_t)D * CW * 2,
                 W_UP = W_O + (size_t)D * D * 2, W_DN = W_UP + (size_t)DFF * D * 2, W_PG = W_DN + (size_t)D * DFF * 2,
                 W_PL = W_PG + (size_t)D * D * 2, W_RS0 = W_PL + (size_t)D * PLE * 2, W_SS = W_RS0 + (size_t)M * 4,
                 W_PB = W_SS + (size_t)3 * M * 4, W_RA = W_PB + (size_t)M * PLE * 2, W_RB = W_RA + (size_t)M * D * 2,
                 W_RC = W_RB + (size_t)M * D * 2, W_END = W_RC + (size_t)M * P4W * 2;

struct Params {
  const float *x_p, *x_s, *p_p, *p_s, *cache_k, *cache_v, *cache_conv;
  const float *g_mix, *w_in, *conv_w, *w_ao, *w_co, *w_o, *g_ffn, *w_up, *w_dn, *g_ple, *w_pg, *w_pl, *g_final;
  float* out; unsigned char* ws;
};

extern __shared__ __attribute__((aligned(16))) unsigned char dyn_lds[];

DI unsigned pk2(float lo, float hi) { f32x2 f = {lo, hi}; bf16v2 b = __builtin_convertvector(f, bf16v2); return __builtin_bit_cast(unsigned, b); }
DI float bf2f(unsigned h16) { return __uint_as_float(h16 << 16); }
DI float bflo(unsigned u) { return __uint_as_float(u << 16); }
DI float bfhi(unsigned u) { return __uint_as_float(u & 0xffff0000u); }
DI bf16x8 cvt8(f32x4 a, f32x4 b) { u32x4 u = {pk2(a.x, a.y), pk2(a.z, a.w), pk2(b.x, b.y), pk2(b.z, b.w)}; return __builtin_bit_cast(bf16x8, u); }
DI float sigmoidf_(float v) { return 1.f / (1.f + __expf(-v)); }
DI float wave_sum(float v) {
#pragma unroll
  for (int o = 1; o < 64; o <<= 1) v += __shfl_xor(v, o);
  return v;
}

constexpr int BM = 256, BK = 64, HALF = 128, NXCD = 8, WGM = 8, HT = HALF * BK, SHM_B = 8 * HT * 2;
DI int lds_byte(int r, int c) { int st = (r >> 4) * 2 + (c >> 5), rr = r & 15, cc = c & 31, ob = rr * 64 + cc * 2; return st * 1024 + (ob ^ (((ob >> 9) & 1) << 5)); }
DI void stage_rc(int b, int& R, int& C) { int st = b / 1024, sb = b % 1024, swz = sb ^ (((sb >> 9) & 1) << 5); R = (st >> 1) * 16 + swz / 64; C = (st & 1) * 32 + (swz % 64) / 2; }

DI bool tile_order(int i, int G, int c, int nM, int nN, int& pm, int& pn) {
  const int nwg = nM * nN; const long L = (long)i * G + c; if (L >= nwg) return false;
  int wgid = (int)L; { const int q = nwg / NXCD, r = nwg % NXCD, xcd = wgid % NXCD, off = wgid / NXCD; wgid = (xcd < r ? xcd * (q + 1) : r * (q + 1) + (xcd - r) * q) + off; }
  const int nig = WGM * nN, gid = wgid / nig, fm = gid * WGM, gsz = (nM - fm) < WGM ? (nM - fm) : WGM;
  pm = fm + ((wgid % nig) % gsz); pn = (wgid % nig) / gsz; return true;
}

typedef f32x4 acc_t[2][2][4][2];
DI void gemm_kloop(const bf16_t* __restrict__ A, const bf16_t* __restrict__ Bt, const int K, const int brow, const int bcol, acc_t& acc) {
  bf16_t* shm = (bf16_t*)dyn_lds;
  int tid = threadIdx.x; asm volatile("" : "+v"(tid));
#define SA(b, h) (shm + ((b) * 2 + (h)) * HT)
#define SB(b, h) (shm + (4 + (b) * 2 + (h)) * HT)
#define STAGE(P, BASE, br, kt) do { const char* _ub = (const char*)(BASE) + ((size_t)(br) * K + (size_t)(kt) * BK) * 2; \
    __builtin_amdgcn_global_load_lds((const unsigned*)(_ub + voff0), (unsigned*)((char*)(P) + wbase), 16, 0, 0); \
    __builtin_amdgcn_global_load_lds((const unsigned*)(_ub + voff1), (unsigned*)((char*)(P) + wbase + 8192), 16, 0, 0); } while (0)
#define LDA(dst, b, h) for (int m = 0; m < 4; ++m) for (int k = 0; k < 2; ++k) \
    dst[m][k] = *reinterpret_cast<const bf16x8*>((char*)SA(b, h) + lds_byte(wr * 64 + m * 16 + fr, k * 32 + fq * 8))
#define LDB(dst, b, h) for (int n = 0; n < 2; ++n) for (int k = 0; k < 2; ++k) \
    dst[n][k] = *reinterpret_cast<const bf16x8*>((char*)SB(b, h) + lds_byte(wc * 32 + n * 16 + fr, k * 32 + fq * 8))
#define MMA(ai, bj, At_, Bt_) do { __builtin_amdgcn_s_setprio(1); \
    for (int m = 0; m < 4; ++m) for (int n = 0; n < 2; ++n) for (int k = 0; k < 2; ++k) \
      acc[ai][bj][m][n] = __builtin_amdgcn_mfma_f32_16x16x32_bf16(Bt_[n][k], At_[m][k], acc[ai][bj][m][n], 0, 0, 0); \
    __builtin_amdgcn_s_setprio(0); } while (0)
#define WAIT_V(n) asm volatile("s_waitcnt vmcnt(" #n ")" ::: "memory")
#define WAIT_L(n) asm volatile("s_waitcnt lgkmcnt(" #n ")" ::: "memory")
#define BAR __builtin_amdgcn_s_barrier()
#define SCHED __builtin_amdgcn_sched_barrier(0)
  const int wid = tid >> 6, lane = tid & 63, wr = wid >> 2, wc = wid & 3, fr = lane & 15, fq = lane >> 4;
  bf16x8 At[4][2], B0[2][2], B1[2][2];
  const int nt = K / BK;
  const int wbase = __builtin_amdgcn_readfirstlane((tid & ~63) * 16);
  unsigned voff0, voff1;
  { int r_, c_; stage_rc(tid * 16, r_, c_); voff0 = (unsigned)(r_ * K + c_) * 2u; stage_rc(tid * 16 + 8192, r_, c_); voff1 = (unsigned)(r_ * K + c_) * 2u; }
  STAGE(SB(0, 0), Bt, bcol, 0); STAGE(SA(0, 0), A, brow, 0);
  STAGE(SB(0, 1), Bt, bcol + HALF, 0); STAGE(SA(0, 1), A, brow + HALF, 0);
  if (wr == 1) BAR;
  WAIT_V(4); BAR;
  STAGE(SB(1, 0), Bt, bcol, 1); STAGE(SA(1, 0), A, brow, 1); STAGE(SB(1, 1), Bt, bcol + HALF, 1);
  WAIT_V(6); BAR;
  for (int t = 0; t < nt - 2; t += 2) {
    LDB(B0, 0, 0); SCHED; LDA(At, 0, 0); STAGE(SA(1, 1), A, brow + HALF, t + 1);
    WAIT_L(8); BAR; WAIT_L(0); MMA(0, 0, At, B0); BAR; SCHED;
    LDB(B1, 0, 1); STAGE(SB(0, 0), Bt, bcol, t + 2);
    BAR; WAIT_L(0); MMA(0, 1, At, B1); BAR;
    LDA(At, 0, 1); STAGE(SA(0, 0), A, brow, t + 2);
    BAR; WAIT_L(0); MMA(1, 0, At, B0); BAR; SCHED;
    STAGE(SB(0, 1), Bt, bcol + HALF, t + 2);
    WAIT_V(6); BAR; MMA(1, 1, At, B1); BAR;
    LDB(B0, 1, 0); SCHED; LDA(At, 1, 0); STAGE(SA(0, 1), A, brow + HALF, t + 2);
    WAIT_L(8); BAR; WAIT_L(0); MMA(0, 0, At, B0); BAR; SCHED;
    LDB(B1, 1, 1); STAGE(SB(1, 0), Bt, bcol, t + 3);
    BAR; WAIT_L(0); MMA(0, 1, At, B1); BAR;
    LDA(At, 1, 1); STAGE(SA(1, 0), A, brow, t + 3);
    BAR; WAIT_L(0); MMA(1, 0, At, B0); BAR; SCHED;
    STAGE(SB(1, 1), Bt, bcol + HALF, t + 3);
    WAIT_V(6); BAR; MMA(1, 1, At, B1); BAR;
  }
  { LDB(B0, 0, 0); LDA(At, 0, 0); STAGE(SA(1, 1), A, brow + HALF, nt - 1);
    BAR; WAIT_L(0); MMA(0, 0, At, B0); BAR;
    LDB(B1, 0, 1); BAR; WAIT_L(0); MMA(0, 1, At, B1); BAR;
    LDA(At, 0, 1); WAIT_V(4); BAR; WAIT_L(0); MMA(1, 0, At, B0); MMA(1, 1, At, B1); BAR; }
  { LDB(B0, 1, 0); LDA(At, 1, 0); WAIT_V(2); BAR; WAIT_L(0); MMA(0, 0, At, B0); BAR;
    LDB(B1, 1, 1); WAIT_V(0); BAR; WAIT_L(0); MMA(0, 1, At, B1); BAR;
    LDA(At, 1, 1); BAR; WAIT_L(0); MMA(1, 0, At, B0); MMA(1, 1, At, B1); BAR; }
  if (wr == 0) BAR;
}
template <class F>
DI void epi_call(acc_t& acc, const int brow, const int bcol, const F& f) {
  int tid2 = threadIdx.x, brow2 = brow, bcol2 = bcol;
  asm volatile("" : "+v"(tid2), "+s"(brow2), "+s"(bcol2));
  const int wid2 = tid2 >> 6, lane2 = tid2 & 63;
  f(acc, brow2, bcol2, wid2 >> 2, wid2 & 3, lane2 & 15, lane2 >> 4);
}
template <class Epi>
DI void gemm_tile(const bf16_t* __restrict__ A, const bf16_t* __restrict__ Bt, const int K, const int brow, const int bcol, const Epi& epi) {
  acc_t acc = {};
  gemm_kloop(A, Bt, K, brow, bcol, acc);
  epi_call(acc, brow, bcol, epi);
}

template <class Epi>
DI void gemm_phase(const bf16_t* A, const bf16_t* Bt, int Mrows, int N, int K, const Epi& epi) {
  const int nM = Mrows / BM, nN = N / BM;
  for (int i = 0;; ++i) {
    int pm, pn; if (!tile_order(i, gridDim.x, blockIdx.x, nM, nN, pm, pn)) break;
    gemm_tile(A, Bt, K, pm * BM, pn * BM, epi);
  }
}

DI void st_bf16x4(bf16_t* p, f32x4 v) { u32x2 u = {pk2(v.x, v.y), pk2(v.z, v.w)}; *(u32x2*)p = u; }
DI f32x4 ld_bf16x4(const bf16_t* p) { u32x2 u = *(const u32x2*)p; f32x4 v = {bflo(u.x), bfhi(u.x), bflo(u.y), bfhi(u.y)}; return v; }

#define EPI_ROWS for (int ai = 0; ai < 2; ++ai) for (int m = 0; m < 4; ++m)
#define EPI_COLS for (int bj = 0; bj < 2; ++bj) for (int n = 0; n < 2; ++n)
#define EPI_BJ for (int bj = 0; bj < 2; ++bj)
#define EPI_ROW (brow + ai * HALF + wr * 64 + m * 16 + fr)
#define EPI_COL (bcol + bj * HALF + wc * 32 + n * 16 + fq * 4)
#define EPI_COL8 (bcol + bj * HALF + wc * 32 + fq * 8)
DI void st_bf16x8(bf16_t* p, f32x4 a, f32x4 b) { u32x4 u = {pk2(a.x, a.y), pk2(a.z, a.w), pk2(b.x, b.y), pk2(b.z, b.w)}; *(u32x4*)p = u; }
DI void unpack8(const u32x4 u, f32x4& a, f32x4& b) { a = (f32x4){bflo(u.x), bfhi(u.x), bflo(u.y), bfhi(u.y)}; b = (f32x4){bflo(u.z), bfhi(u.z), bflo(u.w), bfhi(u.w)}; }

struct EpiIn {
  const float* rs0; bf16_t* proj4; float* out;
  DI void operator()(const acc_t& acc, int brow, int bcol, int wr, int wc, int fr, int fq) const {
    float rr[2][4];
#pragma unroll
    EPI_ROWS rr[ai][m] = rs0[EPI_ROW];
    if (bcol >= 512 && bcol < 1536) {
#pragma unroll
      EPI_ROWS { const int row = EPI_ROW; const float r = rr[ai][m];
#pragma unroll
        EPI_COLS { const int col = EPI_COL; f32x4 v = acc[ai][bj][m][n] * r;
          const int isv = bcol >= 1024; const int c = col - (isv ? 1024 : 512);
          float* dst = (row < MP) ? out + (isv ? O_VP : O_KP) + (size_t)row * SBW + c : out + (isv ? O_VS : O_KS) + (size_t)(row - MP) * SBW + c;
          *(f32x4*)dst = v; } }
    } else if (bcol < 2048) {
      const float sc = (bcol < 512) ? 0.125f : 1.f; const int sh = (bcol < 512) ? 0 : 1024;
#pragma unroll
      EPI_ROWS { const int row = EPI_ROW; const float r = rr[ai][m] * sc;
#pragma unroll
        EPI_BJ { st_bf16x8(proj4 + (size_t)row * P4W + (EPI_COL8 - sh), acc[ai][bj][m][0] * r, acc[ai][bj][m][1] * r); } }
    } else {
      const bool gate = bcol >= 3072; const int t = ((bcol - (gate ? 3072 : 2048)) >> 8) * 128;
#pragma unroll
      EPI_ROWS { const int row = EPI_ROW; const float r = rr[ai][m]; const int ch = t + wc * 32 + fq * 8;
        const f32x4 a0 = acc[ai][0][m][0] * r, a1 = acc[ai][0][m][1] * r, b0 = acc[ai][1][m][0] * r, b1 = acc[ai][1][m][1] * r;
        if (!gate) { st_bf16x8(proj4 + (size_t)row * P4W + 1024 + ch, a0 * b0, a1 * b1); }
        else { f32x4 rho0, rho1, sg0, sg1;
#pragma unroll
          for (int e = 0; e < 4; ++e) {
            { const float ea = __expf(-a0[e]), eb = __expf(-fmaxf(b0[e], -80.f)); sg0[e] = 1.f / (1.f + eb); rho0[e] = (1.f + eb) / (1.f + ea); }
            { const float ea = __expf(-a1[e]), eb = __expf(-fmaxf(b1[e], -80.f)); sg1[e] = 1.f / (1.f + eb); rho1[e] = (1.f + eb) / (1.f + ea); } }
          st_bf16x8(proj4 + (size_t)row * P4W + 2048 + ch, rho0, rho1); st_bf16x8(proj4 + (size_t)row * P4W + 3072 + ch, sg0, sg1); } }
    }
  }
};
template <bool FINAL>
struct EpiGate {
  const bf16_t* proj4; int off; bf16_t* merged;
  DI void operator()(acc_t& acc, int brow, int bcol, int wr, int wc, int fr, int fq) const {
    u32x4 g[2][4][2];
#pragma unroll
    EPI_ROWS { const int row = EPI_ROW;
#pragma unroll
      EPI_BJ g[ai][m][bj] = *(const u32x4*)(proj4 + (size_t)row * P4W + off + EPI_COL8); }
#pragma unroll
    EPI_ROWS { const int row = EPI_ROW;
#pragma unroll
      EPI_BJ { f32x4 g0, g1; unpack8(g[ai][m][bj], g0, g1);
        if (FINAL) st_bf16x8(merged + (size_t)row * D + EPI_COL8, acc[ai][bj][m][0] * g0, acc[ai][bj][m][1] * g1);
        else { acc[ai][bj][m][0] *= g0; acc[ai][bj][m][1] *= g1; } } }
  }
};
template <int MODE>
struct EpiRes {
  const float *x_p, *x_s; const bf16_t* resb; bf16_t* outb; float* ss; const float* ssprev; const bf16_t* pe;
  DI void operator()(const acc_t& acc, int brow, int bcol, int wr, int wc, int fr, int fq) const {
#pragma unroll
    for (int ai = 0; ai < 2; ++ai) {
      f32x4 resf[4][2][2]; u32x4 resh[4][2], peh[4][2]; float rr[4];
#pragma unroll
      for (int m = 0; m < 4; ++m) { const int row = EPI_ROW;
        if (MODE == 2) rr[m] = ssprev[row];
#pragma unroll
        EPI_BJ { const int col = EPI_COL8;
          if (MODE == 0) { const float* xp = (row < MP) ? x_p + (size_t)row * D + col : x_s + (size_t)(row - MP) * D + col;
            resf[m][bj][0] = *(const f32x4*)xp; resf[m][bj][1] = *(const f32x4*)(xp + 4); }
          else resh[m][bj] = *(const u32x4*)(resb + (size_t)row * D + col);
          if (MODE == 2) peh[m][bj] = *(const u32x4*)(pe + (size_t)row * D + col); } }
#pragma unroll
      for (int m = 0; m < 4; ++m) { const int row = EPI_ROW; float part = 0.f; float r = 0.f;
        if (MODE == 2) r = rsqrtf(rr[m] * (1.f / D) + EPS);
#pragma unroll
        EPI_BJ { const int col = EPI_COL8; f32x4 a0 = acc[ai][bj][m][0], a1 = acc[ai][bj][m][1]; f32x4 r0, r1;
          if (MODE == 0) { r0 = resf[m][bj][0]; r1 = resf[m][bj][1]; } else unpack8(resh[m][bj], r0, r1);
          if (MODE == 2) { f32x4 e0, e1; unpack8(peh[m][bj], e0, e1); a0 = a0 * r; a1 = a1 * r;
            const f32x4 s0 = {sigmoidf_(a0.x), sigmoidf_(a0.y), sigmoidf_(a0.z), sigmoidf_(a0.w)}, s1 = {sigmoidf_(a1.x), sigmoidf_(a1.y), sigmoidf_(a1.z), sigmoidf_(a1.w)};
            a0 = s0 * e0; a1 = s1 * e1; }
          const f32x4 o0 = r0 + a0, o1 = r1 + a1;
          st_bf16x8(outb + (size_t)row * D + col, o0, o1);
          part += (o0.x * o0.x + o0.y * o0.y + o0.z * o0.z + o0.w * o0.w) + (o1.x * o1.x + o1.y * o1.y + o1.z * o1.z + o1.w * o1.w); }
        part += __shfl_xor(part, 16); part += __shfl_xor(part, 32);
        if (fq == 0) atomicAdd(ss + row, part); }
    }
  }
};
struct EpiUp {
  const float* ss1; bf16_t* u;
  DI void operator()(const acc_t& acc, int brow, int bcol, int wr, int wc, int fr, int fq) const {
    float rr[2][4];
#pragma unroll
    EPI_ROWS rr[ai][m] = ss1[EPI_ROW];
#pragma unroll
    EPI_ROWS { const int row = EPI_ROW; const float r = rsqrtf(rr[ai][m] * (1.f / D) + EPS);
#pragma unroll
      EPI_BJ { f32x4 a0 = acc[ai][bj][m][0] * r, a1 = acc[ai][bj][m][1] * r;
        const f32x4 z0 = {fmaxf(a0.x, 0.f), fmaxf(a0.y, 0.f), fmaxf(a0.z, 0.f), fmaxf(a0.w, 0.f)}, z1 = {fmaxf(a1.x, 0.f), fmaxf(a1.y, 0.f), fmaxf(a1.z, 0.f), fmaxf(a1.w, 0.f)};
        st_bf16x8(u + (size_t)row * DFF + EPI_COL8, z0 * z0, z1 * z1); } }
  }
};
struct EpiPe {
  bf16_t* pe;
  DI void operator()(const acc_t& acc, int brow, int bcol, int wr, int wc, int fr, int fq) const {
#pragma unroll
    EPI_ROWS { const int row = EPI_ROW;
#pragma unroll
      EPI_BJ { st_bf16x8(pe + (size_t)row * D + EPI_COL8, acc[ai][bj][m][0], acc[ai][bj][m][1]); } }
  }
};

DI int win_perm(int n) {
  if (n < 2048) return n;
  if (n < 3072) { const int r = n - 2048, c = r & 511; return 2048 + 256 * (c >> 7) + ((r >> 9) ? 128 : 0) + (c & 127); }
  const int r = n - 3072, c = r & 1023; return 3072 + 256 * (c >> 7) + ((r >> 10) ? 128 : 0) + (c & 127);
}
template <bool PERM>
DI void transpose_item(const float* __restrict__ W, const float* __restrict__ g, int K, int N, bf16_t* __restrict__ WT, float* scr, int item, int lane) {
  const int nblk = N / 32, kb = item / nblk, nb = item % nblk, k0 = 64 * kb, n0 = 32 * nb;
  const int n0d = PERM ? win_perm(n0) : n0;
  const bool p32 = !(PERM && n0 >= 512 && n0 < 1536);
#pragma unroll 8
  for (int i = 0; i < 32; ++i) { const int kk = 2 * i + (lane >> 5); float w = W[(size_t)(k0 + kk) * N + n0 + (lane & 31)]; if (g) w *= g[k0 + kk]; scr[kk * 33 + (lane & 31)] = w; }
  asm volatile("s_waitcnt lgkmcnt(0)" ::: "memory");
  const int c = lane & 7;
#pragma unroll
  for (int j = 0; j < 4; ++j) { const int n = (lane >> 3) + 8 * j; const int ns = p32 ? (8 * ((n & 15) >> 2) + 4 * (n >> 4) + (n & 3)) : n; const float* s = scr + (8 * c) * 33 + ns;
    u32x4 o = {pk2(s[0 * 33], s[1 * 33]), pk2(s[2 * 33], s[3 * 33]), pk2(s[4 * 33], s[5 * 33]), pk2(s[6 * 33], s[7 * 33])};
    *(u32x4*)(WT + (size_t)(n0d + n) * K + k0 + 8 * c) = o; }
  asm volatile("s_waitcnt lgkmcnt(0)" ::: "memory");
}

#define MFMA32(a, b, c) __builtin_amdgcn_mfma_f32_32x32x16_bf16((a), (b), (c), 0, 0, 0)
DI void attn_task(const Params& p, int task, int lane) {
  const bf16_t* proj4 = (const bf16_t*)(p.ws + W_RC);
  bf16_t* attn = (bf16_t*)(p.ws + W_RB);
  const int qb = task >> 3, h = task & 7, i = lane & 31, half = lane >> 5;
  int qtok0, nblk; const float *k0p, *v0p, *k1p, *v1p;
  if (qb < MP / 32) { const int b = qb >> 8, t0 = (qb & 255) * 32; qtok0 = b * SEQ + t0; nblk = (t0 >> 5) + 1;
    k0p = p.out + O_KP + (size_t)qtok0 * SBW; v0p = p.out + O_VP + (size_t)qtok0 * SBW; k1p = k0p; v1p = v0p; }
  else { const int b = qb - MP / 32; qtok0 = MP + b * DSEQ; nblk = 1 + PAST / 32;
    k0p = p.out + O_KS + (size_t)(b * DSEQ) * SBW; v0p = p.out + O_VS + (size_t)(b * DSEQ) * SBW;
    k1p = p.cache_k + (size_t)(b * PAST + PAST) * SBW; v1p = p.cache_v + (size_t)(b * PAST + PAST) * SBW; }
  bf16x8 qf[4];
  { const bf16_t* qp = proj4 + (size_t)(qtok0 + i) * P4W + h * HD + 8 * half;
#pragma unroll
    for (int s = 0; s < 4; ++s) qf[s] = *(const bf16x8*)(qp + 16 * s); }
  f32x16 o0 = {}, o1 = {};
  float C = 0.f;
  for (int it = 0; it < nblk; ++it) {
    const float* Kp = (it == 0 ? k0p : k1p - (size_t)it * 32 * SBW) + h * HD;
    const float* Vp = (it == 0 ? v0p : v1p - (size_t)it * 32 * SBW) + h * HD;
    f32x16 sacc = {};
#pragma unroll
    for (int s = 0; s < 4; ++s) { const f32x4* kp = (const f32x4*)(Kp + (size_t)i * SBW + 16 * s + 8 * half);
      sacc = MFMA32(cvt8(kp[0], kp[1]), qf[s], sacc); }
    float vv[2][2][8];
#pragma unroll
    for (int s = 0; s < 2; ++s)
#pragma unroll
      for (int jj = 0; jj < 8; ++jj) { const int key = 16 * s + 8 * (jj >> 2) + 4 * half + (jj & 3);
        vv[s][0][jj] = Vp[(size_t)key * SBW + i]; vv[s][1][jj] = Vp[(size_t)key * SBW + 32 + i]; }
    float lm[16], lp[16];
#pragma unroll
    for (int r = 0; r < 16; ++r) { const float z = sacc[r]; const int key = (r & 3) + 8 * (r >> 2) + 4 * half;
      const float sp = fmaxf(z, 0.f) + __logf(1.f + __expf(-fabsf(z)));
      const bool valid = (it != 0) || (key < i);
      lm[r] = valid ? -sp : 0.f; lp[r] = valid ? (z - sp) : -1e30f; }
    float G[4], Pn[4];
#pragma unroll
    for (int g = 0; g < 4; ++g) { G[g] = (lm[4 * g] + lm[4 * g + 1]) + (lm[4 * g + 2] + lm[4 * g + 3]); Pn[g] = __shfl_xor(G[g], 32); }
    float run = C; float a[16];
#pragma unroll
    for (int g = 3; g >= 0; --g) { float t = half ? run : run + Pn[g];
#pragma unroll
      for (int u = 3; u >= 0; --u) { a[4 * g + u] = __expf(lp[4 * g + u] + t); t += lm[4 * g + u]; }
      run += G[g] + Pn[g]; }
    C = run;
#pragma unroll
    for (int s = 0; s < 2; ++s) {
      u32x4 pu = {pk2(a[8 * s], a[8 * s + 1]), pk2(a[8 * s + 2], a[8 * s + 3]), pk2(a[8 * s + 4], a[8 * s + 5]), pk2(a[8 * s + 6], a[8 * s + 7])};
      const bf16x8 pf = __builtin_bit_cast(bf16x8, pu);
      u32x4 v0 = {pk2(vv[s][0][0], vv[s][0][1]), pk2(vv[s][0][2], vv[s][0][3]), pk2(vv[s][0][4], vv[s][0][5]), pk2(vv[s][0][6], vv[s][0][7])};
      u32x4 v1 = {pk2(vv[s][1][0], vv[s][1][1]), pk2(vv[s][1][2], vv[s][1][3]), pk2(vv[s][1][4], vv[s][1][5]), pk2(vv[s][1][6], vv[s][1][7])};
      o0 = MFMA32(__builtin_bit_cast(bf16x8, v0), pf, o0);
      o1 = MFMA32(__builtin_bit_cast(bf16x8, v1), pf, o1); }
    if (__all(C < -104.f)) break;
  }
  bf16_t* op = attn + (size_t)(qtok0 + i) * SBW + h * HD + 4 * half;
#pragma unroll
  for (int g = 0; g < 4; ++g) {
    f32x4 a0 = {o0[4 * g], o0[4 * g + 1], o0[4 * g + 2], o0[4 * g + 3]}; st_bf16x4(op + 8 * g, a0);
    f32x4 a1 = {o1[4 * g], o1[4 * g + 1], o1[4 * g + 2], o1[4 * g + 3]}; st_bf16x4(op + 32 + 8 * g, a1); }
}

DI void conv_items(const Params& p) {
  const bf16_t* proj4 = (const bf16_t*)(p.ws + W_RC);
  bf16_t* convg = (bf16_t*)(p.ws + W_RB) + (size_t)M * SBW;
  const int total = M * (CW / 8);
  for (int idx = blockIdx.x * blockDim.x + threadIdx.x; idx < total; idx += gridDim.x * blockDim.x) {
    const int tok = idx >> 6, c0 = (idx & 63) * 8;
    int b, t, T; const float* buf; float* nb;
    if (tok < MP) { b = tok >> 13; t = tok & (SEQ - 1); T = SEQ; buf = nullptr; nb = p.out + O_CP + (size_t)b * 2 * CW; }
    else { const int s = tok - MP; b = s >> 5; t = s & (DSEQ - 1); T = DSEQ; buf = p.cache_conv + (size_t)b * 2 * CW; nb = p.out + O_CS + (size_t)b * 2 * CW; }
    const bf16_t* row = proj4 + (size_t)tok * P4W + c0;
    float u0[8], u1[8], u2[8], cbv[8];
    { const u32x4 x = *(const u32x4*)(row + 1024), bb = *(const u32x4*)(row + 512);
#pragma unroll
      for (int e = 0; e < 4; ++e) { u0[2 * e] = bflo(x[e]); u0[2 * e + 1] = bfhi(x[e]); cbv[2 * e] = bflo(bb[e]); cbv[2 * e + 1] = bfhi(bb[e]); } }
    if (t >= 1) { const u32x4 x = *(const u32x4*)(row - P4W + 1024);
#pragma unroll
      for (int e = 0; e < 4; ++e) { u1[2 * e] = bflo(x[e]); u1[2 * e + 1] = bfhi(x[e]); } }
    else {
#pragma unroll
      for (int e = 0; e < 8; ++e) u1[e] = buf ? buf[CW + c0 + e] : 0.f; }
    if (t >= 2) { const u32x4 x = *(const u32x4*)(row - 2 * P4W + 1024);
#pragma unroll
      for (int e = 0; e < 4; ++e) { u2[2 * e] = bflo(x[e]); u2[2 * e + 1] = bfhi(x[e]); } }
    else {
#pragma unroll
      for (int e = 0; e < 8; ++e) u2[e] = buf ? buf[t * CW + c0 + e] : 0.f; }
    float o[8];
#pragma unroll
    for (int e = 0; e < 8; ++e) { const int c = c0 + e; o[e] = cbv[e] * (p.conv_w[c] * u2[e] + p.conv_w[CW + c] * u1[e] + p.conv_w[2 * CW + c] * u0[e]); }
    u32x4 ov = {pk2(o[0], o[1]), pk2(o[2], o[3]), pk2(o[4], o[5]), pk2(o[6], o[7])};
    *(u32x4*)(convg + (size_t)tok * CW + c0) = ov;
    if (t >= T - 2) { float* d = nb + (size_t)(t - (T - 2)) * CW + c0;
#pragma unroll
      for (int e = 0; e < 8; ++e) d[e] = u0[e]; }
  }
}

__global__ void __launch_bounds__(512, 2) fwd_megakernel(Params p) {
  cg::grid_group grid = cg::this_grid();
  const int lane = threadIdx.x & 63, wave = threadIdx.x >> 6;
  const int gw = blockIdx.x * 8 + wave, NGW = gridDim.x * 8;
  const int gtid = blockIdx.x * blockDim.x + threadIdx.x, NT = gridDim.x * blockDim.x;
  unsigned char* ws = p.ws;
  bf16_t *wInT = (bf16_t*)(ws + W_IN), *wAoT = (bf16_t*)(ws + W_AO), *wCoT = (bf16_t*)(ws + W_CO), *wOT = (bf16_t*)(ws + W_O),
         *wUpT = (bf16_t*)(ws + W_UP), *wDnT = (bf16_t*)(ws + W_DN), *wPgT = (bf16_t*)(ws + W_PG), *wPlT = (bf16_t*)(ws + W_PL);
  float* rs0 = (float*)(ws + W_RS0); float* ss = (float*)(ws + W_SS);
  bf16_t *pb = (bf16_t*)(ws + W_PB), *RA = (bf16_t*)(ws + W_RA), *RB = (bf16_t*)(ws + W_RB), *RC = (bf16_t*)(ws + W_RC);
  float* y = p.out + O_Y;

  {
    float* scr = (float*)dyn_lds + wave * (64 * 33);
    constexpr int I0 = (D / 64) * (NPROJ / 32), I1 = (SBW / 64) * (D / 32), I2 = I1, I3 = (D / 64) * (D / 32), I4 = (D / 64) * (DFF / 32),
                  I5 = (DFF / 64) * (D / 32), I6 = I3, I7 = (PLE / 64) * (D / 32), NI = I0 + I1 + I2 + I3 + I4 + I5 + I6 + I7;
    for (int it = gw; it < NI; it += NGW) {
      int r = it;
      if (r < I0) { transpose_item<true>(p.w_in, p.g_mix, D, NPROJ, wInT, scr, r, lane); continue; } r -= I0;
      if (r < I1) { transpose_item<false>(p.w_ao, nullptr, SBW, D, wAoT, scr, r, lane); continue; } r -= I1;
      if (r < I2) { transpose_item<false>(p.w_co, nullptr, CW, D, wCoT, scr, r, lane); continue; } r -= I2;
      if (r < I3) { transpose_item<false>(p.w_o, nullptr, D, D, wOT, scr, r, lane); continue; } r -= I3;
      if (r < I4) { transpose_item<false>(p.w_up, p.g_ffn, D, DFF, wUpT, scr, r, lane); continue; } r -= I4;
      if (r < I5) { transpose_item<false>(p.w_dn, nullptr, DFF, D, wDnT, scr, r, lane); continue; } r -= I5;
      if (r < I6) { transpose_item<false>(p.w_pg, p.g_ple, D, D, wPgT, scr, r, lane); continue; } r -= I6;
      transpose_item<false>(p.w_pl, nullptr, PLE, D, wPlT, scr, r, lane);
    }
    for (int row = gw; row < M; row += NGW) {
      const float* xr = (row < MP) ? p.x_p + (size_t)row * D : p.x_s + (size_t)(row - MP) * D;
      const f32x4* x4 = (const f32x4*)xr + lane; f32x4 v[4]; float s = 0.f;
#pragma unroll
      for (int j = 0; j < 4; ++j) { v[j] = x4[64 * j]; s += (v[j].x * v[j].x + v[j].y * v[j].y) + (v[j].z * v[j].z + v[j].w * v[j].w); }
      s = wave_sum(s);
      if (lane == 0) rs0[row] = rsqrtf(s * (1.f / D) + EPS);
      u32x2* o8 = (u32x2*)(RA + (size_t)row * D) + lane;
#pragma unroll
      for (int j = 0; j < 4; ++j) { u32x2 o = {pk2(v[j].x, v[j].y), pk2(v[j].z, v[j].w)}; o8[64 * j] = o; }
    }
    for (int idx = gtid; idx < M * PLE / 4; idx += NT) {
      const size_t e = (size_t)idx * 4; const float* src = (e < (size_t)MP * PLE) ? p.p_p + e : p.p_s + (e - (size_t)MP * PLE);
      f32x4 v = *(const f32x4*)src; st_bf16x4(pb + e, v);
    }
    for (int idx = gtid; idx < 3 * M; idx += NT) ss[idx] = 0.f;
  }
  grid.sync();
  { EpiIn e{rs0, RC, p.out}; gemm_phase(RA, wInT, M, NPROJ, D, e); }
  grid.sync();
  for (int task = gw; task < (M / 32) * NH; task += NGW) attn_task(p, task, lane);
  conv_items(p);
  grid.sync();
  {
    const int nM = M / BM, nN = D / BM;
    for (int i = 0;; ++i) { int pm, pn; if (!tile_order(i, gridDim.x, blockIdx.x, nM, nN, pm, pn)) break;
      acc_t acc = {};
      gemm_kloop(RB, wAoT, SBW, pm * BM, pn * BM, acc);
      { EpiGate<false> e{RC, 2048, nullptr}; epi_call(acc, pm * BM, pn * BM, e); }
      gemm_kloop(RB + (size_t)M * SBW, wCoT, CW, pm * BM, pn * BM, acc);
      { EpiGate<true> e{RC, 3072, RA}; epi_call(acc, pm * BM, pn * BM, e); } }
  }
  grid.sync();
  { EpiRes<0> e{p.x_p, p.x_s, nullptr, RB, ss, nullptr, nullptr}; gemm_phase(RA, wOT, M, D, D, e); }
  grid.sync();
  { EpiUp e{ss, RC}; gemm_phase(RB, wUpT, M, DFF, D, e); }
  grid.sync();
  { EpiRes<1> e{nullptr, nullptr, RB, RA, ss + M, nullptr, nullptr}; gemm_phase(RC, wDnT, M, D, DFF, e); }
  grid.sync();
  {
    const int nM = M / BM, nN = D / BM;
    for (int i = 0;; ++i) { int pm, pn; if (!tile_order(i, gridDim.x, blockIdx.x, nM, nN, pm, pn)) break;
      { EpiPe e{RB}; gemm_tile(pb, wPlT, PLE, pm * BM, pn * BM, e); }
      { EpiRes<2> e{nullptr, nullptr, RA, RC, ss + 2 * M, ss + M, RB}; gemm_tile(RA, wPgT, D, pm * BM, pn * BM, e); } }
  }
  grid.sync();
  for (int idx = gtid; idx < M * (D / 4); idx += NT) {
    const int row = idx >> 8, c = (idx & 255) * 4; const float r = rsqrtf(ss[2 * M + row] * (1.f / D) + EPS);
    const f32x4 v = ld_bf16x4(RC + (size_t)row * D + c); const f32x4 g = *(const f32x4*)(p.g_final + c);
    *(f32x4*)(y + (size_t)row * D + c) = v * r * g;
  }
}

extern "C" void kernel_launch(void* const* d_in, const int* in_sizes, int n_in, void* d_out, int out_size, void* d_ws, size_t ws_size, hipStream_t stream) {
  static int grid_blocks = 0;
  if (grid_blocks == 0) {
    if (ws_size < W_END) { fprintf(stderr, "kernel_launch: workspace too small (%zu < %zu)\n", ws_size, (size_t)W_END); grid_blocks = -1; return; }
    int dev = 0, cus = 0, per_cu = 0;
    hipGetDevice(&dev);
    hipDeviceGetAttribute(&cus, hipDeviceAttributeMultiprocessorCount, dev);
    hipFuncSetAttribute((const void*)fwd_megakernel, hipFuncAttributeMaxDynamicSharedMemorySize, SHM_B);
    hipOccupancyMaxActiveBlocksPerMultiprocessor(&per_cu, (const void*)fwd_megakernel, 512, SHM_B);
    if (per_cu < 1) { fprintf(stderr, "kernel_launch: occupancy query says %d blocks/CU\n", per_cu); per_cu = 1; }
    grid_blocks = cus;
  }
  if (grid_blocks < 0) return;
  Params p{};
  p.x_p = (const float*)d_in[0]; p.x_s = (const float*)d_in[1]; p.p_p = (const float*)d_in[2]; p.p_s = (const float*)d_in[3];
  p.cache_k = (const float*)d_in[4]; p.cache_v = (const float*)d_in[5]; p.cache_conv = (const float*)d_in[6];
  p.g_mix = (const float*)d_in[7]; p.w_in = (const float*)d_in[8]; p.conv_w = (const float*)d_in[9]; p.w_ao = (const float*)d_in[10];
  p.w_co = (const float*)d_in[11]; p.w_o = (const float*)d_in[12]; p.g_ffn = (const float*)d_in[13]; p.w_up = (const float*)d_in[14];
  p.w_dn = (const float*)d_in[15]; p.g_ple = (const float*)d_in[16]; p.w_pg = (const float*)d_in[17]; p.w_pl = (const float*)d_in[18];
  p.g_final = (const float*)d_in[19];
  p.out = (float*)d_out; p.ws = (unsigned char*)d_ws;
  void* args[] = {&p};
  hipError_t e = hipLaunchCooperativeKernel((const void*)fwd_megakernel, dim3(grid_blocks), dim3(512), args, SHM_B, stream);
  if (e != hipSuccess) fprintf(stderr, "cooperative launch failed: %s (grid %d)\n", hipGetErrorString(e), grid_blocks);
}
```

```cpp
#include <hip/hip_runtime.h>
#include <hip/hip_cooperative_groups.h>
#include <cstdio>
#include <cstdint>
namespace cg = cooperative_groups;

#define DI __device__ __forceinline__
typedef unsigned short bf16_t;
typedef short bf16x8 __attribute__((ext_vector_type(8)));
typedef float f32x4 __attribute__((ext_vector_type(4)));
typedef float f32x2 __attribute__((ext_vector_type(2)));
typedef float f32x16 __attribute__((ext_vector_type(16)));
typedef unsigned u32x4 __attribute__((ext_vector_type(4)));
typedef unsigned u32x2 __attribute__((ext_vector_type(2)));
typedef __bf16 bf16v2 __attribute__((ext_vector_type(2)));

constexpr int D = 1024, NPROJ = 5120, MP = 32768, MS = 1024, M = MP + MS, SEQ = 8192, DSEQ = 32, PAST = 2048;
constexpr int NH = 8, HD = 64, SBW = 512, CW = 512, PLE = 256, DFF = 4096, P4W = 4096;
constexpr float EPS = 1e-6f;
constexpr size_t O_Y = 0, O_KP = (size_t)M * D, O_VP = O_KP + (size_t)MP * SBW, O_CP = O_VP + (size_t)MP * SBW,
                 O_KS = O_CP + 4 * 2 * CW, O_VS = O_KS + (size_t)MS * SBW, O_CS = O_VS + (size_t)MS * SBW;
constexpr size_t W_IN = 0, W_AO = W_IN + (size_t)NPROJ * D * 2, W_CO = W_AO + (size_t)D * SBW * 2, W_O = W_CO + (size_t)D * CW * 2,
                 W_UP = W_O + (size_t)D * D * 2, W_DN = W_UP + (size_t)DFF * D * 2, W_PG = W_DN + (size_t)D * DFF * 2,
                 W_PL = W_PG + (size_t)D * D * 2, W_RS0 = W_PL + (size_t)D * PLE * 2, W_SS = W_RS0 + (size_t)M * 4,
                 W_PB = W_SS + (size_t)3 * M * 4, W_RA = W_PB + (size_t)M * PLE * 2, W_RB = W_RA + (size_t)M * D * 2,
                 W_RC = W_RB + (size_t)M * D * 2, W_BAR = W_RC + (size_t)M * P4W * 2, W_END = W_BAR + 16384;

struct Params {
  const float *x_p, *x_s, *p_p, *p_s, *cache_k, *cache_v, *cache_conv;
  const float *g_mix, *w_in, *conv_w, *w_ao, *w_co, *w_o, *g_ffn, *w_up, *w_dn, *g_ple, *w_pg, *w_pl, *g_final;
  float* out; unsigned char* ws;
};

extern __shared__ __attribute__((aligned(16))) unsigned char dyn_lds[];

DI unsigned pk2(float lo, float hi) { f32x2 f = {lo, hi}; bf16v2 b = __builtin_convertvector(f, bf16v2); return __builtin_bit_cast(unsigned, b); }
DI float bf2f(unsigned h16) { return __uint_as_float(h16 << 16); }
DI float bflo(unsigned u) { return __uint_as_float(u << 16); }
DI float bfhi(unsigned u) { return __uint_as_float(u & 0xffff0000u); }
DI bf16x8 cvt8(f32x4 a, f32x4 b) { u32x4 u = {pk2(a.x, a.y), pk2(a.z, a.w), pk2(b.x, b.y), pk2(b.z, b.w)}; return __builtin_bit_cast(bf16x8, u); }
DI float sigmoidf_(float v) { return 1.f / (1.f + __expf(-v)); }
DI float wave_sum(float v) {
#pragma unroll
  for (int o = 1; o < 64; o <<= 1) v += __shfl_xor(v, o);
  return v;
}

constexpr int BM = 256, BK = 64, HALF = 128, NXCD = 8, WGM = 8, HT = HALF * BK, SHM_B = 8 * HT * 2;
DI int lds_byte(int r, int c) { int st = (r >> 4) * 2 + (c >> 5), rr = r & 15, cc = c & 31, ob = rr * 64 + cc * 2; return st * 1024 + (ob ^ (((ob >> 9) & 1) << 5)); }
DI void stage_rc(int b, int& R, int& C) { int st = b / 1024, sb = b % 1024, swz = sb ^ (((sb >> 9) & 1) << 5); R = (st >> 1) * 16 + swz / 64; C = (st & 1) * 32 + (swz % 64) / 2; }

DI bool tile_order(int i, int G, int c, int nM, int nN, int& pm, int& pn) {
  const int nwg = nM * nN; const long L = (long)i * G + c; if (L >= nwg) return false;
  int wgid = (int)L; { const int q = nwg / NXCD, r = nwg % NXCD, xcd = wgid % NXCD, off = wgid / NXCD; wgid = (xcd < r ? xcd * (q + 1) : r * (q + 1) + (xcd - r) * q) + off; }
  const int nig = WGM * nN, gid = wgid / nig, fm = gid * WGM, gsz = (nM - fm) < WGM ? (nM - fm) : WGM;
  pm = fm + ((wgid % nig) % gsz); pn = (wgid % nig) / gsz; return true;
}

typedef f32x4 acc_t[2][2][4][2];
DI void gemm_kloop(const bf16_t* __restrict__ A, const bf16_t* __restrict__ Bt, const int K, const int brow, const int bcol, acc_t& acc) {
  bf16_t* shm = (bf16_t*)dyn_lds;
  int tid = threadIdx.x; asm volatile("" : "+v"(tid));
#define SA(b, h) (shm + ((b) * 2 + (h)) * HT)
#define SB(b, h) (shm + (4 + (b) * 2 + (h)) * HT)
#define STAGE(P, BASE, br, kt) do { const char* _ub = (const char*)(BASE) + ((size_t)(br) * K + (size_t)(kt) * BK) * 2; \
    __builtin_amdgcn_global_load_lds((const unsigned*)(_ub + voff0), (unsigned*)((char*)(P) + wbase), 16, 0, 0); \
    __builtin_amdgcn_global_load_lds((const unsigned*)(_ub + voff1), (unsigned*)((char*)(P) + wbase + 8192), 16, 0, 0); } while (0)
#define LDA(dst, b, h) for (int m = 0; m < 4; ++m) for (int k = 0; k < 2; ++k) \
    dst[m][k] = *reinterpret_cast<const bf16x8*>((char*)SA(b, h) + lds_byte(wr * 64 + m * 16 + fr, k * 32 + fq * 8))
#define LDB(dst, b, h) for (int n = 0; n < 2; ++n) for (int k = 0; k < 2; ++k) \
    dst[n][k] = *reinterpret_cast<const bf16x8*>((char*)SB(b, h) + lds_byte(wc * 32 + n * 16 + fr, k * 32 + fq * 8))
#define MMA(ai, bj, At_, Bt_) do { __builtin_amdgcn_s_setprio(1); \
    for (int m = 0; m < 4; ++m) for (int n = 0; n < 2; ++n) for (int k = 0; k < 2; ++k) \
      acc[ai][bj][m][n] = __builtin_amdgcn_mfma_f32_16x16x32_bf16(Bt_[n][k], At_[m][k], acc[ai][bj][m][n], 0, 0, 0); \
    __builtin_amdgcn_s_setprio(0); } while (0)
#define WAIT_V(n) asm volatile("s_waitcnt vmcnt(" #n ")" ::: "memory")
#define WAIT_L(n) asm volatile("s_waitcnt lgkmcnt(" #n ")" ::: "memory")
#define BAR __builtin_amdgcn_s_barrier()
#define SCHED __builtin_amdgcn_sched_barrier(0)
  const int wid = tid >> 6, lane = tid & 63, wr = wid >> 2, wc = wid & 3, fr = lane & 15, fq = lane >> 4;
  bf16x8 At[4][2], B0[2][2], B1[2][2];
  const int nt = K / BK;
  const int wbase = __builtin_amdgcn_readfirstlane((tid & ~63) * 16);
  unsigned voff0, voff1;
  { int r_, c_; stage_rc(tid * 16, r_, c_); voff0 = (unsigned)(r_ * K + c_) * 2u; stage_rc(tid * 16 + 8192, r_, c_); voff1 = (unsigned)(r_ * K + c_) * 2u; }
  STAGE(SB(0, 0), Bt, bcol, 0); STAGE(SA(0, 0), A, brow, 0);
  STAGE(SB(0, 1), Bt, bcol + HALF, 0); STAGE(SA(0, 1), A, brow + HALF, 0);
  if (wr == 1) BAR;
  WAIT_V(4); BAR;
  STAGE(SB(1, 0), Bt, bcol, 1); STAGE(SA(1, 0), A, brow, 1); STAGE(SB(1, 1), Bt, bcol + HALF, 1);
  WAIT_V(6); BAR;
  for (int t = 0; t < nt - 2; t += 2) {
    LDB(B0, 0, 0); SCHED; LDA(At, 0, 0); STAGE(SA(1, 1), A, brow + HALF, t + 1);
    WAIT_L(8); BAR; WAIT_L(0); MMA(0, 0, At, B0); BAR; SCHED;
    LDB(B1, 0, 1); STAGE(SB(0, 0), Bt, bcol, t + 2);
    BAR; WAIT_L(0); MMA(0, 1, At, B1); BAR;
    LDA(At, 0, 1); STAGE(SA(0, 0), A, brow, t + 2);
    BAR; WAIT_L(0); MMA(1, 0, At, B0); BAR; SCHED;
    STAGE(SB(0, 1), Bt, bcol + HALF, t + 2);
    WAIT_V(6); BAR; MMA(1, 1, At, B1); BAR;
    LDB(B0, 1, 0); SCHED; LDA(At, 1, 0); STAGE(SA(0, 1), A, brow + HALF, t + 2);
    WAIT_L(8); BAR; WAIT_L(0); MMA(0, 0, At, B0); BAR; SCHED;
    LDB(B1, 1, 1); STAGE(SB(1, 0), Bt, bcol, t + 3);
    BAR; WAIT_L(0); MMA(0, 1, At, B1); BAR;
    LDA(At, 1, 1); STAGE(SA(1, 0), A, brow, t + 3);
    BAR; WAIT_L(0); MMA(1, 0, At, B0); BAR; SCHED;
    STAGE(SB(1, 1), Bt, bcol + HALF, t + 3);
    WAIT_V(6); BAR; MMA(1, 1, At, B1); BAR;
  }
  { LDB(B0, 0, 0); LDA(At, 0, 0); STAGE(SA(1, 1), A, brow + HALF, nt - 1);
    BAR; WAIT_L(0); MMA(0, 0, At, B0); BAR;
    LDB(B1, 0, 1); BAR; WAIT_L(0); MMA(0, 1, At, B1); BAR;
    LDA(At, 0, 1); WAIT_V(4); BAR; WAIT_L(0); MMA(1, 0, At, B0); MMA(1, 1, At, B1); BAR; }
  { LDB(B0, 1, 0); LDA(At, 1, 0); WAIT_V(2); BAR; WAIT_L(0); MMA(0, 0, At, B0); BAR;
    LDB(B1, 1, 1); WAIT_V(0); BAR; WAIT_L(0); MMA(0, 1, At, B1); BAR;
    LDA(At, 1, 1); BAR; WAIT_L(0); MMA(1, 0, At, B0); MMA(1, 1, At, B1); BAR; }
  if (wr == 0) BAR;
}
template <class F>
DI void epi_call(acc_t& acc, const int brow, const int bcol, const F& f) {
  int tid2 = threadIdx.x, brow2 = brow, bcol2 = bcol;
  asm volatile("" : "+v"(tid2), "+s"(brow2), "+s"(bcol2));
  const int wid2 = tid2 >> 6, lane2 = tid2 & 63;
  f(acc, brow2, bcol2, wid2 >> 2, wid2 & 3, lane2 & 15, lane2 >> 4);
}
template <class Epi>
DI void gemm_tile(const bf16_t* __restrict__ A, const bf16_t* __restrict__ Bt, const int K, const int brow, const int bcol, const Epi& epi) {
  acc_t acc = {};
  gemm_kloop(A, Bt, K, brow, bcol, acc);
  epi_call(acc, brow, bcol, epi);
}

template <class Epi>
DI void gemm_phase(const bf16_t* A, const bf16_t* Bt, int Mrows, int N, int K, const Epi& epi) {
  const int nM = Mrows / BM, nN = N / BM;
  for (int i = 0;; ++i) {
    int pm, pn; if (!tile_order(i, gridDim.x, blockIdx.x, nM, nN, pm, pn)) break;
    gemm_tile(A, Bt, K, pm * BM, pn * BM, epi);
  }
}

DI void st_bf16x4(bf16_t* p, f32x4 v) { u32x2 u = {pk2(v.x, v.y), pk2(v.z, v.w)}; *(u32x2*)p = u; }
DI f32x4 ld_bf16x4(const bf16_t* p) { u32x2 u = *(const u32x2*)p; f32x4 v = {bflo(u.x), bfhi(u.x), bflo(u.y), bfhi(u.y)}; return v; }

#define EPI_ROWS for (int ai = 0; ai < 2; ++ai) for (int m = 0; m < 4; ++m)
#define EPI_COLS for (int bj = 0; bj < 2; ++bj) for (int n = 0; n < 2; ++n)
#define EPI_BJ for (int bj = 0; bj < 2; ++bj)
#define EPI_ROW (brow + ai * HALF + wr * 64 + m * 16 + fr)
#define EPI_COL (bcol + bj * HALF + wc * 32 + n * 16 + fq * 4)
#define EPI_COL8 (bcol + bj * HALF + wc * 32 + fq * 8)
DI void st_bf16x8(bf16_t* p, f32x4 a, f32x4 b) { u32x4 u = {pk2(a.x, a.y), pk2(a.z, a.w), pk2(b.x, b.y), pk2(b.z, b.w)}; *(u32x4*)p = u; }
DI void unpack8(const u32x4 u, f32x4& a, f32x4& b) { a = (f32x4){bflo(u.x), bfhi(u.x), bflo(u.y), bfhi(u.y)}; b = (f32x4){bflo(u.z), bfhi(u.z), bflo(u.w), bfhi(u.w)}; }

struct EpiIn {
  const float* rs0; bf16_t* proj4; float* out;
  DI void operator()(const acc_t& acc, int brow, int bcol, int wr, int wc, int fr, int fq) const {
    float rr[2][4];
#pragma unroll
    EPI_ROWS rr[ai][m] = rs0[EPI_ROW];
    if (bcol >= 512 && bcol < 1536) {
#pragma unroll
      EPI_ROWS { const int row = EPI_ROW; const float r = rr[ai][m];
#pragma unroll
        EPI_COLS { const int col = EPI_COL; f32x4 v = acc[ai][bj][m][n] * r;
          const int isv = bcol >= 1024; const int c = col - (isv ? 1024 : 512);
          float* dst = (row < MP) ? out + (isv ? O_VP : O_KP) + (size_t)row * SBW + c : out + (isv ? O_VS : O_KS) + (size_t)(row - MP) * SBW + c;
          *(f32x4*)dst = v; } }
    } else if (bcol < 2048) {
      const float sc = (bcol < 512) ? 0.18033688011112042f   : 1.f; const int sh = (bcol < 512) ? 0 : 1024;
#pragma unroll
      EPI_ROWS { const int row = EPI_ROW; const float r = rr[ai][m] * sc;
#pragma unroll
        EPI_BJ { st_bf16x8(proj4 + (size_t)row * P4W + (EPI_COL8 - sh), acc[ai][bj][m][0] * r, acc[ai][bj][m][1] * r); } }
    } else {
      const bool gate = bcol >= 3072; const int t = ((bcol - (gate ? 3072 : 2048)) >> 8) * 128;
#pragma unroll
      EPI_ROWS { const int row = EPI_ROW; const float r = rr[ai][m]; const int ch = t + wc * 32 + fq * 8;
        const f32x4 a0 = acc[ai][0][m][0] * r, a1 = acc[ai][0][m][1] * r, b0 = acc[ai][1][m][0] * r, b1 = acc[ai][1][m][1] * r;
        if (!gate) { st_bf16x8(proj4 + (size_t)row * P4W + 1024 + ch, a0 * b0, a1 * b1); }
        else { f32x4 rho0, rho1, sg0, sg1;
#pragma unroll
          for (int e = 0; e < 4; ++e) {
            { const float ea = __expf(-a0[e]), eb = __expf(-fmaxf(b0[e], -80.f)); sg0[e] = 1.f / (1.f + eb); rho0[e] = (1.f + eb) / (1.f + ea); }
            { const float ea = __expf(-a1[e]), eb = __expf(-fmaxf(b1[e], -80.f)); sg1[e] = 1.f / (1.f + eb); rho1[e] = (1.f + eb) / (1.f + ea); } }
          st_bf16x8(proj4 + (size_t)row * P4W + 2048 + ch, rho0, rho1); st_bf16x8(proj4 + (size_t)row * P4W + 3072 + ch, sg0, sg1); } }
    }
  }
};
template <bool FINAL>
struct EpiGate {
  const bf16_t* proj4; int off; bf16_t* merged;
  DI void operator()(acc_t& acc, int brow, int bcol, int wr, int wc, int fr, int fq) const {
    u32x4 g[2][4][2];
#pragma unroll
    EPI_ROWS { const int row = EPI_ROW;
#pragma unroll
      EPI_BJ g[ai][m][bj] = *(const u32x4*)(proj4 + (size_t)row * P4W + off + EPI_COL8); }
#pragma unroll
    EPI_ROWS { const int row = EPI_ROW;
#pragma unroll
      EPI_BJ { f32x4 g0, g1; unpack8(g[ai][m][bj], g0, g1);
        if (FINAL) st_bf16x8(merged + (size_t)row * D + EPI_COL8, acc[ai][bj][m][0] * g0, acc[ai][bj][m][1] * g1);
        else { acc[ai][bj][m][0] *= g0; acc[ai][bj][m][1] *= g1; } } }
  }
};
template <int MODE>
struct EpiRes {
  const float *x_p, *x_s; const bf16_t* resb; bf16_t* outb; float* ss; const float* ssprev; const bf16_t* pe;
  DI void operator()(const acc_t& acc, int brow, int bcol, int wr, int wc, int fr, int fq) const {
#pragma unroll
    for (int ai = 0; ai < 2; ++ai) {
      f32x4 resf[4][2][2]; u32x4 resh[4][2], peh[4][2]; float rr[4];
#pragma unroll
      for (int m = 0; m < 4; ++m) { const int row = EPI_ROW;
        if (MODE == 2) rr[m] = ssprev[row];
#pragma unroll
        EPI_BJ { const int col = EPI_COL8;
          if (MODE == 0) { const float* xp = (row < MP) ? x_p + (size_t)row * D + col : x_s + (size_t)(row - MP) * D + col;
            resf[m][bj][0] = *(const f32x4*)xp; resf[m][bj][1] = *(const f32x4*)(xp + 4); }
          else resh[m][bj] = *(const u32x4*)(resb + (size_t)row * D + col);
          if (MODE == 2) peh[m][bj] = *(const u32x4*)(pe + (size_t)row * D + col); } }
#pragma unroll
      for (int m = 0; m < 4; ++m) { const int row = EPI_ROW; float part = 0.f; float r = 0.f;
        if (MODE == 2) r = rsqrtf(rr[m] * (1.f / D) + EPS);
#pragma unroll
        EPI_BJ { const int col = EPI_COL8; f32x4 a0 = acc[ai][bj][m][0], a1 = acc[ai][bj][m][1]; f32x4 r0, r1;
          if (MODE == 0) { r0 = resf[m][bj][0]; r1 = resf[m][bj][1]; } else unpack8(resh[m][bj], r0, r1);
          if (MODE == 2) { f32x4 e0, e1; unpack8(peh[m][bj], e0, e1); a0 = a0 * r; a1 = a1 * r;
            const f32x4 s0 = {sigmoidf_(a0.x), sigmoidf_(a0.y), sigmoidf_(a0.z), sigmoidf_(a0.w)}, s1 = {sigmoidf_(a1.x), sigmoidf_(a1.y), sigmoidf_(a1.z), sigmoidf_(a1.w)};
            a0 = s0 * e0; a1 = s1 * e1; }
          const f32x4 o0 = r0 + a0, o1 = r1 + a1;
          st_bf16x8(outb + (size_t)row * D + col, o0, o1);
          part += (o0.x * o0.x + o0.y * o0.y + o0.z * o0.z + o0.w * o0.w) + (o1.x * o1.x + o1.y * o1.y + o1.z * o1.z + o1.w * o1.w); }
        part += __shfl_xor(part, 16); part += __shfl_xor(part, 32);
        if (fq == 0) atomicAdd(ss + row, part); }
    }
  }
};
struct EpiUp {
  const float* ss1; bf16_t* u;
  DI void operator()(const acc_t& acc, int brow, int bcol, int wr, int wc, int fr, int fq) const {
    float rr[2][4];
#pragma unroll
    EPI_ROWS rr[ai][m] = ss1[EPI_ROW];
#pragma unroll
    EPI_ROWS { const int row = EPI_ROW; const float r = rsqrtf(rr[ai][m] * (1.f / D) + EPS);
#pragma unroll
      EPI_BJ { f32x4 a0 = acc[ai][bj][m][0] * r, a1 = acc[ai][bj][m][1] * r;
        const f32x4 z0 = {fmaxf(a0.x, 0.f), fmaxf(a0.y, 0.f), fmaxf(a0.z, 0.f), fmaxf(a0.w, 0.f)}, z1 = {fmaxf(a1.x, 0.f), fmaxf(a1.y, 0.f), fmaxf(a1.z, 0.f), fmaxf(a1.w, 0.f)};
        st_bf16x8(u + (size_t)row * DFF + EPI_COL8, z0 * z0, z1 * z1); } }
  }
};
struct EpiPe {
  bf16_t* pe;
  DI void operator()(const acc_t& acc, int brow, int bcol, int wr, int wc, int fr, int fq) const {
#pragma unroll
    EPI_ROWS { const int row = EPI_ROW;
#pragma unroll
      EPI_BJ { st_bf16x8(pe + (size_t)row * D + EPI_COL8, acc[ai][bj][m][0], acc[ai][bj][m][1]); } }
  }
};

DI int win_perm(int n) {
  if (n < 2048) return n;
  if (n < 3072) { const int r = n - 2048, c = r & 511; return 2048 + 256 * (c >> 7) + ((r >> 9) ? 128 : 0) + (c & 127); }
  const int r = n - 3072, c = r & 1023; return 3072 + 256 * (c >> 7) + ((r >> 10) ? 128 : 0) + (c & 127);
}
template <bool PERM>
DI void transpose_item(const float* __restrict__ W, const float* __restrict__ g, int K, int N, bf16_t* __restrict__ WT, float* scr, int item, int lane) {
  const int nblk = N / 32, kb = item / nblk, nb = item % nblk, k0 = 64 * kb, n0 = 32 * nb;
  const int n0d = PERM ? win_perm(n0) : n0;
  const bool p32 = !(PERM && n0 >= 512 && n0 < 1536);
#pragma unroll 8
  for (int i = 0; i < 32; ++i) { const int kk = 2 * i + (lane >> 5); float w = W[(size_t)(k0 + kk) * N + n0 + (lane & 31)]; if (g) w *= g[k0 + kk]; scr[kk * 33 + (lane & 31)] = w; }
  asm volatile("s_waitcnt lgkmcnt(0)" ::: "memory");
  const int c = lane & 7;
#pragma unroll
  for (int j = 0; j < 4; ++j) { const int n = (lane >> 3) + 8 * j; const int ns = p32 ? (8 * ((n & 15) >> 2) + 4 * (n >> 4) + (n & 3)) : n; const float* s = scr + (8 * c) * 33 + ns;
    u32x4 o = {pk2(s[0 * 33], s[1 * 33]), pk2(s[2 * 33], s[3 * 33]), pk2(s[4 * 33], s[5 * 33]), pk2(s[6 * 33], s[7 * 33])};
    *(u32x4*)(WT + (size_t)(n0d + n) * K + k0 + 8 * c) = o; }
  asm volatile("s_waitcnt lgkmcnt(0)" ::: "memory");
}

#define MFMA32(a, b, c) __builtin_amdgcn_mfma_f32_32x32x16_bf16((a), (b), (c), 0, 0, 0)
DI void attn_load(const float* __restrict__ Kp, const float* __restrict__ Vp, int i, int half, f32x4 (&kr)[8], float (&vr)[32]) {
#pragma unroll
  for (int s = 0; s < 4; ++s) { const f32x4* kp = (const f32x4*)(Kp + (size_t)i * SBW + 16 * s + 8 * half); kr[2 * s] = kp[0]; kr[2 * s + 1] = kp[1]; }
#pragma unroll
  for (int s = 0; s < 2; ++s)
#pragma unroll
    for (int jj = 0; jj < 8; ++jj) { const int key = 16 * s + 8 * (jj >> 2) + 4 * half + (jj & 3);
      vr[(2 * s) * 8 + jj] = Vp[(size_t)key * SBW + i]; vr[(2 * s + 1) * 8 + jj] = Vp[(size_t)key * SBW + 32 + i]; }
}
template <bool DIAG>
DI void attn_weights(const f32x16& sacc, int i, int half, float& C, float (&a)[16]) {
  float be[16], om[16];
#pragma unroll
  for (int r = 0; r < 16; ++r) { const float z = sacc[r];
    const float e = __builtin_amdgcn_exp2f(-fabsf(z)), rc = __builtin_amdgcn_rcpf(1.f + e), er = e * rc;
    float b = (z >= 0.f) ? rc : er, o = (z >= 0.f) ? er : rc;
    if (DIAG) { const int key = (r & 3) + 8 * (r >> 2) + 4 * half; const bool valid = key < i; b = valid ? b : 0.f; o = valid ? o : 1.f; }
    be[r] = b; om[r] = o; }
  float G[4], Pn[4];
#pragma unroll
  for (int g = 0; g < 4; ++g) { G[g] = (om[4 * g] * om[4 * g + 1]) * (om[4 * g + 2] * om[4 * g + 3]); Pn[g] = __shfl_xor(G[g], 32); }
  float run = C;
#pragma unroll
  for (int g = 3; g >= 0; --g) { float t = half ? run : run * Pn[g];
#pragma unroll
    for (int u = 3; u >= 0; --u) { a[4 * g + u] = be[4 * g + u] * t; t *= om[4 * g + u]; }
    run *= G[g] * Pn[g]; }
  C = run;
}
DI void attn_task(const Params& p, const int qb, const int h, int lane) {
  const bf16_t* proj4 = (const bf16_t*)(p.ws + W_RC);
  bf16_t* attn = (bf16_t*)(p.ws + W_RB);
  const int i = lane & 31, half = lane >> 5;
  int qtok0, nblk; const float *k0p, *v0p, *k1p, *v1p;
  if (qb < MP / 32) { const int b = qb >> 8, t0 = (qb & 255) * 32; qtok0 = b * SEQ + t0; nblk = (t0 >> 5) + 1;
    k0p = p.out + O_KP + (size_t)qtok0 * SBW; v0p = p.out + O_VP + (size_t)qtok0 * SBW; k1p = k0p; v1p = v0p; }
  else { const int b = qb - MP / 32; qtok0 = MP + b * DSEQ; nblk = 1 + PAST / 32;
    k0p = p.out + O_KS + (size_t)(b * DSEQ) * SBW; v0p = p.out + O_VS + (size_t)(b * DSEQ) * SBW;
    k1p = p.cache_k + (size_t)(b * PAST + PAST) * SBW; v1p = p.cache_v + (size_t)(b * PAST + PAST) * SBW; }
  k0p += h * HD; v0p += h * HD; k1p += h * HD; v1p += h * HD;
  bf16x8 qf[4];
  { const bf16_t* qp = proj4 + (size_t)(qtok0 + i) * P4W + h * HD + 8 * half;
#pragma unroll
    for (int s = 0; s < 4; ++s) qf[s] = *(const bf16x8*)(qp + 16 * s); }
  f32x16 o0 = {}, o1 = {};
  float C = 1.f;
  f32x4 kr[8]; float vr[32];
  bf16x8 kf[4], vf[4];
#define ATTN_CVT() do { _Pragma("unroll") for (int s = 0; s < 4; ++s) kf[s] = cvt8(kr[2 * s], kr[2 * s + 1]); \
    _Pragma("unroll") for (int q = 0; q < 4; ++q) { u32x4 v = {pk2(vr[8 * q], vr[8 * q + 1]), pk2(vr[8 * q + 2], vr[8 * q + 3]), pk2(vr[8 * q + 4], vr[8 * q + 5]), pk2(vr[8 * q + 6], vr[8 * q + 7])}; \
      vf[q] = __builtin_bit_cast(bf16x8, v); } } while (0)
  attn_load(k0p, v0p, i, half, kr, vr);
  ATTN_CVT();
  for (int it = 0; it < nblk; ++it) {
    { const int itn = (it + 1 < nblk) ? it + 1 : it;
      attn_load(k1p - (size_t)itn * 32 * SBW, v1p - (size_t)itn * 32 * SBW, i, half, kr, vr); }
    __builtin_amdgcn_sched_barrier(0);
    f32x16 sacc = {};
#pragma unroll
    for (int s = 0; s < 4; ++s) sacc = MFMA32(kf[s], qf[s], sacc);
    float a[16];
    if (it == 0) attn_weights<true>(sacc, i, half, C, a); else attn_weights<false>(sacc, i, half, C, a);
#pragma unroll
    for (int s = 0; s < 2; ++s) {
      u32x4 pu = {pk2(a[8 * s], a[8 * s + 1]), pk2(a[8 * s + 2], a[8 * s + 3]), pk2(a[8 * s + 4], a[8 * s + 5]), pk2(a[8 * s + 6], a[8 * s + 7])};
      const bf16x8 pf = __builtin_bit_cast(bf16x8, pu);
      o0 = MFMA32(vf[2 * s], pf, o0);
      o1 = MFMA32(vf[2 * s + 1], pf, o1); }
    if (__all(C == 0.f)) break;
    __builtin_amdgcn_sched_barrier(0);
    ATTN_CVT();
  }
  bf16_t* op = attn + (size_t)(qtok0 + i) * SBW + h * HD + 4 * half;
#pragma unroll
  for (int g = 0; g < 4; ++g) {
    f32x4 a0 = {o0[4 * g], o0[4 * g + 1], o0[4 * g + 2], o0[4 * g + 3]}; st_bf16x4(op + 8 * g, a0);
    f32x4 a1 = {o1[4 * g], o1[4 * g + 1], o1[4 * g + 2], o1[4 * g + 3]}; st_bf16x4(op + 32 + 8 * g, a1); }
}

DI void conv_items(const Params& p) {
  const bf16_t* proj4 = (const bf16_t*)(p.ws + W_RC);
  bf16_t* convg = (bf16_t*)(p.ws + W_RB) + (size_t)M * SBW;
  const int total = (M / 8) * (CW / 8);
  for (int idx = blockIdx.x * blockDim.x + threadIdx.x; idx < total; idx += gridDim.x * blockDim.x) {
    const int tok0 = (idx >> 6) * 8, c0 = (idx & 63) * 8;
    int b, t0, T; const float* buf; float* nb;
    if (tok0 < MP) { b = tok0 >> 13; t0 = tok0 & (SEQ - 1); T = SEQ; buf = nullptr; nb = p.out + O_CP + (size_t)b * 2 * CW; }
    else { const int s = tok0 - MP; b = s >> 5; t0 = s & (DSEQ - 1); T = DSEQ; buf = p.cache_conv + (size_t)b * 2 * CW; nb = p.out + O_CS + (size_t)b * 2 * CW; }
    const bf16_t* row = proj4 + (size_t)tok0 * P4W + c0;
    u32x4 ur[10], cr[8];
#pragma unroll
    for (int j = 0; j < 8; ++j) { ur[j + 2] = *(const u32x4*)(row + (size_t)j * P4W + 1024); cr[j] = *(const u32x4*)(row + (size_t)j * P4W + 512); }
    float w0[8], w1[8], w2[8];
#pragma unroll
    for (int e = 0; e < 8; ++e) { w0[e] = p.conv_w[c0 + e]; w1[e] = p.conv_w[CW + c0 + e]; w2[e] = p.conv_w[2 * CW + c0 + e]; }
    float um2[8], um1[8];
    if (t0 > 0) { const u32x4 x2 = *(const u32x4*)(row - 2 * (size_t)P4W + 1024), x1 = *(const u32x4*)(row - (size_t)P4W + 1024);
#pragma unroll
      for (int e = 0; e < 4; ++e) { um2[2 * e] = bflo(x2[e]); um2[2 * e + 1] = bfhi(x2[e]); um1[2 * e] = bflo(x1[e]); um1[2 * e + 1] = bfhi(x1[e]); } }
    else {
#pragma unroll
      for (int e = 0; e < 8; ++e) { um2[e] = buf ? buf[c0 + e] : 0.f; um1[e] = buf ? buf[CW + c0 + e] : 0.f; } }
#pragma unroll
    for (int j = 0; j < 8; ++j) {
      float u0[8], cbv[8], o[8];
#pragma unroll
      for (int e = 0; e < 4; ++e) { u0[2 * e] = bflo(ur[j + 2][e]); u0[2 * e + 1] = bfhi(ur[j + 2][e]); cbv[2 * e] = bflo(cr[j][e]); cbv[2 * e + 1] = bfhi(cr[j][e]); }
#pragma unroll
      for (int e = 0; e < 8; ++e) o[e] = cbv[e] * (w0[e] * um2[e] + w1[e] * um1[e] + w2[e] * u0[e]);
      u32x4 ov = {pk2(o[0], o[1]), pk2(o[2], o[3]), pk2(o[4], o[5]), pk2(o[6], o[7])};
      *(u32x4*)(convg + (size_t)(tok0 + j) * CW + c0) = ov;
      if (t0 + j >= T - 2) { float* d = nb + (size_t)(t0 + j - (T - 2)) * CW + c0;
#pragma unroll
        for (int e = 0; e < 8; ++e) d[e] = u0[e]; }
#pragma unroll
      for (int e = 0; e < 8; ++e) { um2[e] = um1[e]; um1[e] = u0[e]; }
    }
  }
}

#define XB_TMO      128
#define XB_XCNT(j)  (256  + 64 * (j))
#define XB_XSUB(j)  (1280 + 64 * (j))
#define XB_XGEN(j)  (2304 + 64 * (j))
#define XB_TOP      3328
#define XB_TOPGEN   3392
#define XCD_BAR_WORDS 3456
#define XB_SPIN_CAP (1u << 18)
#define LAS __attribute__((address_space(3)))
DI unsigned xb_ld(unsigned* p) { return __hip_atomic_load(p, __ATOMIC_RELAXED, __HIP_MEMORY_SCOPE_AGENT); }
DI unsigned xb_add(unsigned* p, unsigned v) { return __hip_atomic_fetch_add(p, v, __ATOMIC_RELAXED, __HIP_MEMORY_SCOPE_AGENT); }
DI unsigned xb_xcc_id() { return (unsigned)__builtin_amdgcn_s_getreg((3 << 11) | 20) & 0xFu; }
#define XB_SPIN(cond, bar) do { unsigned _sp = 0; while (cond) { __builtin_amdgcn_s_sleep(1); \
    if ((++_sp & 255u) == 0u) { if (xb_ld(&(bar)[XB_TMO])) break; if (_sp > XB_SPIN_CAP) { atomicAdd(&(bar)[XB_TMO], 1u); break; } } } } while (0)
struct XcdBarrier { unsigned* bar; unsigned x; volatile LAS unsigned* st; };
DI XcdBarrier xcd_barrier_post(unsigned* bar, volatile LAS unsigned* st) {
  XcdBarrier b; b.bar = bar; b.x = xb_xcc_id(); b.st = st;
  if (threadIdx.x == 0) (void)xb_add(&bar[XB_XCNT(b.x)], 1u);
  return b;
}
DI void xcd_barrier_complete(unsigned* bar, unsigned x, unsigned& nloc, unsigned& nx) {
  const unsigned G = gridDim.x * gridDim.y * gridDim.z;
  unsigned sum, cnt, mine, sp = 0u;
  for (;;) {
    sum = 0u; cnt = 0u; mine = 0u;
#pragma unroll
    for (unsigned j = 0; j < 16; ++j) { const unsigned c = xb_ld(&bar[XB_XCNT(j)]); sum += c; cnt += (c > 0u) ? 1u : 0u; mine = (j == x) ? c : mine; }
    if (sum == G) break;
    __builtin_amdgcn_s_sleep(1);
    if ((++sp & 255u) == 0u) { if (xb_ld(&bar[XB_TMO])) break; if (sp > XB_SPIN_CAP) { atomicAdd(&bar[XB_TMO], 1u); break; } }
  }
  nloc = mine > 0u ? mine : 1u; nx = cnt > 0u ? cnt : 1u;
}
DI void xcd_barrier(const XcdBarrier& b) {
  asm volatile("s_waitcnt vmcnt(0)" ::: "memory");
  __syncthreads();
  if (threadIdx.x == 0) {
    unsigned* bar = b.bar;
    __builtin_amdgcn_s_waitcnt(0);
    unsigned nloc = b.st[0], nx = b.st[1];
    if (nloc == 0u) { xcd_barrier_complete(bar, b.x, nloc, nx); b.st[0] = nloc; b.st[1] = nx; }
    const unsigned old = xb_add(&bar[XB_XSUB(b.x)], 1u);
    const unsigned gen = old / nloc;
    if (old + 1u == (gen + 1u) * nloc) {
      __builtin_amdgcn_fence(__ATOMIC_RELEASE, "agent");
      asm volatile("s_waitcnt vmcnt(0)" ::: "memory");
      const unsigned og = xb_add(&bar[XB_TOP], 1u);
      const unsigned tg = og / nx;
      if (og + 1u == (tg + 1u) * nx) xb_add(&bar[XB_TOPGEN], 1u);
      else XB_SPIN(xb_ld(&bar[XB_TOPGEN]) == tg, bar);
      __builtin_amdgcn_fence(__ATOMIC_ACQUIRE, "agent");
      xb_add(&bar[XB_XGEN(b.x)], 1u);
      asm volatile("s_waitcnt vmcnt(0)" ::: "memory");
    } else {
      XB_SPIN(xb_ld(&bar[XB_XGEN(b.x)]) == gen, bar);
      __builtin_amdgcn_fence(__ATOMIC_ACQUIRE, "agent");
      asm volatile("s_waitcnt vmcnt(0)" ::: "memory");
    }
  }
  __syncthreads();
}

__global__ void __launch_bounds__(512, 2) fwd_megakernel(Params p) {
  cg::grid_group grid = cg::this_grid();
  const int lane = threadIdx.x & 63, wave = threadIdx.x >> 6;
  const int gw = blockIdx.x * 8 + wave, NGW = gridDim.x * 8;
  const int gtid = blockIdx.x * blockDim.x + threadIdx.x, NT = gridDim.x * blockDim.x;
  unsigned char* ws = p.ws;
  bf16_t *wInT = (bf16_t*)(ws + W_IN), *wAoT = (bf16_t*)(ws + W_AO), *wCoT = (bf16_t*)(ws + W_CO), *wOT = (bf16_t*)(ws + W_O),
         *wUpT = (bf16_t*)(ws + W_UP), *wDnT = (bf16_t*)(ws + W_DN), *wPgT = (bf16_t*)(ws + W_PG), *wPlT = (bf16_t*)(ws + W_PL);
  float* rs0 = (float*)(ws + W_RS0); float* ss = (float*)(ws + W_SS);
  bf16_t *pb = (bf16_t*)(ws + W_PB), *RA = (bf16_t*)(ws + W_RA), *RB = (bf16_t*)(ws + W_RB), *RC = (bf16_t*)(ws + W_RC);
  float* y = p.out + O_Y;
  __shared__ uint4 xb_words;
  if (threadIdx.x == 0) xb_words = make_uint4(0u, 0u, 0u, 0u);
  __syncthreads();
  const XcdBarrier xb = xcd_barrier_post((unsigned*)(ws + W_BAR), (volatile LAS unsigned*)&xb_words);

  {
    float* scr = (float*)dyn_lds + wave * (64 * 33);
    constexpr int I0 = (D / 64) * (NPROJ / 32), I1 = (SBW / 64) * (D / 32), I2 = I1, I3 = (D / 64) * (D / 32), I4 = (D / 64) * (DFF / 32),
                  I5 = (DFF / 64) * (D / 32), I6 = I3, I7 = (PLE / 64) * (D / 32), NI = I0 + I1 + I2 + I3 + I4 + I5 + I6 + I7;
    for (int it = gw; it < NI; it += NGW) {
      int r = it;
      if (r < I0) { transpose_item<true>(p.w_in, p.g_mix, D, NPROJ, wInT, scr, r, lane); continue; } r -= I0;
      if (r < I1) { transpose_item<false>(p.w_ao, nullptr, SBW, D, wAoT, scr, r, lane); continue; } r -= I1;
      if (r < I2) { transpose_item<false>(p.w_co, nullptr, CW, D, wCoT, scr, r, lane); continue; } r -= I2;
      if (r < I3) { transpose_item<false>(p.w_o, nullptr, D, D, wOT, scr, r, lane); continue; } r -= I3;
      if (r < I4) { transpose_item<false>(p.w_up, p.g_ffn, D, DFF, wUpT, scr, r, lane); continue; } r -= I4;
      if (r < I5) { transpose_item<false>(p.w_dn, nullptr, DFF, D, wDnT, scr, r, lane); continue; } r -= I5;
      if (r < I6) { transpose_item<false>(p.w_pg, p.g_ple, D, D, wPgT, scr, r, lane); continue; } r -= I6;
      transpose_item<false>(p.w_pl, nullptr, PLE, D, wPlT, scr, r, lane);
    }
    for (int row = gw; row < M; row += NGW) {
      const float* xr = (row < MP) ? p.x_p + (size_t)row * D : p.x_s + (size_t)(row - MP) * D;
      const f32x4* x4 = (const f32x4*)xr + lane; f32x4 v[4]; float s = 0.f;
#pragma unroll
      for (int j = 0; j < 4; ++j) { v[j] = x4[64 * j]; s += (v[j].x * v[j].x + v[j].y * v[j].y) + (v[j].z * v[j].z + v[j].w * v[j].w); }
      s = wave_sum(s);
      if (lane == 0) rs0[row] = rsqrtf(s * (1.f / D) + EPS);
      u32x2* o8 = (u32x2*)(RA + (size_t)row * D) + lane;
#pragma unroll
      for (int j = 0; j < 4; ++j) { u32x2 o = {pk2(v[j].x, v[j].y), pk2(v[j].z, v[j].w)}; o8[64 * j] = o; }
    }
    for (int idx = gtid; idx < M * PLE / 4; idx += NT) {
      const size_t e = (size_t)idx * 4; const float* src = (e < (size_t)MP * PLE) ? p.p_p + e : p.p_s + (e - (size_t)MP * PLE);
      f32x4 v = *(const f32x4*)src; st_bf16x4(pb + e, v);
    }
    for (int idx = gtid; idx < 3 * M; idx += NT) ss[idx] = 0.f;
  }
  grid.sync();
  { EpiIn e{rs0, RC, p.out}; gemm_phase(RA, wInT, M, NPROJ, D, e); }
  xcd_barrier(xb);
  { constexpr int NU = (MP / 32 / 8) * NH;
    const int upb = (NU + gridDim.x - 1) / gridDim.x;
    for (int j = 0; j < upb; ++j) { const int u = blockIdx.x * upb + j; if (u >= NU) break;
      const int bh = u >> 5, g = u & 31; attn_task(p, (bh >> 3) * (SEQ / 32) + g * 8 + wave, bh & 7, lane); }
    for (int sb = 0; sb < MS / DSEQ; ++sb) if ((sb * 8 + (sb & 7)) % gridDim.x == blockIdx.x) attn_task(p, MP / 32 + sb, wave, lane); }
  conv_items(p);
  xcd_barrier(xb);
  {
    const int nM = M / BM, nN = D / BM;
    for (int i = 0;; ++i) { int pm, pn; if (!tile_order(i, gridDim.x, blockIdx.x, nM, nN, pm, pn)) break;
      acc_t acc = {};
      gemm_kloop(RB, wAoT, SBW, pm * BM, pn * BM, acc);
      { EpiGate<false> e{RC, 2048, nullptr}; epi_call(acc, pm * BM, pn * BM, e); }
      gemm_kloop(RB + (size_t)M * SBW, wCoT, CW, pm * BM, pn * BM, acc);
      { EpiGate<true> e{RC, 3072, RA}; epi_call(acc, pm * BM, pn * BM, e); } }
  }
  xcd_barrier(xb);
  { EpiRes<0> e{p.x_p, p.x_s, nullptr, RB, ss, nullptr, nullptr}; gemm_phase(RA, wOT, M, D, D, e); }
  xcd_barrier(xb);
  { EpiUp e{ss, RC}; gemm_phase(RB, wUpT, M, DFF, D, e); }
  xcd_barrier(xb);
  { EpiRes<1> e{nullptr, nullptr, RB, RA, ss + M, nullptr, nullptr}; gemm_phase(RC, wDnT, M, D, DFF, e); }
  xcd_barrier(xb);
  {
    const int nM = M / BM, nN = D / BM;
    for (int i = 0;; ++i) { int pm, pn; if (!tile_order(i, gridDim.x, blockIdx.x, nM, nN, pm, pn)) break;
      { EpiPe e{RB}; gemm_tile(pb, wPlT, PLE, pm * BM, pn * BM, e); }
      { EpiRes<2> e{nullptr, nullptr, RA, RC, ss + 2 * M, ss + M, RB}; gemm_tile(RA, wPgT, D, pm * BM, pn * BM, e); } }
  }
  xcd_barrier(xb);
  for (int idx = gtid; idx < M * (D / 4); idx += NT) {
    const int row = idx >> 8, c = (idx & 255) * 4; const float r = rsqrtf(ss[2 * M + row] * (1.f / D) + EPS);
    const f32x4 v = ld_bf16x4(RC + (size_t)row * D + c); const f32x4 g = *(const f32x4*)(p.g_final + c);
    *(f32x4*)(y + (size_t)row * D + c) = v * r * g;
  }
}

extern "C" void kernel_launch(void* const* d_in, const int* in_sizes, int n_in, void* d_out, int out_size, void* d_ws, size_t ws_size, hipStream_t stream) {
  static int grid_blocks = 0;
  if (grid_blocks == 0) {
    if (ws_size < W_END) { fprintf(stderr, "kernel_launch: workspace too small (%zu < %zu)\n", ws_size, (size_t)W_END); grid_blocks = -1; return; }
    int dev = 0, cus = 0, per_cu = 0;
    hipGetDevice(&dev);
    hipDeviceGetAttribute(&cus, hipDeviceAttributeMultiprocessorCount, dev);
    hipFuncSetAttribute((const void*)fwd_megakernel, hipFuncAttributeMaxDynamicSharedMemorySize, SHM_B);
    hipOccupancyMaxActiveBlocksPerMultiprocessor(&per_cu, (const void*)fwd_megakernel, 512, SHM_B);
    if (per_cu < 1) { fprintf(stderr, "kernel_launch: occupancy query says %d blocks/CU\n", per_cu); per_cu = 1; }
    grid_blocks = cus;
  }
  if (grid_blocks < 0) return;
  Params p{};
  p.x_p = (const float*)d_in[0]; p.x_s = (const float*)d_in[1]; p.p_p = (const float*)d_in[2]; p.p_s = (const float*)d_in[3];
  p.cache_k = (const float*)d_in[4]; p.cache_v = (const float*)d_in[5]; p.cache_conv = (const float*)d_in[6];
  p.g_mix = (const float*)d_in[7]; p.w_in = (const float*)d_in[8]; p.conv_w = (const float*)d_in[9]; p.w_ao = (const float*)d_in[10];
  p.w_co = (const float*)d_in[11]; p.w_o = (const float*)d_in[12]; p.g_ffn = (const float*)d_in[13]; p.w_up = (const float*)d_in[14];
  p.w_dn = (const float*)d_in[15]; p.g_ple = (const float*)d_in[16]; p.w_pg = (const float*)d_in[17]; p.w_pl = (const float*)d_in[18];
  p.g_final = (const float*)d_in[19];
  p.out = (float*)d_out; p.ws = (unsigned char*)d_ws;
  (void)hipMemsetAsync((unsigned char*)d_ws + W_BAR, 0, XCD_BAR_WORDS * 4, stream);
  void* args[] = {&p};
  hipError_t e = hipLaunchCooperativeKernel((const void*)fwd_megakernel, dim3(grid_blocks), dim3(512), args, SHM_B, stream);
  if (e != hipSuccess) fprintf(stderr, "cooperative launch failed: %s (grid %d)\n", hipGetErrorString(e), grid_blocks);
}
```

```cpp
#include <hip/hip_runtime.h>
#include <hip/hip_cooperative_groups.h>
#include <cstdio>
#include <cstdint>
namespace cg = cooperative_groups;

#define DI __device__ __forceinline__
typedef unsigned short bf16_t;
typedef short bf16x8 __attribute__((ext_vector_type(8)));
typedef float f32x4 __attribute__((ext_vector_type(4)));
typedef float f32x2 __attribute__((ext_vector_type(2)));
typedef float f32x16 __attribute__((ext_vector_type(16)));
typedef unsigned u32x4 __attribute__((ext_vector_type(4)));
typedef unsigned u32x2 __attribute__((ext_vector_type(2)));
typedef __bf16 bf16v2 __attribute__((ext_vector_type(2)));

constexpr int D = 1024, NPROJ = 5120, MP = 32768, MS = 1024, M = MP + MS, SEQ = 8192, DSEQ = 32, PAST = 2048;
constexpr int NH = 8, HD = 64, SBW = 512, CW = 512, PLE = 256, DFF = 4096, P4W = 4096;
constexpr float EPS = 1e-6f;
constexpr size_t O_Y = 0, O_KP = (size_t)M * D, O_VP = O_KP + (size_t)MP * SBW, O_CP = O_VP + (size_t)MP * SBW,
                 O_KS = O_CP + 4 * 2 * CW, O_VS = O_KS + (size_t)MS * SBW, O_CS = O_VS + (size_t)MS * SBW;
constexpr size_t W_IN = 0, W_AO = W_IN + (size_t)NPROJ * D * 2, W_CO = W_AO + (size_t)D * SBW * 2, W_O = W_CO + (size_t)D * CW * 2,
                 W_UP = W_O + (size_t)D * D * 2, W_DN = W_UP + (size_t)DFF * D * 2, W_PG = W_DN + (size_t)D * DFF * 2,
                 W_PL = W_PG + (size_t)D * D * 2, W_RS0 = W_PL + (size_t)D * PLE * 2, W_SS = W_RS0 + (size_t)M * 4,
                 W_PB = W_SS + (size_t)3 * M * 4, W_RA = W_PB + (size_t)M * PLE * 2, W_RB = W_RA + (size_t)M * D * 2,
                 W_RC = W_RB + (size_t)M * D * 2, W_BAR = W_RC + (size_t)M * P4W * 2, W_PE = W_BAR + 16384, W_END = W_PE + (size_t)M * D * 2;

struct Params {
  const float *x_p, *x_s, *p_p, *p_s, *cache_k, *cache_v, *cache_conv;
  const float *g_mix, *w_in, *conv_w, *w_ao, *w_co, *w_o, *g_ffn, *w_up, *w_dn, *g_ple, *w_pg, *w_pl, *g_final;
  float* out; unsigned char* ws;
};

extern __shared__ __attribute__((aligned(16))) unsigned char dyn_lds[];

DI unsigned pk2(float lo, float hi) { f32x2 f = {lo, hi}; bf16v2 b = __builtin_convertvector(f, bf16v2); return __builtin_bit_cast(unsigned, b); }
DI float bf2f(unsigned h16) { return __uint_as_float(h16 << 16); }
DI float bflo(unsigned u) { return __uint_as_float(u << 16); }
DI float bfhi(unsigned u) { return __uint_as_float(u & 0xffff0000u); }
DI bf16x8 cvt8(f32x4 a, f32x4 b) { u32x4 u = {pk2(a.x, a.y), pk2(a.z, a.w), pk2(b.x, b.y), pk2(b.z, b.w)}; return __builtin_bit_cast(bf16x8, u); }
DI float sigmoidf_(float v) { return 1.f / (1.f + __expf(-v)); }
DI float wave_sum(float v) {
#pragma unroll
  for (int o = 1; o < 64; o <<= 1) v += __shfl_xor(v, o);
  return v;
}

constexpr int BM = 256, BK = 64, HALF = 128, NXCD = 8, WGM = 8, HT = HALF * BK, SHM_B = 8 * HT * 2;
DI int lds_byte(int r, int c) { int st = (r >> 4) * 2 + (c >> 5), rr = r & 15, cc = c & 31, ob = rr * 64 + cc * 2; return st * 1024 + (ob ^ (((ob >> 9) & 1) << 5)); }
DI void stage_rc(int b, int& R, int& C) { int st = b / 1024, sb = b % 1024, swz = sb ^ (((sb >> 9) & 1) << 5); R = (st >> 1) * 16 + swz / 64; C = (st & 1) * 32 + (swz % 64) / 2; }

DI bool tile_order(int i, int G, int c, int nM, int nN, int& pm, int& pn) {
  const int nwg = nM * nN; const long L = (long)i * G + c; if (L >= nwg) return false;
  int wgid = (int)L; { const int q = nwg / NXCD, r = nwg % NXCD, xcd = wgid % NXCD, off = wgid / NXCD; wgid = (xcd < r ? xcd * (q + 1) : r * (q + 1) + (xcd - r) * q) + off; }
  const int nig = WGM * nN, gid = wgid / nig, fm = gid * WGM, gsz = (nM - fm) < WGM ? (nM - fm) : WGM;
  pm = fm + ((wgid % nig) % gsz); pn = (wgid % nig) / gsz; return true;
}

typedef f32x4 acc_t[2][2][4][2];
DI void gemm_kloop(const bf16_t* __restrict__ A, const bf16_t* __restrict__ Bt, const int K, const int brow, const int bcol, acc_t& acc) {
  bf16_t* shm = (bf16_t*)dyn_lds;
  int tid = threadIdx.x; asm volatile("" : "+v"(tid));
#define SA(b, h) (shm + ((b) * 2 + (h)) * HT)
#define SB(b, h) (shm + (4 + (b) * 2 + (h)) * HT)
#define STAGE(P, BASE, br, kt) do { const char* _ub = (const char*)(BASE) + ((size_t)(br) * K + (size_t)(kt) * BK) * 2; \
    __builtin_amdgcn_global_load_lds((const unsigned*)(_ub + voff0), (unsigned*)((char*)(P) + wbase), 16, 0, 0); \
    __builtin_amdgcn_global_load_lds((const unsigned*)(_ub + voff1), (unsigned*)((char*)(P) + wbase + 8192), 16, 0, 0); } while (0)
#define LDA(dst, b, h) for (int m = 0; m < 4; ++m) for (int k = 0; k < 2; ++k) \
    dst[m][k] = *reinterpret_cast<const bf16x8*>((char*)SA(b, h) + lds_byte(wr * 64 + m * 16 + fr, k * 32 + fq * 8))
#define LDB(dst, b, h) for (int n = 0; n < 2; ++n) for (int k = 0; k < 2; ++k) \
    dst[n][k] = *reinterpret_cast<const bf16x8*>((char*)SB(b, h) + lds_byte(wc * 32 + n * 16 + fr, k * 32 + fq * 8))
#define MMA(ai, bj, At_, Bt_) do { __builtin_amdgcn_s_setprio(1); \
    for (int m = 0; m < 4; ++m) for (int n = 0; n < 2; ++n) for (int k = 0; k < 2; ++k) \
      acc[ai][bj][m][n] = __builtin_amdgcn_mfma_f32_16x16x32_bf16(Bt_[n][k], At_[m][k], acc[ai][bj][m][n], 0, 0, 0); \
    __builtin_amdgcn_s_setprio(0); } while (0)
#define WAIT_V(n) asm volatile("s_waitcnt vmcnt(" #n ")" ::: "memory")
#define WAIT_L(n) asm volatile("s_waitcnt lgkmcnt(" #n ")" ::: "memory")
#define BAR __builtin_amdgcn_s_barrier()
#define SCHED __builtin_amdgcn_sched_barrier(0)
  const int wid = tid >> 6, lane = tid & 63, wr = wid >> 2, wc = wid & 3, fr = lane & 15, fq = lane >> 4;
  bf16x8 At[4][2], B0[2][2], B1[2][2];
  const int nt = K / BK;
  const int wbase = __builtin_amdgcn_readfirstlane((tid & ~63) * 16);
  unsigned voff0, voff1;
  { int r_, c_; stage_rc(tid * 16, r_, c_); voff0 = (unsigned)(r_ * K + c_) * 2u; stage_rc(tid * 16 + 8192, r_, c_); voff1 = (unsigned)(r_ * K + c_) * 2u; }
  STAGE(SB(0, 0), Bt, bcol, 0); STAGE(SA(0, 0), A, brow, 0);
  STAGE(SB(0, 1), Bt, bcol + HALF, 0); STAGE(SA(0, 1), A, brow + HALF, 0);
  if (wr == 1) BAR;
  WAIT_V(4); BAR;
  STAGE(SB(1, 0), Bt, bcol, 1); STAGE(SA(1, 0), A, brow, 1); STAGE(SB(1, 1), Bt, bcol + HALF, 1);
  WAIT_V(6); BAR;
  for (int t = 0; t < nt - 2; t += 2) {
    LDB(B0, 0, 0); SCHED; LDA(At, 0, 0); STAGE(SA(1, 1), A, brow + HALF, t + 1);
    WAIT_L(8); BAR; WAIT_L(0); MMA(0, 0, At, B0); BAR; SCHED;
    LDB(B1, 0, 1); STAGE(SB(0, 0), Bt, bcol, t + 2);
    BAR; WAIT_L(0); MMA(0, 1, At, B1); BAR;
    LDA(At, 0, 1); STAGE(SA(0, 0), A, brow, t + 2);
    BAR; WAIT_L(0); MMA(1, 0, At, B0); BAR; SCHED;
    STAGE(SB(0, 1), Bt, bcol + HALF, t + 2);
    WAIT_V(6); BAR; MMA(1, 1, At, B1); BAR;
    LDB(B0, 1, 0); SCHED; LDA(At, 1, 0); STAGE(SA(0, 1), A, brow + HALF, t + 2);
    WAIT_L(8); BAR; WAIT_L(0); MMA(0, 0, At, B0); BAR; SCHED;
    LDB(B1, 1, 1); STAGE(SB(1, 0), Bt, bcol, t + 3);
    BAR; WAIT_L(0); MMA(0, 1, At, B1); BAR;
    LDA(At, 1, 1); STAGE(SA(1, 0), A, brow, t + 3);
    BAR; WAIT_L(0); MMA(1, 0, At, B0); BAR; SCHED;
    STAGE(SB(1, 1), Bt, bcol + HALF, t + 3);
    WAIT_V(6); BAR; MMA(1, 1, At, B1); BAR;
  }
  { LDB(B0, 0, 0); LDA(At, 0, 0); STAGE(SA(1, 1), A, brow + HALF, nt - 1);
    BAR; WAIT_L(0); MMA(0, 0, At, B0); BAR;
    LDB(B1, 0, 1); BAR; WAIT_L(0); MMA(0, 1, At, B1); BAR;
    LDA(At, 0, 1); WAIT_V(4); BAR; WAIT_L(0); MMA(1, 0, At, B0); MMA(1, 1, At, B1); BAR; }
  { LDB(B0, 1, 0); LDA(At, 1, 0); WAIT_V(2); BAR; WAIT_L(0); MMA(0, 0, At, B0); BAR;
    LDB(B1, 1, 1); WAIT_V(0); BAR; WAIT_L(0); MMA(0, 1, At, B1); BAR;
    LDA(At, 1, 1); BAR; WAIT_L(0); MMA(1, 0, At, B0); MMA(1, 1, At, B1); BAR; }
  if (wr == 0) BAR;
}
template <class F>
DI void epi_call(acc_t& acc, const int brow, const int bcol, const F& f) {
  int tid2 = threadIdx.x, brow2 = brow, bcol2 = bcol;
  asm volatile("" : "+v"(tid2), "+s"(brow2), "+s"(bcol2));
  const int wid2 = tid2 >> 6, lane2 = tid2 & 63;
  f(acc, brow2, bcol2, wid2 >> 2, wid2 & 3, lane2 & 15, lane2 >> 4);
}
template <class Epi>
DI void gemm_tile(const bf16_t* __restrict__ A, const bf16_t* __restrict__ Bt, const int K, const int brow, const int bcol, const Epi& epi) {
  acc_t acc = {};
  gemm_kloop(A, Bt, K, brow, bcol, acc);
  epi_call(acc, brow, bcol, epi);
}

template <class Epi>
DI void gemm_phase(const bf16_t* A, const bf16_t* Bt, int Mrows, int N, int K, const Epi& epi) {
  const int nM = Mrows / BM, nN = N / BM;
  for (int i = 0;; ++i) {
    int pm, pn; if (!tile_order(i, gridDim.x, blockIdx.x, nM, nN, pm, pn)) break;
    gemm_tile(A, Bt, K, pm * BM, pn * BM, epi);
  }
}

DI void st_bf16x4(bf16_t* p, f32x4 v) { u32x2 u = {pk2(v.x, v.y), pk2(v.z, v.w)}; *(u32x2*)p = u; }
DI f32x4 ld_bf16x4(const bf16_t* p) { u32x2 u = *(const u32x2*)p; f32x4 v = {bflo(u.x), bfhi(u.x), bflo(u.y), bfhi(u.y)}; return v; }

#define EPI_ROWS for (int ai = 0; ai < 2; ++ai) for (int m = 0; m < 4; ++m)
#define EPI_COLS for (int bj = 0; bj < 2; ++bj) for (int n = 0; n < 2; ++n)
#define EPI_BJ for (int bj = 0; bj < 2; ++bj)
#define EPI_ROW (brow + ai * HALF + wr * 64 + m * 16 + fr)
#define EPI_COL (bcol + bj * HALF + wc * 32 + n * 16 + fq * 4)
#define EPI_COL8 (bcol + bj * HALF + wc * 32 + fq * 8)
DI void st_bf16x8(bf16_t* p, f32x4 a, f32x4 b) { u32x4 u = {pk2(a.x, a.y), pk2(a.z, a.w), pk2(b.x, b.y), pk2(b.z, b.w)}; *(u32x4*)p = u; }
DI void unpack8(const u32x4 u, f32x4& a, f32x4& b) { a = (f32x4){bflo(u.x), bfhi(u.x), bflo(u.y), bfhi(u.y)}; b = (f32x4){bflo(u.z), bfhi(u.z), bflo(u.w), bfhi(u.w)}; }

struct EpiIn {
  const float* rs0; bf16_t* proj4; float* out;
  DI void operator()(const acc_t& acc, int brow, int bcol, int wr, int wc, int fr, int fq) const {
    float rr[2][4];
#pragma unroll
    EPI_ROWS rr[ai][m] = rs0[EPI_ROW];
    if (bcol >= 512 && bcol < 1536) {
#pragma unroll
      EPI_ROWS { const int row = EPI_ROW; const float r = rr[ai][m];
#pragma unroll
        EPI_COLS { const int col = EPI_COL; f32x4 v = acc[ai][bj][m][n] * r;
          const int isv = bcol >= 1024; const int c = col - (isv ? 1024 : 512);
          float* dst = (row < MP) ? out + (isv ? O_VP : O_KP) + (size_t)row * SBW + c : out + (isv ? O_VS : O_KS) + (size_t)(row - MP) * SBW + c;
          *(f32x4*)dst = v; } }
    } else if (bcol < 2048) {
      const float sc = (bcol < 512) ? 0.18033688011112042f   : 1.f; const int sh = (bcol < 512) ? 0 : 1024;
#pragma unroll
      EPI_ROWS { const int row = EPI_ROW; const float r = rr[ai][m] * sc;
#pragma unroll
        EPI_BJ { st_bf16x8(proj4 + (size_t)row * P4W + (EPI_COL8 - sh), acc[ai][bj][m][0] * r, acc[ai][bj][m][1] * r); } }
    } else {
      const bool gate = bcol >= 3072; const int t = ((bcol - (gate ? 3072 : 2048)) >> 8) * 128;
#pragma unroll
      EPI_ROWS { const int row = EPI_ROW; const float r = rr[ai][m]; const int ch = t + wc * 32 + fq * 8;
        const f32x4 a0 = acc[ai][0][m][0] * r, a1 = acc[ai][0][m][1] * r, b0 = acc[ai][1][m][0] * r, b1 = acc[ai][1][m][1] * r;
        if (!gate) { st_bf16x8(proj4 + (size_t)row * P4W + 1024 + ch, a0 * b0, a1 * b1); }
        else { f32x4 rho0, rho1, sg0, sg1;
#pragma unroll
          for (int e = 0; e < 4; ++e) {
            { const float ea = __expf(-a0[e]), eb = __expf(-fmaxf(b0[e], -80.f)); sg0[e] = 1.f / (1.f + eb); rho0[e] = (1.f + eb) / (1.f + ea); }
            { const float ea = __expf(-a1[e]), eb = __expf(-fmaxf(b1[e], -80.f)); sg1[e] = 1.f / (1.f + eb); rho1[e] = (1.f + eb) / (1.f + ea); } }
          st_bf16x8(proj4 + (size_t)row * P4W + 2048 + ch, rho0, rho1); st_bf16x8(proj4 + (size_t)row * P4W + 3072 + ch, sg0, sg1); } }
    }
  }
};
template <bool FINAL>
struct EpiGate {
  const bf16_t* proj4; int off; bf16_t* merged;
  DI void operator()(acc_t& acc, int brow, int bcol, int wr, int wc, int fr, int fq) const {
    u32x4 g[2][4][2];
#pragma unroll
    EPI_ROWS { const int row = EPI_ROW;
#pragma unroll
      EPI_BJ g[ai][m][bj] = *(const u32x4*)(proj4 + (size_t)row * P4W + off + EPI_COL8); }
#pragma unroll
    EPI_ROWS { const int row = EPI_ROW;
#pragma unroll
      EPI_BJ { f32x4 g0, g1; unpack8(g[ai][m][bj], g0, g1);
        if (FINAL) st_bf16x8(merged + (size_t)row * D + EPI_COL8, acc[ai][bj][m][0] * g0, acc[ai][bj][m][1] * g1);
        else { acc[ai][bj][m][0] *= g0; acc[ai][bj][m][1] *= g1; } } }
  }
};
template <int MODE>
struct EpiRes {
  const float *x_p, *x_s; const bf16_t* resb; bf16_t* outb; float* ss; const float* ssprev; const bf16_t* pe;
  DI void operator()(const acc_t& acc, int brow, int bcol, int wr, int wc, int fr, int fq) const {
#pragma unroll
    for (int ai = 0; ai < 2; ++ai) {
      f32x4 resf[4][2][2]; u32x4 resh[4][2], peh[4][2]; float rr[4];
#pragma unroll
      for (int m = 0; m < 4; ++m) { const int row = EPI_ROW;
        if (MODE == 2) rr[m] = ssprev[row];
#pragma unroll
        EPI_BJ { const int col = EPI_COL8;
          if (MODE == 0) { const float* xp = (row < MP) ? x_p + (size_t)row * D + col : x_s + (size_t)(row - MP) * D + col;
            resf[m][bj][0] = *(const f32x4*)xp; resf[m][bj][1] = *(const f32x4*)(xp + 4); }
          else resh[m][bj] = *(const u32x4*)(resb + (size_t)row * D + col);
          if (MODE == 2) peh[m][bj] = *(const u32x4*)(pe + (size_t)row * D + col); } }
#pragma unroll
      for (int m = 0; m < 4; ++m) { const int row = EPI_ROW; float part = 0.f; float r = 0.f;
        if (MODE == 2) r = rsqrtf(rr[m] * (1.f / D) + EPS);
#pragma unroll
        EPI_BJ { const int col = EPI_COL8; f32x4 a0 = acc[ai][bj][m][0], a1 = acc[ai][bj][m][1]; f32x4 r0, r1;
          if (MODE == 0) { r0 = resf[m][bj][0]; r1 = resf[m][bj][1]; } else unpack8(resh[m][bj], r0, r1);
          if (MODE == 2) { f32x4 e0, e1; unpack8(peh[m][bj], e0, e1); a0 = a0 * r; a1 = a1 * r;
            const f32x4 s0 = {sigmoidf_(a0.x), sigmoidf_(a0.y), sigmoidf_(a0.z), sigmoidf_(a0.w)}, s1 = {sigmoidf_(a1.x), sigmoidf_(a1.y), sigmoidf_(a1.z), sigmoidf_(a1.w)};
            a0 = s0 * e0; a1 = s1 * e1; }
          const f32x4 o0 = r0 + a0, o1 = r1 + a1;
          st_bf16x8(outb + (size_t)row * D + col, o0, o1);
          part += (o0.x * o0.x + o0.y * o0.y + o0.z * o0.z + o0.w * o0.w) + (o1.x * o1.x + o1.y * o1.y + o1.z * o1.z + o1.w * o1.w); }
        part += __shfl_xor(part, 16); part += __shfl_xor(part, 32);
        if (fq == 0) atomicAdd(ss + row, part); }
    }
  }
};
struct EpiUp {
  const float* ss1; bf16_t* u;
  DI void operator()(const acc_t& acc, int brow, int bcol, int wr, int wc, int fr, int fq) const {
    float rr[2][4];
#pragma unroll
    EPI_ROWS rr[ai][m] = ss1[EPI_ROW];
#pragma unroll
    EPI_ROWS { const int row = EPI_ROW; const float r = rsqrtf(rr[ai][m] * (1.f / D) + EPS);
#pragma unroll
      EPI_BJ { f32x4 a0 = acc[ai][bj][m][0] * r, a1 = acc[ai][bj][m][1] * r;
        const f32x4 z0 = {fmaxf(a0.x, 0.f), fmaxf(a0.y, 0.f), fmaxf(a0.z, 0.f), fmaxf(a0.w, 0.f)}, z1 = {fmaxf(a1.x, 0.f), fmaxf(a1.y, 0.f), fmaxf(a1.z, 0.f), fmaxf(a1.w, 0.f)};
        st_bf16x8(u + (size_t)row * DFF + EPI_COL8, z0 * z0, z1 * z1); } }
  }
};
struct EpiPe {
  bf16_t* pe;
  DI void operator()(const acc_t& acc, int brow, int bcol, int wr, int wc, int fr, int fq) const {
#pragma unroll
    EPI_ROWS { const int row = EPI_ROW;
#pragma unroll
      EPI_BJ { st_bf16x8(pe + (size_t)row * D + EPI_COL8, acc[ai][bj][m][0], acc[ai][bj][m][1]); } }
  }
};

DI int win_perm(int n) {
  if (n < 2048) return n;
  if (n < 3072) { const int r = n - 2048, c = r & 511; return 2048 + 256 * (c >> 7) + ((r >> 9) ? 128 : 0) + (c & 127); }
  const int r = n - 3072, c = r & 1023; return 3072 + 256 * (c >> 7) + ((r >> 10) ? 128 : 0) + (c & 127);
}
template <bool PERM>
DI void transpose_item(const float* __restrict__ W, const float* __restrict__ g, int K, int N, bf16_t* __restrict__ WT, float* scr, int item, int lane) {
  const int nblk = N / 32, kb = item / nblk, nb = item % nblk, k0 = 64 * kb, n0 = 32 * nb;
  const int n0d = PERM ? win_perm(n0) : n0;
  const bool p32 = !(PERM && n0 >= 512 && n0 < 1536);
  float wv[32];
#pragma unroll
  for (int i = 0; i < 32; ++i) { const int kk = 2 * i + (lane >> 5); wv[i] = W[(size_t)(k0 + kk) * N + n0 + (lane & 31)]; }
  if (g) {
#pragma unroll
    for (int i = 0; i < 32; ++i) wv[i] *= g[k0 + 2 * i + (lane >> 5)]; }
#pragma unroll
  for (int i = 0; i < 32; ++i) scr[(2 * i + (lane >> 5)) * 33 + (lane & 31)] = wv[i];
  asm volatile("s_waitcnt lgkmcnt(0)" ::: "memory");
  const int c = lane & 7;
#pragma unroll
  for (int j = 0; j < 4; ++j) { const int n = (lane >> 3) + 8 * j; const int ns = p32 ? (8 * ((n & 15) >> 2) + 4 * (n >> 4) + (n & 3)) : n; const float* s = scr + (8 * c) * 33 + ns;
    u32x4 o = {pk2(s[0 * 33], s[1 * 33]), pk2(s[2 * 33], s[3 * 33]), pk2(s[4 * 33], s[5 * 33]), pk2(s[6 * 33], s[7 * 33])};
    *(u32x4*)(WT + (size_t)(n0d + n) * K + k0 + 8 * c) = o; }
  asm volatile("s_waitcnt lgkmcnt(0)" ::: "memory");
}

#define MFMA32(a, b, c) __builtin_amdgcn_mfma_f32_32x32x16_bf16((a), (b), (c), 0, 0, 0)
DI void attn_load(const float* __restrict__ Kp, const float* __restrict__ Vp, int i, int half, f32x4 (&kr)[8], float (&vr)[32]) {
#pragma unroll
  for (int s = 0; s < 4; ++s) { const f32x4* kp = (const f32x4*)(Kp + (size_t)i * SBW + 16 * s + 8 * half); kr[2 * s] = kp[0]; kr[2 * s + 1] = kp[1]; }
#pragma unroll
  for (int s = 0; s < 2; ++s)
#pragma unroll
    for (int jj = 0; jj < 8; ++jj) { const int key = 16 * s + 8 * (jj >> 2) + 4 * half + (jj & 3);
      vr[(2 * s) * 8 + jj] = Vp[(size_t)key * SBW + i]; vr[(2 * s + 1) * 8 + jj] = Vp[(size_t)key * SBW + 32 + i]; }
}
template <bool DIAG>
DI void attn_weights(const f32x16& sacc, int i, int half, float& C, float (&a)[16]) {
  float be[16], om[16];
#pragma unroll
  for (int r = 0; r < 16; ++r) { const float z = sacc[r];
    const float e = __builtin_amdgcn_exp2f(-fabsf(z)), rc = __builtin_amdgcn_rcpf(1.f + e), er = e * rc;
    float b = (z >= 0.f) ? rc : er, o = (z >= 0.f) ? er : rc;
    if (DIAG) { const int key = (r & 3) + 8 * (r >> 2) + 4 * half; const bool valid = key < i; b = valid ? b : 0.f; o = valid ? o : 1.f; }
    be[r] = b; om[r] = o; }
  float G[4], Pn[4];
#pragma unroll
  for (int g = 0; g < 4; ++g) { G[g] = (om[4 * g] * om[4 * g + 1]) * (om[4 * g + 2] * om[4 * g + 3]); Pn[g] = __shfl_xor(G[g], 32); }
  float run = C;
#pragma unroll
  for (int g = 3; g >= 0; --g) { float t = half ? run : run * Pn[g];
#pragma unroll
    for (int u = 3; u >= 0; --u) { a[4 * g + u] = be[4 * g + u] * t; t *= om[4 * g + u]; }
    run *= G[g] * Pn[g]; }
  C = run;
}
DI void attn_task(const Params& p, const int qb, const int h, int lane) {
  const bf16_t* proj4 = (const bf16_t*)(p.ws + W_RC);
  bf16_t* attn = (bf16_t*)(p.ws + W_RB);
  const int i = lane & 31, half = lane >> 5;
  int qtok0, nblk; const float *k0p, *v0p, *k1p, *v1p;
  if (qb < MP / 32) { const int b = qb >> 8, t0 = (qb & 255) * 32; qtok0 = b * SEQ + t0; nblk = (t0 >> 5) + 1;
    k0p = p.out + O_KP + (size_t)qtok0 * SBW; v0p = p.out + O_VP + (size_t)qtok0 * SBW; k1p = k0p; v1p = v0p; }
  else { const int b = qb - MP / 32; qtok0 = MP + b * DSEQ; nblk = 1 + PAST / 32;
    k0p = p.out + O_KS + (size_t)(b * DSEQ) * SBW; v0p = p.out + O_VS + (size_t)(b * DSEQ) * SBW;
    k1p = p.cache_k + (size_t)(b * PAST + PAST) * SBW; v1p = p.cache_v + (size_t)(b * PAST + PAST) * SBW; }
  k0p += h * HD; v0p += h * HD; k1p += h * HD; v1p += h * HD;
  bf16x8 qf[4];
  { const bf16_t* qp = proj4 + (size_t)(qtok0 + i) * P4W + h * HD + 8 * half;
#pragma unroll
    for (int s = 0; s < 4; ++s) qf[s] = *(const bf16x8*)(qp + 16 * s); }
  f32x16 o0 = {}, o1 = {};
  float C = 1.f;
  f32x4 kr[8]; float vr[32];
  bf16x8 kf[4], vf[4];
#define ATTN_CVT() do { _Pragma("unroll") for (int s = 0; s < 4; ++s) kf[s] = cvt8(kr[2 * s], kr[2 * s + 1]); \
    _Pragma("unroll") for (int q = 0; q < 4; ++q) { u32x4 v = {pk2(vr[8 * q], vr[8 * q + 1]), pk2(vr[8 * q + 2], vr[8 * q + 3]), pk2(vr[8 * q + 4], vr[8 * q + 5]), pk2(vr[8 * q + 6], vr[8 * q + 7])}; \
      vf[q] = __builtin_bit_cast(bf16x8, v); } } while (0)
  attn_load(k0p, v0p, i, half, kr, vr);
  ATTN_CVT();
  for (int it = 0; it < nblk; ++it) {
    { const int itn = (it + 1 < nblk) ? it + 1 : it;
      attn_load(k1p - (size_t)itn * 32 * SBW, v1p - (size_t)itn * 32 * SBW, i, half, kr, vr); }
    __builtin_amdgcn_sched_barrier(0);
    f32x16 sacc = {};
#pragma unroll
    for (int s = 0; s < 4; ++s) sacc = MFMA32(kf[s], qf[s], sacc);
    float a[16];
    if (it == 0) attn_weights<true>(sacc, i, half, C, a); else attn_weights<false>(sacc, i, half, C, a);
#pragma unroll
    for (int s = 0; s < 2; ++s) {
      u32x4 pu = {pk2(a[8 * s], a[8 * s + 1]), pk2(a[8 * s + 2], a[8 * s + 3]), pk2(a[8 * s + 4], a[8 * s + 5]), pk2(a[8 * s + 6], a[8 * s + 7])};
      const bf16x8 pf = __builtin_bit_cast(bf16x8, pu);
      o0 = MFMA32(vf[2 * s], pf, o0);
      o1 = MFMA32(vf[2 * s + 1], pf, o1); }
    if (__all(C == 0.f)) break;
    __builtin_amdgcn_sched_barrier(0);
    ATTN_CVT();
  }
  bf16_t* op = attn + (size_t)(qtok0 + i) * SBW + h * HD + 4 * half;
#pragma unroll
  for (int g = 0; g < 4; ++g) {
    f32x4 a0 = {o0[4 * g], o0[4 * g + 1], o0[4 * g + 2], o0[4 * g + 3]}; st_bf16x4(op + 8 * g, a0);
    f32x4 a1 = {o1[4 * g], o1[4 * g + 1], o1[4 * g + 2], o1[4 * g + 3]}; st_bf16x4(op + 32 + 8 * g, a1); }
}

DI void conv_items(const Params& p) {
  const bf16_t* proj4 = (const bf16_t*)(p.ws + W_RC);
  bf16_t* convg = (bf16_t*)(p.ws + W_RB) + (size_t)M * SBW;
  const int total = (M / 8) * (CW / 8);
  for (int idx = blockIdx.x * blockDim.x + threadIdx.x; idx < total; idx += gridDim.x * blockDim.x) {
    const int tok0 = (idx >> 6) * 8, c0 = (idx & 63) * 8;
    int b, t0, T; const float* buf; float* nb;
    if (tok0 < MP) { b = tok0 >> 13; t0 = tok0 & (SEQ - 1); T = SEQ; buf = nullptr; nb = p.out + O_CP + (size_t)b * 2 * CW; }
    else { const int s = tok0 - MP; b = s >> 5; t0 = s & (DSEQ - 1); T = DSEQ; buf = p.cache_conv + (size_t)b * 2 * CW; nb = p.out + O_CS + (size_t)b * 2 * CW; }
    const bf16_t* row = proj4 + (size_t)tok0 * P4W + c0;
    u32x4 ur[10], cr[8];
#pragma unroll
    for (int j = 0; j < 8; ++j) { ur[j + 2] = *(const u32x4*)(row + (size_t)j * P4W + 1024); cr[j] = *(const u32x4*)(row + (size_t)j * P4W + 512); }
    float w0[8], w1[8], w2[8];
#pragma unroll
    for (int e = 0; e < 8; ++e) { w0[e] = p.conv_w[c0 + e]; w1[e] = p.conv_w[CW + c0 + e]; w2[e] = p.conv_w[2 * CW + c0 + e]; }
    float um2[8], um1[8];
    if (t0 > 0) { const u32x4 x2 = *(const u32x4*)(row - 2 * (size_t)P4W + 1024), x1 = *(const u32x4*)(row - (size_t)P4W + 1024);
#pragma unroll
      for (int e = 0; e < 4; ++e) { um2[2 * e] = bflo(x2[e]); um2[2 * e + 1] = bfhi(x2[e]); um1[2 * e] = bflo(x1[e]); um1[2 * e + 1] = bfhi(x1[e]); } }
    else {
#pragma unroll
      for (int e = 0; e < 8; ++e) { um2[e] = buf ? buf[c0 + e] : 0.f; um1[e] = buf ? buf[CW + c0 + e] : 0.f; } }
#pragma unroll
    for (int j = 0; j < 8; ++j) {
      float u0[8], cbv[8], o[8];
#pragma unroll
      for (int e = 0; e < 4; ++e) { u0[2 * e] = bflo(ur[j + 2][e]); u0[2 * e + 1] = bfhi(ur[j + 2][e]); cbv[2 * e] = bflo(cr[j][e]); cbv[2 * e + 1] = bfhi(cr[j][e]); }
#pragma unroll
      for (int e = 0; e < 8; ++e) o[e] = cbv[e] * (w0[e] * um2[e] + w1[e] * um1[e] + w2[e] * u0[e]);
      u32x4 ov = {pk2(o[0], o[1]), pk2(o[2], o[3]), pk2(o[4], o[5]), pk2(o[6], o[7])};
      *(u32x4*)(convg + (size_t)(tok0 + j) * CW + c0) = ov;
      if (t0 + j >= T - 2) { float* d = nb + (size_t)(t0 + j - (T - 2)) * CW + c0;
#pragma unroll
        for (int e = 0; e < 8; ++e) d[e] = u0[e]; }
#pragma unroll
      for (int e = 0; e < 8; ++e) { um2[e] = um1[e]; um1[e] = u0[e]; }
    }
  }
}

#define XB_TMO      128
#define XB_XCNT(j)  (256  + 64 * (j))
#define XB_XSUB(j)  (1280 + 64 * (j))
#define XB_XGEN(j)  (2304 + 64 * (j))
#define XB_TOP      3328
#define XB_TOPGEN   3392
#define XCD_BAR_WORDS 3456
#define XB_SPIN_CAP (1u << 18)
#define LAS __attribute__((address_space(3)))
DI unsigned xb_ld(unsigned* p) { return __hip_atomic_load(p, __ATOMIC_RELAXED, __HIP_MEMORY_SCOPE_AGENT); }
DI unsigned xb_add(unsigned* p, unsigned v) { return __hip_atomic_fetch_add(p, v, __ATOMIC_RELAXED, __HIP_MEMORY_SCOPE_AGENT); }
DI unsigned xb_xcc_id() { return (unsigned)__builtin_amdgcn_s_getreg((3 << 11) | 20) & 0xFu; }
#define XB_SPIN(cond, bar) do { unsigned _sp = 0; while (cond) { __builtin_amdgcn_s_sleep(1); \
    if ((++_sp & 255u) == 0u) { if (xb_ld(&(bar)[XB_TMO])) break; if (_sp > XB_SPIN_CAP) { atomicAdd(&(bar)[XB_TMO], 1u); break; } } } } while (0)
struct XcdBarrier { unsigned* bar; unsigned x; volatile LAS unsigned* st; };
DI XcdBarrier xcd_barrier_post(unsigned* bar, volatile LAS unsigned* st) {
  XcdBarrier b; b.bar = bar; b.x = xb_xcc_id(); b.st = st;
  if (threadIdx.x == 0) (void)xb_add(&bar[XB_XCNT(b.x)], 1u);
  return b;
}
DI void xcd_barrier_complete(unsigned* bar, unsigned x, unsigned& nloc, unsigned& nx) {
  const unsigned G = gridDim.x * gridDim.y * gridDim.z;
  unsigned sum, cnt, mine, sp = 0u;
  for (;;) {
    sum = 0u; cnt = 0u; mine = 0u;
#pragma unroll
    for (unsigned j = 0; j < 16; ++j) { const unsigned c = xb_ld(&bar[XB_XCNT(j)]); sum += c; cnt += (c > 0u) ? 1u : 0u; mine = (j == x) ? c : mine; }
    if (sum == G) break;
    __builtin_amdgcn_s_sleep(1);
    if ((++sp & 255u) == 0u) { if (xb_ld(&bar[XB_TMO])) break; if (sp > XB_SPIN_CAP) { atomicAdd(&bar[XB_TMO], 1u); break; } }
  }
  nloc = mine > 0u ? mine : 1u; nx = cnt > 0u ? cnt : 1u;
}
DI void xcd_barrier(const XcdBarrier& b) {
  asm volatile("s_waitcnt vmcnt(0)" ::: "memory");
  __syncthreads();
  if (threadIdx.x == 0) {
    unsigned* bar = b.bar;
    __builtin_amdgcn_s_waitcnt(0);
    unsigned nloc = b.st[0], nx = b.st[1];
    if (nloc == 0u) { xcd_barrier_complete(bar, b.x, nloc, nx); b.st[0] = nloc; b.st[1] = nx; }
    const unsigned old = xb_add(&bar[XB_XSUB(b.x)], 1u);
    const unsigned gen = old / nloc;
    if (old + 1u == (gen + 1u) * nloc) {
      __builtin_amdgcn_fence(__ATOMIC_RELEASE, "agent");
      asm volatile("s_waitcnt vmcnt(0)" ::: "memory");
      const unsigned og = xb_add(&bar[XB_TOP], 1u);
      const unsigned tg = og / nx;
      if (og + 1u == (tg + 1u) * nx) xb_add(&bar[XB_TOPGEN], 1u);
      else XB_SPIN(xb_ld(&bar[XB_TOPGEN]) == tg, bar);
      __builtin_amdgcn_fence(__ATOMIC_ACQUIRE, "agent");
      xb_add(&bar[XB_XGEN(b.x)], 1u);
      asm volatile("s_waitcnt vmcnt(0)" ::: "memory");
    } else {
      XB_SPIN(xb_ld(&bar[XB_XGEN(b.x)]) == gen, bar);
      __builtin_amdgcn_fence(__ATOMIC_ACQUIRE, "agent");
      asm volatile("s_waitcnt vmcnt(0)" ::: "memory");
    }
  }
  __syncthreads();
}

__global__ void __launch_bounds__(512, 2) fwd_megakernel(Params p) {
  cg::grid_group grid = cg::this_grid();
  const int lane = threadIdx.x & 63, wave = threadIdx.x >> 6;
  const int gw = blockIdx.x * 8 + wave, NGW = gridDim.x * 8;
  const int gtid = blockIdx.x * blockDim.x + threadIdx.x, NT = gridDim.x * blockDim.x;
  unsigned char* ws = p.ws;
  bf16_t *wInT = (bf16_t*)(ws + W_IN), *wAoT = (bf16_t*)(ws + W_AO), *wCoT = (bf16_t*)(ws + W_CO), *wOT = (bf16_t*)(ws + W_O),
         *wUpT = (bf16_t*)(ws + W_UP), *wDnT = (bf16_t*)(ws + W_DN), *wPgT = (bf16_t*)(ws + W_PG), *wPlT = (bf16_t*)(ws + W_PL);
  float* rs0 = (float*)(ws + W_RS0); float* ss = (float*)(ws + W_SS);
  bf16_t* PE = (bf16_t*)(ws + W_PE);
  bf16_t *pb = (bf16_t*)(ws + W_PB), *RA = (bf16_t*)(ws + W_RA), *RB = (bf16_t*)(ws + W_RB), *RC = (bf16_t*)(ws + W_RC);
  float* y = p.out + O_Y;
  __shared__ uint4 xb_words;
  if (threadIdx.x == 0) xb_words = make_uint4(0u, 0u, 0u, 0u);
  __syncthreads();
  const XcdBarrier xb = xcd_barrier_post((unsigned*)(ws + W_BAR), (volatile LAS unsigned*)&xb_words);

  {
    float* scr = (float*)dyn_lds + wave * (64 * 33);
    constexpr int I0 = (D / 64) * (NPROJ / 32), I1 = (SBW / 64) * (D / 32), I2 = I1, I3 = (D / 64) * (D / 32), I4 = (D / 64) * (DFF / 32),
                  I5 = (DFF / 64) * (D / 32), I6 = I3, I7 = (PLE / 64) * (D / 32), NI = I0 + I1 + I2 + I3 + I4 + I5 + I6 + I7;
    for (int it = gw; it < NI; it += NGW) {
      int r = it;
      if (r < I0) { transpose_item<true>(p.w_in, p.g_mix, D, NPROJ, wInT, scr, r, lane); continue; } r -= I0;
      if (r < I1) { transpose_item<false>(p.w_ao, nullptr, SBW, D, wAoT, scr, r, lane); continue; } r -= I1;
      if (r < I2) { transpose_item<false>(p.w_co, nullptr, CW, D, wCoT, scr, r, lane); continue; } r -= I2;
      if (r < I3) { transpose_item<false>(p.w_o, nullptr, D, D, wOT, scr, r, lane); continue; } r -= I3;
      if (r < I4) { transpose_item<false>(p.w_up, p.g_ffn, D, DFF, wUpT, scr, r, lane); continue; } r -= I4;
      if (r < I5) { transpose_item<false>(p.w_dn, nullptr, DFF, D, wDnT, scr, r, lane); continue; } r -= I5;
      if (r < I6) { transpose_item<false>(p.w_pg, p.g_ple, D, D, wPgT, scr, r, lane); continue; } r -= I6;
      transpose_item<false>(p.w_pl, nullptr, PLE, D, wPlT, scr, r, lane);
    }
    for (int row0 = gw * 4; row0 < M; row0 += NGW * 4) {
      f32x4 v[4][4];
#pragma unroll
      for (int q = 0; q < 4; ++q) { const int row = row0 + q;
        const float* xr = (row < MP) ? p.x_p + (size_t)row * D : p.x_s + (size_t)(row - MP) * D;
        const f32x4* x4 = (const f32x4*)xr + lane;
#pragma unroll
        for (int j = 0; j < 4; ++j) v[q][j] = x4[64 * j]; }
#pragma unroll
      for (int q = 0; q < 4; ++q) { const int row = row0 + q; float sq = 0.f;
#pragma unroll
        for (int j = 0; j < 4; ++j) sq += (v[q][j].x * v[q][j].x + v[q][j].y * v[q][j].y) + (v[q][j].z * v[q][j].z + v[q][j].w * v[q][j].w);
        sq = wave_sum(sq);
        if (lane == 0) rs0[row] = rsqrtf(sq * (1.f / D) + EPS);
        u32x2* o8 = (u32x2*)(RA + (size_t)row * D) + lane;
#pragma unroll
        for (int j = 0; j < 4; ++j) { u32x2 o = {pk2(v[q][j].x, v[q][j].y), pk2(v[q][j].z, v[q][j].w)}; o8[64 * j] = o; } }
    }
    for (int idx0 = gtid; idx0 < M * PLE / 4; idx0 += NT * 4) {
      f32x4 v[4];
#pragma unroll
      for (int q = 0; q < 4; ++q) { const int idx = idx0 + q * NT; if (idx < M * PLE / 4) { const size_t e = (size_t)idx * 4;
          v[q] = *(const f32x4*)((e < (size_t)MP * PLE) ? p.p_p + e : p.p_s + (e - (size_t)MP * PLE)); } }
#pragma unroll
      for (int q = 0; q < 4; ++q) { const int idx = idx0 + q * NT; if (idx < M * PLE / 4) st_bf16x4(pb + (size_t)idx * 4, v[q]); }
    }
    for (int idx = gtid; idx < 3 * M; idx += NT) ss[idx] = 0.f;
  }
  if (p.ws == nullptr) grid.sync();
  xcd_barrier(xb);
  { EpiIn e{rs0, RC, p.out}; gemm_phase(RA, wInT, M, NPROJ, D, e); }
  { const int G = gridDim.x, ntl = (M / BM) * (NPROJ / BM), rem = ntl % G, c = blockIdx.x;
    const int nidle = (rem == 0) ? G : G - rem, q = (rem == 0) ? c : c - rem;
    if (q >= 0) { EpiPe e{PE};
      for (int t = q; t < (M / BM) * (D / BM); t += nidle) gemm_tile(pb, wPlT, PLE, (t >> 2) * BM, (t & 3) * BM, e); } }
  xcd_barrier(xb);
  { constexpr int NU = (MP / 32 / 8) * NH;
    const int upb = (NU + gridDim.x - 1) / gridDim.x;
    for (int j = 0; j < upb; ++j) { const int u = blockIdx.x * upb + j; if (u >= NU) break;
      const int bh = u >> 5, g = u & 31; attn_task(p, (bh >> 3) * (SEQ / 32) + g * 8 + wave, bh & 7, lane); }
    for (int sb = 0; sb < MS / DSEQ; ++sb) if ((sb * 8 + (sb & 7)) % gridDim.x == blockIdx.x) attn_task(p, MP / 32 + sb, wave, lane); }
  conv_items(p);
  xcd_barrier(xb);
  {
    const int nM = M / BM, nN = D / BM;
    for (int i = 0;; ++i) { int pm, pn; if (!tile_order(i, gridDim.x, blockIdx.x, nM, nN, pm, pn)) break;
      acc_t acc = {};
      gemm_kloop(RB, wAoT, SBW, pm * BM, pn * BM, acc);
      { EpiGate<false> e{RC, 2048, nullptr}; epi_call(acc, pm * BM, pn * BM, e); }
      gemm_kloop(RB + (size_t)M * SBW, wCoT, CW, pm * BM, pn * BM, acc);
      { EpiGate<true> e{RC, 3072, RA}; epi_call(acc, pm * BM, pn * BM, e); } }
  }
  xcd_barrier(xb);
  { EpiRes<0> e{p.x_p, p.x_s, nullptr, RB, ss, nullptr, nullptr}; gemm_phase(RA, wOT, M, D, D, e); }
  xcd_barrier(xb);
  { EpiUp e{ss, RC}; gemm_phase(RB, wUpT, M, DFF, D, e); }
  xcd_barrier(xb);
  { EpiRes<1> e{nullptr, nullptr, RB, RA, ss + M, nullptr, nullptr}; gemm_phase(RC, wDnT, M, D, DFF, e); }
  xcd_barrier(xb);
  { EpiRes<2> e{nullptr, nullptr, RA, RC, ss + 2 * M, ss + M, PE}; gemm_phase(RA, wPgT, M, D, D, e); }
  xcd_barrier(xb);
  for (int idx0 = gtid; idx0 < M * (D / 8); idx0 += NT * 4) {
    u32x4 xv[4]; float rv[4];
#pragma unroll
    for (int q = 0; q < 4; ++q) { const int idx = idx0 + q * NT; if (idx < M * (D / 8)) { const int row = idx >> 7, c = (idx & 127) * 8;
        xv[q] = *(const u32x4*)(RC + (size_t)row * D + c); rv[q] = ss[2 * M + row]; } }
#pragma unroll
    for (int q = 0; q < 4; ++q) { const int idx = idx0 + q * NT; if (idx < M * (D / 8)) { const int row = idx >> 7, c = (idx & 127) * 8;
        const float r = rsqrtf(rv[q] * (1.f / D) + EPS); f32x4 a0, a1; unpack8(xv[q], a0, a1);
        const f32x4 g0 = *(const f32x4*)(p.g_final + c), g1 = *(const f32x4*)(p.g_final + c + 4);
        *(f32x4*)(y + (size_t)row * D + c) = a0 * r * g0; *(f32x4*)(y + (size_t)row * D + c + 4) = a1 * r * g1; } }
  }
}

extern "C" void kernel_launch(void* const* d_in, const int* in_sizes, int n_in, void* d_out, int out_size, void* d_ws, size_t ws_size, hipStream_t stream) {
  static int grid_blocks = 0;
  if (grid_blocks == 0) {
    if (ws_size < W_END) { fprintf(stderr, "kernel_launch: workspace too small (%zu < %zu)\n", ws_size, (size_t)W_END); grid_blocks = -1; return; }
    int dev = 0, cus = 0, per_cu = 0;
    hipGetDevice(&dev);
    hipDeviceGetAttribute(&cus, hipDeviceAttributeMultiprocessorCount, dev);
    hipFuncSetAttribute((const void*)fwd_megakernel, hipFuncAttributeMaxDynamicSharedMemorySize, SHM_B);
    hipOccupancyMaxActiveBlocksPerMultiprocessor(&per_cu, (const void*)fwd_megakernel, 512, SHM_B);
    if (per_cu < 1) { fprintf(stderr, "kernel_launch: occupancy query says %d blocks/CU\n", per_cu); per_cu = 1; }
    grid_blocks = cus;
  }
  if (grid_blocks < 0) return;
  Params p{};
  p.x_p = (const float*)d_in[0]; p.x_s = (const float*)d_in[1]; p.p_p = (const float*)d_in[2]; p.p_s = (const float*)d_in[3];
  p.cache_k = (const float*)d_in[4]; p.cache_v = (const float*)d_in[5]; p.cache_conv = (const float*)d_in[6];
  p.g_mix = (const float*)d_in[7]; p.w_in = (const float*)d_in[8]; p.conv_w = (const float*)d_in[9]; p.w_ao = (const float*)d_in[10];
  p.w_co = (const float*)d_in[11]; p.w_o = (const float*)d_in[12]; p.g_ffn = (const float*)d_in[13]; p.w_up = (const float*)d_in[14];
  p.w_dn = (const float*)d_in[15]; p.g_ple = (const float*)d_in[16]; p.w_pg = (const float*)d_in[17]; p.w_pl = (const float*)d_in[18];
  p.g_final = (const float*)d_in[19];
  p.out = (float*)d_out; p.ws = (unsigned char*)d_ws;
  (void)hipMemsetAsync((unsigned char*)d_ws + W_BAR, 0, XCD_BAR_WORDS * 4, stream);
  void* args[] = {&p};
  hipError_t e = hipLaunchCooperativeKernel((const void*)fwd_megakernel, dim3(grid_blocks), dim3(512), args, SHM_B, stream);
  if (e != hipSuccess) fprintf(stderr, "cooperative launch failed: %s (grid %d)\n", hipGetErrorString(e), grid_blocks);
}
```

```cpp
#include <hip/hip_runtime.h>
#include <hip/hip_cooperative_groups.h>
#include <cstdio>
#include <cstdint>
namespace cg = cooperative_groups;

#define DI __device__ __forceinline__
typedef unsigned short bf16_t;
typedef short bf16x8 __attribute__((ext_vector_type(8)));
typedef float f32x4 __attribute__((ext_vector_type(4)));
typedef float f32x2 __attribute__((ext_vector_type(2)));
typedef float f32x16 __attribute__((ext_vector_type(16)));
typedef unsigned u32x4 __attribute__((ext_vector_type(4)));
typedef unsigned u32x2 __attribute__((ext_vector_type(2)));
typedef __bf16 bf16v2 __attribute__((ext_vector_type(2)));

constexpr int D = 1024, NPROJ = 5120, MP = 32768, MS = 1024, M = MP + MS, SEQ = 8192, DSEQ = 32, PAST = 2048;
constexpr int NH = 8, HD = 64, SBW = 512, CW = 512, PLE = 256, DFF = 4096, P4W = 4096;
constexpr float EPS = 1e-6f;
constexpr size_t O_Y = 0, O_KP = (size_t)M * D, O_VP = O_KP + (size_t)MP * SBW, O_CP = O_VP + (size_t)MP * SBW,
                 O_KS = O_CP + 4 * 2 * CW, O_VS = O_KS + (size_t)MS * SBW, O_CS = O_VS + (size_t)MS * SBW;
constexpr size_t W_IN = 0, W_AO = W_IN + (size_t)NPROJ * D * 2, W_CO = W_AO + (size_t)D * SBW * 2, W_O = W_CO + (size_t)D * CW * 2,
                 W_UP = W_O + (size_t)D * D * 2, W_DN = W_UP + (size_t)DFF * D * 2, W_PG = W_DN + (size_t)D * DFF * 2,
                 W_PL = W_PG + (size_t)D * D * 2, W_RS0 = W_PL + (size_t)D * PLE * 2, W_SS = W_RS0 + (size_t)M * 4,
                 W_PB = W_SS + (size_t)3 * M * 4, W_RA = W_PB + (size_t)M * PLE * 2, W_RB = W_RA + (size_t)M * D * 2,
                 W_RC = W_RB + (size_t)M * D * 2, W_BAR = W_RC + (size_t)M * P4W * 2, W_PE = W_BAR + 16384, W_END = W_PE + (size_t)M * D * 2;

struct Params {
  const float *x_p, *x_s, *p_p, *p_s, *cache_k, *cache_v, *cache_conv;
  const float *g_mix, *w_in, *conv_w, *w_ao, *w_co, *w_o, *g_ffn, *w_up, *w_dn, *g_ple, *w_pg, *w_pl, *g_final;
  float* out; unsigned char* ws;
};

extern __shared__ __attribute__((aligned(16))) unsigned char dyn_lds[];

DI unsigned pk2(float lo, float hi) { f32x2 f = {lo, hi}; bf16v2 b = __builtin_convertvector(f, bf16v2); return __builtin_bit_cast(unsigned, b); }
DI float bf2f(unsigned h16) { return __uint_as_float(h16 << 16); }
DI float bflo(unsigned u) { return __uint_as_float(u << 16); }
DI float bfhi(unsigned u) { return __uint_as_float(u & 0xffff0000u); }
DI bf16x8 cvt8(f32x4 a, f32x4 b) { u32x4 u = {pk2(a.x, a.y), pk2(a.z, a.w), pk2(b.x, b.y), pk2(b.z, b.w)}; return __builtin_bit_cast(bf16x8, u); }
DI float sigmoidf_(float v) { return 1.f / (1.f + __expf(-v)); }
DI float wave_sum(float v) {
#pragma unroll
  for (int o = 1; o < 64; o <<= 1) v += __shfl_xor(v, o);
  return v;
}

constexpr int BM = 256, BK = 64, HALF = 128, NXCD = 8, WGM = 8, HT = HALF * BK, SHM_B = 8 * HT * 2;
DI int lds_byte(int r, int c) { int st = (r >> 4) * 2 + (c >> 5), rr = r & 15, cc = c & 31, ob = rr * 64 + cc * 2; return st * 1024 + (ob ^ (((ob >> 9) & 1) << 5)); }
DI void stage_rc(int b, int& R, int& C) { int st = b / 1024, sb = b % 1024, swz = sb ^ (((sb >> 9) & 1) << 5); R = (st >> 1) * 16 + swz / 64; C = (st & 1) * 32 + (swz % 64) / 2; }

DI bool tile_order(int i, int G, int c, int nM, int nN, int& pm, int& pn) {
  const int nwg = nM * nN; const long L = (long)i * G + c; if (L >= nwg) return false;
  int wgid = (int)L; { const int q = nwg / NXCD, r = nwg % NXCD, xcd = wgid % NXCD, off = wgid / NXCD; wgid = (xcd < r ? xcd * (q + 1) : r * (q + 1) + (xcd - r) * q) + off; }
  const int nig = WGM * nN, gid = wgid / nig, fm = gid * WGM, gsz = (nM - fm) < WGM ? (nM - fm) : WGM;
  pm = fm + ((wgid % nig) % gsz); pn = (wgid % nig) / gsz; return true;
}

typedef f32x4 acc_t[2][2][4][2];
DI void gemm_kloop(const bf16_t* __restrict__ A, const bf16_t* __restrict__ Bt, const int K, const int brow, const int bcol, acc_t& acc, const int ld) {
  bf16_t* shm = (bf16_t*)dyn_lds;
  int tid = threadIdx.x; asm volatile("" : "+v"(tid));
#define SA(b, h) (shm + ((b) * 2 + (h)) * HT)
#define SB(b, h) (shm + (4 + (b) * 2 + (h)) * HT)
#define STAGE(P, BASE, br, kt) do { const char* _ub = (const char*)(BASE) + ((size_t)(br) * ld + (size_t)(kt) * BK) * 2; \
    __builtin_amdgcn_global_load_lds((const unsigned*)(_ub + voff0), (unsigned*)((char*)(P) + wbase), 16, 0, 0); \
    __builtin_amdgcn_global_load_lds((const unsigned*)(_ub + voff1), (unsigned*)((char*)(P) + wbase + 8192), 16, 0, 0); } while (0)
#define LDA(dst, b, h) for (int m = 0; m < 4; ++m) for (int k = 0; k < 2; ++k) \
    dst[m][k] = *reinterpret_cast<const bf16x8*>((char*)SA(b, h) + lds_byte(wr * 64 + m * 16 + fr, k * 32 + fq * 8))
#define LDB(dst, b, h) for (int n = 0; n < 2; ++n) for (int k = 0; k < 2; ++k) \
    dst[n][k] = *reinterpret_cast<const bf16x8*>((char*)SB(b, h) + lds_byte(wc * 32 + n * 16 + fr, k * 32 + fq * 8))
#define MMA(ai, bj, At_, Bt_) do { __builtin_amdgcn_s_setprio(1); \
    for (int m = 0; m < 4; ++m) for (int n = 0; n < 2; ++n) for (int k = 0; k < 2; ++k) \
      acc[ai][bj][m][n] = __builtin_amdgcn_mfma_f32_16x16x32_bf16(Bt_[n][k], At_[m][k], acc[ai][bj][m][n], 0, 0, 0); \
    __builtin_amdgcn_s_setprio(0); } while (0)
#define WAIT_V(n) asm volatile("s_waitcnt vmcnt(" #n ")" ::: "memory")
#define WAIT_L(n) asm volatile("s_waitcnt lgkmcnt(" #n ")" ::: "memory")
#define BAR __builtin_amdgcn_s_barrier()
#define SCHED __builtin_amdgcn_sched_barrier(0)
  const int wid = tid >> 6, lane = tid & 63, wr = wid >> 2, wc = wid & 3, fr = lane & 15, fq = lane >> 4;
  bf16x8 At[4][2], B0[2][2], B1[2][2];
  const int nt = K / BK;
  const int wbase = __builtin_amdgcn_readfirstlane((tid & ~63) * 16);
  unsigned voff0, voff1;
  { int r_, c_; stage_rc(tid * 16, r_, c_); voff0 = (unsigned)(r_ * ld + c_) * 2u; stage_rc(tid * 16 + 8192, r_, c_); voff1 = (unsigned)(r_ * ld + c_) * 2u; }
  STAGE(SB(0, 0), Bt, bcol, 0); STAGE(SA(0, 0), A, brow, 0);
  STAGE(SB(0, 1), Bt, bcol + HALF, 0); STAGE(SA(0, 1), A, brow + HALF, 0);
  if (wr == 1) BAR;
  WAIT_V(4); BAR;
  STAGE(SB(1, 0), Bt, bcol, 1); STAGE(SA(1, 0), A, brow, 1); STAGE(SB(1, 1), Bt, bcol + HALF, 1);
  WAIT_V(6); BAR;
  for (int t = 0; t < nt - 2; t += 2) {
    LDB(B0, 0, 0); SCHED; LDA(At, 0, 0); STAGE(SA(1, 1), A, brow + HALF, t + 1);
    WAIT_L(8); BAR; WAIT_L(0); MMA(0, 0, At, B0); BAR; SCHED;
    LDB(B1, 0, 1); STAGE(SB(0, 0), Bt, bcol, t + 2);
    BAR; WAIT_L(0); MMA(0, 1, At, B1); BAR;
    LDA(At, 0, 1); STAGE(SA(0, 0), A, brow, t + 2);
    BAR; WAIT_L(0); MMA(1, 0, At, B0); BAR; SCHED;
    STAGE(SB(0, 1), Bt, bcol + HALF, t + 2);
    WAIT_V(6); BAR; MMA(1, 1, At, B1); BAR;
    LDB(B0, 1, 0); SCHED; LDA(At, 1, 0); STAGE(SA(0, 1), A, brow + HALF, t + 2);
    WAIT_L(8); BAR; WAIT_L(0); MMA(0, 0, At, B0); BAR; SCHED;
    LDB(B1, 1, 1); STAGE(SB(1, 0), Bt, bcol, t + 3);
    BAR; WAIT_L(0); MMA(0, 1, At, B1); BAR;
    LDA(At, 1, 1); STAGE(SA(1, 0), A, brow, t + 3);
    BAR; WAIT_L(0); MMA(1, 0, At, B0); BAR; SCHED;
    STAGE(SB(1, 1), Bt, bcol + HALF, t + 3);
    WAIT_V(6); BAR; MMA(1, 1, At, B1); BAR;
  }
  { LDB(B0, 0, 0); LDA(At, 0, 0); STAGE(SA(1, 1), A, brow + HALF, nt - 1);
    BAR; WAIT_L(0); MMA(0, 0, At, B0); BAR;
    LDB(B1, 0, 1); BAR; WAIT_L(0); MMA(0, 1, At, B1); BAR;
    LDA(At, 0, 1); WAIT_V(4); BAR; WAIT_L(0); MMA(1, 0, At, B0); MMA(1, 1, At, B1); BAR; }
  { LDB(B0, 1, 0); LDA(At, 1, 0); WAIT_V(2); BAR; WAIT_L(0); MMA(0, 0, At, B0); BAR;
    LDB(B1, 1, 1); WAIT_V(0); BAR; WAIT_L(0); MMA(0, 1, At, B1); BAR;
    LDA(At, 1, 1); BAR; WAIT_L(0); MMA(1, 0, At, B0); MMA(1, 1, At, B1); BAR; }
  if (wr == 0) BAR;
}
template <class F>
DI void epi_call(acc_t& acc, const int brow, const int bcol, const F& f) {
  int tid2 = threadIdx.x, brow2 = brow, bcol2 = bcol;
  asm volatile("" : "+v"(tid2), "+s"(brow2), "+s"(bcol2));
  const int wid2 = tid2 >> 6, lane2 = tid2 & 63;
  f(acc, brow2, bcol2, wid2 >> 2, wid2 & 3, lane2 & 15, lane2 >> 4);
}
template <class Epi>
DI void gemm_tile(const bf16_t* __restrict__ A, const bf16_t* __restrict__ Bt, const int K, const int brow, const int bcol, const Epi& epi) {
  acc_t acc = {};
  gemm_kloop(A, Bt, K, brow, bcol, acc, K);
  epi_call(acc, brow, bcol, epi);
}

template <class Epi>
DI void gemm_phase(const bf16_t* A, const bf16_t* Bt, int Mrows, int N, int K, const Epi& epi) {
  const int nM = Mrows / BM, nN = N / BM;
  for (int i = 0;; ++i) {
    int pm, pn; if (!tile_order(i, gridDim.x, blockIdx.x, nM, nN, pm, pn)) break;
    gemm_tile(A, Bt, K, pm * BM, pn * BM, epi);
  }
}

DI void st_bf16x4(bf16_t* p, f32x4 v) { u32x2 u = {pk2(v.x, v.y), pk2(v.z, v.w)}; *(u32x2*)p = u; }
DI f32x4 ld_bf16x4(const bf16_t* p) { u32x2 u = *(const u32x2*)p; f32x4 v = {bflo(u.x), bfhi(u.x), bflo(u.y), bfhi(u.y)}; return v; }

#define EPI_ROWS for (int ai = 0; ai < 2; ++ai) for (int m = 0; m < 4; ++m)
#define EPI_COLS for (int bj = 0; bj < 2; ++bj) for (int n = 0; n < 2; ++n)
#define EPI_BJ for (int bj = 0; bj < 2; ++bj)
#define EPI_ROW (brow + ai * HALF + wr * 64 + m * 16 + fr)
#define EPI_COL (bcol + bj * HALF + wc * 32 + n * 16 + fq * 4)
#define EPI_COL8 (bcol + bj * HALF + wc * 32 + fq * 8)
DI void st_bf16x8(bf16_t* p, f32x4 a, f32x4 b) { u32x4 u = {pk2(a.x, a.y), pk2(a.z, a.w), pk2(b.x, b.y), pk2(b.z, b.w)}; *(u32x4*)p = u; }
DI void unpack8(const u32x4 u, f32x4& a, f32x4& b) { a = (f32x4){bflo(u.x), bfhi(u.x), bflo(u.y), bfhi(u.y)}; b = (f32x4){bflo(u.z), bfhi(u.z), bflo(u.w), bfhi(u.w)}; }

struct EpiIn {
  const float* rs0; bf16_t* proj4; float* out;
  DI void operator()(const acc_t& acc, int brow, int bcol, int wr, int wc, int fr, int fq) const {
    float rr[2][4];
#pragma unroll
    EPI_ROWS rr[ai][m] = rs0[EPI_ROW];
    if (bcol >= 512 && bcol < 1536) {
#pragma unroll
      EPI_ROWS { const int row = EPI_ROW; const float r = rr[ai][m];
#pragma unroll
        EPI_COLS { const int col = EPI_COL; f32x4 v = acc[ai][bj][m][n] * r;
          const int isv = bcol >= 1024; const int c = col - (isv ? 1024 : 512);
          float* dst = (row < MP) ? out + (isv ? O_VP : O_KP) + (size_t)row * SBW + c : out + (isv ? O_VS : O_KS) + (size_t)(row - MP) * SBW + c;
          *(f32x4*)dst = v; } }
    } else if (bcol < 2048) {
      const float sc = (bcol < 512) ? 0.18033688011112042f   : 1.f; const int sh = (bcol < 512) ? 0 : 1024;
#pragma unroll
      EPI_ROWS { const int row = EPI_ROW; const float r = rr[ai][m] * sc;
#pragma unroll
        EPI_BJ { st_bf16x8(proj4 + (size_t)row * P4W + (EPI_COL8 - sh), acc[ai][bj][m][0] * r, acc[ai][bj][m][1] * r); } }
    } else {
      const bool gate = bcol >= 3072; const int t = ((bcol - (gate ? 3072 : 2048)) >> 8) * 128;
#pragma unroll
      EPI_ROWS { const int row = EPI_ROW; const float r = rr[ai][m]; const int ch = t + wc * 32 + fq * 8;
        const f32x4 a0 = acc[ai][0][m][0] * r, a1 = acc[ai][0][m][1] * r, b0 = acc[ai][1][m][0] * r, b1 = acc[ai][1][m][1] * r;
        if (!gate) { st_bf16x8(proj4 + (size_t)row * P4W + 1024 + ch, a0 * b0, a1 * b1); }
        else { f32x4 rho0, rho1, sg0, sg1;
#pragma unroll
          for (int e = 0; e < 4; ++e) {
            { const float ea = __expf(-a0[e]), eb = __expf(-fmaxf(b0[e], -80.f)); sg0[e] = 1.f / (1.f + eb); rho0[e] = (1.f + eb) / (1.f + ea); }
            { const float ea = __expf(-a1[e]), eb = __expf(-fmaxf(b1[e], -80.f)); sg1[e] = 1.f / (1.f + eb); rho1[e] = (1.f + eb) / (1.f + ea); } }
          st_bf16x8(proj4 + (size_t)row * P4W + 2048 + ch, rho0, rho1); st_bf16x8(proj4 + (size_t)row * P4W + 3072 + ch, sg0, sg1); } }
    }
  }
};
template <bool FINAL>
struct EpiGate {
  const bf16_t* proj4; int off; bf16_t* merged;
  DI void operator()(acc_t& acc, int brow, int bcol, int wr, int wc, int fr, int fq) const {
    u32x4 g[2][4][2];
#pragma unroll
    EPI_ROWS { const int row = EPI_ROW;
#pragma unroll
      EPI_BJ g[ai][m][bj] = *(const u32x4*)(proj4 + (size_t)row * P4W + off + EPI_COL8); }
#pragma unroll
    EPI_ROWS { const int row = EPI_ROW;
#pragma unroll
      EPI_BJ { f32x4 g0, g1; unpack8(g[ai][m][bj], g0, g1);
        if (FINAL) st_bf16x8(merged + (size_t)row * D + EPI_COL8, acc[ai][bj][m][0] * g0, acc[ai][bj][m][1] * g1);
        else { acc[ai][bj][m][0] *= g0; acc[ai][bj][m][1] *= g1; } } }
  }
};
template <int MODE>
struct EpiRes {
  const float *x_p, *x_s; const bf16_t* resb; bf16_t* outb; float* ss; const float* ssprev; const bf16_t* pe;
  DI void operator()(const acc_t& acc, int brow, int bcol, int wr, int wc, int fr, int fq) const {
#pragma unroll
    for (int ai = 0; ai < 2; ++ai) {
      f32x4 resf[4][2][2]; u32x4 resh[4][2], peh[4][2]; float rr[4];
#pragma unroll
      for (int m = 0; m < 4; ++m) { const int row = EPI_ROW;
        if (MODE == 2) rr[m] = ssprev[row];
#pragma unroll
        EPI_BJ { const int col = EPI_COL8;
          if (MODE == 0) { const float* xp = (row < MP) ? x_p + (size_t)row * D + col : x_s + (size_t)(row - MP) * D + col;
            resf[m][bj][0] = *(const f32x4*)xp; resf[m][bj][1] = *(const f32x4*)(xp + 4); }
          else resh[m][bj] = *(const u32x4*)(resb + (size_t)row * D + col);
          if (MODE == 2) peh[m][bj] = *(const u32x4*)(pe + (size_t)row * D + col); } }
#pragma unroll
      for (int m = 0; m < 4; ++m) { const int row = EPI_ROW; float part = 0.f; float r = 0.f;
        if (MODE == 2) r = rsqrtf(rr[m] * (1.f / D) + EPS);
#pragma unroll
        EPI_BJ { const int col = EPI_COL8; f32x4 a0 = acc[ai][bj][m][0], a1 = acc[ai][bj][m][1]; f32x4 r0, r1;
          if (MODE == 0) { r0 = resf[m][bj][0]; r1 = resf[m][bj][1]; } else unpack8(resh[m][bj], r0, r1);
          if (MODE == 2) { f32x4 e0, e1; unpack8(peh[m][bj], e0, e1); a0 = a0 * r; a1 = a1 * r;
            const f32x4 s0 = {sigmoidf_(a0.x), sigmoidf_(a0.y), sigmoidf_(a0.z), sigmoidf_(a0.w)}, s1 = {sigmoidf_(a1.x), sigmoidf_(a1.y), sigmoidf_(a1.z), sigmoidf_(a1.w)};
            a0 = s0 * e0; a1 = s1 * e1; }
          const f32x4 o0 = r0 + a0, o1 = r1 + a1;
          st_bf16x8(outb + (size_t)row * D + col, o0, o1);
          part += (o0.x * o0.x + o0.y * o0.y + o0.z * o0.z + o0.w * o0.w) + (o1.x * o1.x + o1.y * o1.y + o1.z * o1.z + o1.w * o1.w); }
        part += __shfl_xor(part, 16); part += __shfl_xor(part, 32);
        if (fq == 0) atomicAdd(ss + row, part); }
    }
  }
};
struct EpiUp {
  const float* ss1; bf16_t* u;
  DI void operator()(const acc_t& acc, int brow, int bcol, int wr, int wc, int fr, int fq) const {
    float rr[2][4];
#pragma unroll
    EPI_ROWS rr[ai][m] = ss1[EPI_ROW];
#pragma unroll
    EPI_ROWS { const int row = EPI_ROW; const float r = rsqrtf(rr[ai][m] * (1.f / D) + EPS);
#pragma unroll
      EPI_BJ { f32x4 a0 = acc[ai][bj][m][0] * r, a1 = acc[ai][bj][m][1] * r;
        const f32x4 z0 = {fmaxf(a0.x, 0.f), fmaxf(a0.y, 0.f), fmaxf(a0.z, 0.f), fmaxf(a0.w, 0.f)}, z1 = {fmaxf(a1.x, 0.f), fmaxf(a1.y, 0.f), fmaxf(a1.z, 0.f), fmaxf(a1.w, 0.f)};
        st_bf16x8(u + (size_t)row * DFF + EPI_COL8, z0 * z0, z1 * z1); } }
  }
};
struct EpiPartial {
  float* part;
  DI void operator()(const acc_t& acc, int brow, int bcol, int wr, int wc, int fr, int fq) const {
#pragma unroll
    EPI_ROWS { const int row = EPI_ROW;
#pragma unroll
      EPI_BJ { float* d = part + (size_t)row * D + EPI_COL8; *(f32x4*)d = acc[ai][bj][m][0]; *(f32x4*)(d + 4) = acc[ai][bj][m][1]; } }
  }
};
struct EpiPe {
  bf16_t* pe;
  DI void operator()(const acc_t& acc, int brow, int bcol, int wr, int wc, int fr, int fq) const {
#pragma unroll
    EPI_ROWS { const int row = EPI_ROW;
#pragma unroll
      EPI_BJ { st_bf16x8(pe + (size_t)row * D + EPI_COL8, acc[ai][bj][m][0], acc[ai][bj][m][1]); } }
  }
};

DI int win_perm(int n) {
  if (n < 2048) return n;
  if (n < 3072) { const int r = n - 2048, c = r & 511; return 2048 + 256 * (c >> 7) + ((r >> 9) ? 128 : 0) + (c & 127); }
  const int r = n - 3072, c = r & 1023; return 3072 + 256 * (c >> 7) + ((r >> 10) ? 128 : 0) + (c & 127);
}
template <bool PERM>
DI void transpose_item(const float* __restrict__ W, const float* __restrict__ g, int K, int N, bf16_t* __restrict__ WT, float* scr, int item, int lane) {
  const int nblk = N / 32, kb = item / nblk, nb = item % nblk, k0 = 64 * kb, n0 = 32 * nb;
  const int n0d = PERM ? win_perm(n0) : n0;
  const bool p32 = !(PERM && n0 >= 512 && n0 < 1536);
  float wv[32];
#pragma unroll
  for (int i = 0; i < 32; ++i) { const int kk = 2 * i + (lane >> 5); wv[i] = W[(size_t)(k0 + kk) * N + n0 + (lane & 31)]; }
  if (g) {
#pragma unroll
    for (int i = 0; i < 32; ++i) wv[i] *= g[k0 + 2 * i + (lane >> 5)]; }
#pragma unroll
  for (int i = 0; i < 32; ++i) scr[(2 * i + (lane >> 5)) * 33 + (lane & 31)] = wv[i];
  asm volatile("s_waitcnt lgkmcnt(0)" ::: "memory");
  const int c = lane & 7;
#pragma unroll
  for (int j = 0; j < 4; ++j) { const int n = (lane >> 3) + 8 * j; const int ns = p32 ? (8 * ((n & 15) >> 2) + 4 * (n >> 4) + (n & 3)) : n; const float* s = scr + (8 * c) * 33 + ns;
    u32x4 o = {pk2(s[0 * 33], s[1 * 33]), pk2(s[2 * 33], s[3 * 33]), pk2(s[4 * 33], s[5 * 33]), pk2(s[6 * 33], s[7 * 33])};
    *(u32x4*)(WT + (size_t)(n0d + n) * K + k0 + 8 * c) = o; }
  asm volatile("s_waitcnt lgkmcnt(0)" ::: "memory");
}

#define MFMA32(a, b, c) __builtin_amdgcn_mfma_f32_32x32x16_bf16((a), (b), (c), 0, 0, 0)
DI void attn_load(const float* __restrict__ Kp, const float* __restrict__ Vp, int i, int half, f32x4 (&kr)[8], float (&vr)[32]) {
#pragma unroll
  for (int s = 0; s < 4; ++s) { const f32x4* kp = (const f32x4*)(Kp + (size_t)i * SBW + 16 * s + 8 * half); kr[2 * s] = kp[0]; kr[2 * s + 1] = kp[1]; }
#pragma unroll
  for (int s = 0; s < 2; ++s)
#pragma unroll
    for (int jj = 0; jj < 8; ++jj) { const int key = 16 * s + 8 * (jj >> 2) + 4 * half + (jj & 3);
      vr[(2 * s) * 8 + jj] = Vp[(size_t)key * SBW + i]; vr[(2 * s + 1) * 8 + jj] = Vp[(size_t)key * SBW + 32 + i]; }
}
template <bool DIAG>
DI void attn_weights(const f32x16& sacc, int i, int half, float& C, float (&a)[16]) {
  float be[16], om[16];
#pragma unroll
  for (int r = 0; r < 16; ++r) { const float z = sacc[r];
    const float e = __builtin_amdgcn_exp2f(-fabsf(z)), rc = __builtin_amdgcn_rcpf(1.f + e), er = e * rc;
    float b = (z >= 0.f) ? rc : er, o = (z >= 0.f) ? er : rc;
    if (DIAG) { const int key = (r & 3) + 8 * (r >> 2) + 4 * half; const bool valid = key < i; b = valid ? b : 0.f; o = valid ? o : 1.f; }
    be[r] = b; om[r] = o; }
  float G[4], Pn[4];
#pragma unroll
  for (int g = 0; g < 4; ++g) { G[g] = (om[4 * g] * om[4 * g + 1]) * (om[4 * g + 2] * om[4 * g + 3]); Pn[g] = __shfl_xor(G[g], 32); }
  float run = C;
#pragma unroll
  for (int g = 3; g >= 0; --g) { float t = half ? run : run * Pn[g];
#pragma unroll
    for (int u = 3; u >= 0; --u) { a[4 * g + u] = be[4 * g + u] * t; t *= om[4 * g + u]; }
    run *= G[g] * Pn[g]; }
  C = run;
}
DI void attn_task(const Params& p, const int qb, const int h, int lane) {
  const bf16_t* proj4 = (const bf16_t*)(p.ws + W_RC);
  bf16_t* attn = (bf16_t*)(p.ws + W_RB);
  const int i = lane & 31, half = lane >> 5;
  int qtok0, nblk; const float *k0p, *v0p, *k1p, *v1p;
  if (qb < MP / 32) { const int b = qb >> 8, t0 = (qb & 255) * 32; qtok0 = b * SEQ + t0; nblk = (t0 >> 5) + 1;
    k0p = p.out + O_KP + (size_t)qtok0 * SBW; v0p = p.out + O_VP + (size_t)qtok0 * SBW; k1p = k0p; v1p = v0p; }
  else { const int b = qb - MP / 32; qtok0 = MP + b * DSEQ; nblk = 1 + PAST / 32;
    k0p = p.out + O_KS + (size_t)(b * DSEQ) * SBW; v0p = p.out + O_VS + (size_t)(b * DSEQ) * SBW;
    k1p = p.cache_k + (size_t)(b * PAST + PAST) * SBW; v1p = p.cache_v + (size_t)(b * PAST + PAST) * SBW; }
  k0p += h * HD; v0p += h * HD; k1p += h * HD; v1p += h * HD;
  bf16x8 qf[4];
  { const bf16_t* qp = proj4 + (size_t)(qtok0 + i) * P4W + h * HD + 8 * half;
#pragma unroll
    for (int s = 0; s < 4; ++s) qf[s] = *(const bf16x8*)(qp + 16 * s); }
  f32x16 o0 = {}, o1 = {};
  float C = 1.f;
  f32x4 kr[8]; float vr[32];
  bf16x8 kf[4], vf[4];
#define ATTN_CVT() do { _Pragma("unroll") for (int s = 0; s < 4; ++s) kf[s] = cvt8(kr[2 * s], kr[2 * s + 1]); \
    _Pragma("unroll") for (int q = 0; q < 4; ++q) { u32x4 v = {pk2(vr[8 * q], vr[8 * q + 1]), pk2(vr[8 * q + 2], vr[8 * q + 3]), pk2(vr[8 * q + 4], vr[8 * q + 5]), pk2(vr[8 * q + 6], vr[8 * q + 7])}; \
      vf[q] = __builtin_bit_cast(bf16x8, v); } } while (0)
  attn_load(k0p, v0p, i, half, kr, vr);
  ATTN_CVT();
  for (int it = 0; it < nblk; ++it) {
    { const int itn = (it + 1 < nblk) ? it + 1 : it;
      attn_load(k1p - (size_t)itn * 32 * SBW, v1p - (size_t)itn * 32 * SBW, i, half, kr, vr); }
    __builtin_amdgcn_sched_barrier(0);
    f32x16 sacc = {};
#pragma unroll
    for (int s = 0; s < 4; ++s) sacc = MFMA32(kf[s], qf[s], sacc);
    float a[16];
    if (it == 0) attn_weights<true>(sacc, i, half, C, a); else attn_weights<false>(sacc, i, half, C, a);
#pragma unroll
    for (int s = 0; s < 2; ++s) {
      u32x4 pu = {pk2(a[8 * s], a[8 * s + 1]), pk2(a[8 * s + 2], a[8 * s + 3]), pk2(a[8 * s + 4], a[8 * s + 5]), pk2(a[8 * s + 6], a[8 * s + 7])};
      const bf16x8 pf = __builtin_bit_cast(bf16x8, pu);
      o0 = MFMA32(vf[2 * s], pf, o0);
      o1 = MFMA32(vf[2 * s + 1], pf, o1); }
    if (__all(C == 0.f)) break;
    __builtin_amdgcn_sched_barrier(0);
    ATTN_CVT();
  }
  bf16_t* op = attn + (size_t)(qtok0 + i) * SBW + h * HD + 4 * half;
#pragma unroll
  for (int g = 0; g < 4; ++g) {
    f32x4 a0 = {o0[4 * g], o0[4 * g + 1], o0[4 * g + 2], o0[4 * g + 3]}; st_bf16x4(op + 8 * g, a0);
    f32x4 a1 = {o1[4 * g], o1[4 * g + 1], o1[4 * g + 2], o1[4 * g + 3]}; st_bf16x4(op + 32 + 8 * g, a1); }
}

DI void conv_items(const Params& p) {
  const bf16_t* proj4 = (const bf16_t*)(p.ws + W_RC);
  bf16_t* convg = (bf16_t*)(p.ws + W_RB) + (size_t)M * SBW;
  const int total = (M / 8) * (CW / 8);
  for (int idx = blockIdx.x * blockDim.x + threadIdx.x; idx < total; idx += gridDim.x * blockDim.x) {
    const int tok0 = (idx >> 6) * 8, c0 = (idx & 63) * 8;
    int b, t0, T; const float* buf; float* nb;
    if (tok0 < MP) { b = tok0 >> 13; t0 = tok0 & (SEQ - 1); T = SEQ; buf = nullptr; nb = p.out + O_CP + (size_t)b * 2 * CW; }
    else { const int s = tok0 - MP; b = s >> 5; t0 = s & (DSEQ - 1); T = DSEQ; buf = p.cache_conv + (size_t)b * 2 * CW; nb = p.out + O_CS + (size_t)b * 2 * CW; }
    const bf16_t* row = proj4 + (size_t)tok0 * P4W + c0;
    u32x4 ur[10], cr[8];
#pragma unroll
    for (int j = 0; j < 8; ++j) { ur[j + 2] = *(const u32x4*)(row + (size_t)j * P4W + 1024); cr[j] = *(const u32x4*)(row + (size_t)j * P4W + 512); }
    float w0[8], w1[8], w2[8];
#pragma unroll
    for (int e = 0; e < 8; ++e) { w0[e] = p.conv_w[c0 + e]; w1[e] = p.conv_w[CW + c0 + e]; w2[e] = p.conv_w[2 * CW + c0 + e]; }
    float um2[8], um1[8];
    if (t0 > 0) { const u32x4 x2 = *(const u32x4*)(row - 2 * (size_t)P4W + 1024), x1 = *(const u32x4*)(row - (size_t)P4W + 1024);
#pragma unroll
      for (int e = 0; e < 4; ++e) { um2[2 * e] = bflo(x2[e]); um2[2 * e + 1] = bfhi(x2[e]); um1[2 * e] = bflo(x1[e]); um1[2 * e + 1] = bfhi(x1[e]); } }
    else {
#pragma unroll
      for (int e = 0; e < 8; ++e) { um2[e] = buf ? buf[c0 + e] : 0.f; um1[e] = buf ? buf[CW + c0 + e] : 0.f; } }
#pragma unroll
    for (int j = 0; j < 8; ++j) {
      float u0[8], cbv[8], o[8];
#pragma unroll
      for (int e = 0; e < 4; ++e) { u0[2 * e] = bflo(ur[j + 2][e]); u0[2 * e + 1] = bfhi(ur[j + 2][e]); cbv[2 * e] = bflo(cr[j][e]); cbv[2 * e + 1] = bfhi(cr[j][e]); }
#pragma unroll
      for (int e = 0; e < 8; ++e) o[e] = cbv[e] * (w0[e] * um2[e] + w1[e] * um1[e] + w2[e] * u0[e]);
      u32x4 ov = {pk2(o[0], o[1]), pk2(o[2], o[3]), pk2(o[4], o[5]), pk2(o[6], o[7])};
      *(u32x4*)(convg + (size_t)(tok0 + j) * CW + c0) = ov;
      if (t0 + j >= T - 2) { float* d = nb + (size_t)(t0 + j - (T - 2)) * CW + c0;
#pragma unroll
        for (int e = 0; e < 8; ++e) d[e] = u0[e]; }
#pragma unroll
      for (int e = 0; e < 8; ++e) { um2[e] = um1[e]; um1[e] = u0[e]; }
    }
  }
}

#define XB_TMO      128
#define XB_XCNT(j)  (256  + 64 * (j))
#define XB_XSUB(j)  (1280 + 64 * (j))
#define XB_XGEN(j)  (2304 + 64 * (j))
#define XB_TOP      3328
#define XB_TOPGEN   3392
#define XCD_BAR_WORDS 3456
#define XB_SPIN_CAP (1u << 18)
#define LAS __attribute__((address_space(3)))
DI unsigned xb_ld(unsigned* p) { return __hip_atomic_load(p, __ATOMIC_RELAXED, __HIP_MEMORY_SCOPE_AGENT); }
DI unsigned xb_add(unsigned* p, unsigned v) { return __hip_atomic_fetch_add(p, v, __ATOMIC_RELAXED, __HIP_MEMORY_SCOPE_AGENT); }
DI unsigned xb_xcc_id() { return (unsigned)__builtin_amdgcn_s_getreg((3 << 11) | 20) & 0xFu; }
#define XB_SPIN(cond, bar) do { unsigned _sp = 0; while (cond) { __builtin_amdgcn_s_sleep(1); \
    if ((++_sp & 255u) == 0u) { if (xb_ld(&(bar)[XB_TMO])) break; if (_sp > XB_SPIN_CAP) { atomicAdd(&(bar)[XB_TMO], 1u); break; } } } } while (0)
struct XcdBarrier { unsigned* bar; unsigned x; volatile LAS unsigned* st; };
DI XcdBarrier xcd_barrier_post(unsigned* bar, volatile LAS unsigned* st) {
  XcdBarrier b; b.bar = bar; b.x = xb_xcc_id(); b.st = st;
  if (threadIdx.x == 0) (void)xb_add(&bar[XB_XCNT(b.x)], 1u);
  return b;
}
DI void xcd_barrier_complete(unsigned* bar, unsigned x, unsigned& nloc, unsigned& nx) {
  const unsigned G = gridDim.x * gridDim.y * gridDim.z;
  unsigned sum, cnt, mine, sp = 0u;
  for (;;) {
    sum = 0u; cnt = 0u; mine = 0u;
#pragma unroll
    for (unsigned j = 0; j < 16; ++j) { const unsigned c = xb_ld(&bar[XB_XCNT(j)]); sum += c; cnt += (c > 0u) ? 1u : 0u; mine = (j == x) ? c : mine; }
    if (sum == G) break;
    __builtin_amdgcn_s_sleep(1);
    if ((++sp & 255u) == 0u) { if (xb_ld(&bar[XB_TMO])) break; if (sp > XB_SPIN_CAP) { atomicAdd(&bar[XB_TMO], 1u); break; } }
  }
  nloc = mine > 0u ? mine : 1u; nx = cnt > 0u ? cnt : 1u;
}
DI void xcd_barrier(const XcdBarrier& b) {
  asm volatile("s_waitcnt vmcnt(0)" ::: "memory");
  __syncthreads();
  if (threadIdx.x == 0) {
    unsigned* bar = b.bar;
    __builtin_amdgcn_s_waitcnt(0);
    unsigned nloc = b.st[0], nx = b.st[1];
    if (nloc == 0u) { xcd_barrier_complete(bar, b.x, nloc, nx); b.st[0] = nloc; b.st[1] = nx; }
    const unsigned old = xb_add(&bar[XB_XSUB(b.x)], 1u);
    const unsigned gen = old / nloc;
    if (old + 1u == (gen + 1u) * nloc) {
      __builtin_amdgcn_fence(__ATOMIC_RELEASE, "agent");
      asm volatile("s_waitcnt vmcnt(0)" ::: "memory");
      const unsigned og = xb_add(&bar[XB_TOP], 1u);
      const unsigned tg = og / nx;
      if (og + 1u == (tg + 1u) * nx) xb_add(&bar[XB_TOPGEN], 1u);
      else XB_SPIN(xb_ld(&bar[XB_TOPGEN]) == tg, bar);
      __builtin_amdgcn_fence(__ATOMIC_ACQUIRE, "agent");
      xb_add(&bar[XB_XGEN(b.x)], 1u);
      asm volatile("s_waitcnt vmcnt(0)" ::: "memory");
    } else {
      XB_SPIN(xb_ld(&bar[XB_XGEN(b.x)]) == gen, bar);
      __builtin_amdgcn_fence(__ATOMIC_ACQUIRE, "agent");
      asm volatile("s_waitcnt vmcnt(0)" ::: "memory");
    }
  }
  __syncthreads();
}

__global__ void __launch_bounds__(512, 2) fwd_megakernel(Params p) {
  cg::grid_group grid = cg::this_grid();
  const int NGW = gridDim.x * 8, NT = gridDim.x * blockDim.x;
#define PHASE_IDS int tid_ = threadIdx.x; asm volatile("" : "+v"(tid_)); const int lane = tid_ & 63, wave = tid_ >> 6, gw = blockIdx.x * 8 + wave, gtid = blockIdx.x * 512 + tid_; (void)lane; (void)wave; (void)gw; (void)gtid;
  unsigned char* ws = p.ws;
  bf16_t *wInT = (bf16_t*)(ws + W_IN), *wAoT = (bf16_t*)(ws + W_AO), *wCoT = (bf16_t*)(ws + W_CO), *wOT = (bf16_t*)(ws + W_O),
         *wUpT = (bf16_t*)(ws + W_UP), *wDnT = (bf16_t*)(ws + W_DN), *wPgT = (bf16_t*)(ws + W_PG), *wPlT = (bf16_t*)(ws + W_PL);
  float* rs0 = (float*)(ws + W_RS0); float* ss = (float*)(ws + W_SS);
  bf16_t* PE = (bf16_t*)(ws + W_PE);
  bf16_t *pb = (bf16_t*)(ws + W_PB), *RA = (bf16_t*)(ws + W_RA), *RB = (bf16_t*)(ws + W_RB), *RC = (bf16_t*)(ws + W_RC);
  float* y = p.out + O_Y;
  constexpr int I0 = (D / 64) * (NPROJ / 32), I1 = (SBW / 64) * (D / 32), I2 = I1, I3 = (D / 64) * (D / 32), I4 = (D / 64) * (DFF / 32),
                  I5 = (DFF / 64) * (D / 32), I6 = I3, I7 = (PLE / 64) * (D / 32), NI = I0 + I1 + I2 + I3 + I4 + I5 + I6 + I7;
  __shared__ uint4 xb_words;
  if (threadIdx.x == 0) xb_words = make_uint4(0u, 0u, 0u, 0u);
  __syncthreads();
  const XcdBarrier xb = xcd_barrier_post((unsigned*)(ws + W_BAR), (volatile LAS unsigned*)&xb_words);

  {
    PHASE_IDS
    float* scr = (float*)dyn_lds + wave * (64 * 33);
    for (int it = gw; it < I0 + I1 + I2 + I7; it += NGW) {
      int r = it;
      if (r < I0) { transpose_item<true>(p.w_in, p.g_mix, D, NPROJ, wInT, scr, r, lane); continue; } r -= I0;
      if (r < I1) { transpose_item<false>(p.w_ao, nullptr, SBW, D, wAoT, scr, r, lane); continue; } r -= I1;
      if (r < I2) { transpose_item<false>(p.w_co, nullptr, CW, D, wCoT, scr, r, lane); continue; } r -= I2;
      transpose_item<false>(p.w_pl, nullptr, PLE, D, wPlT, scr, r, lane);
    }
    for (int row0 = gw * 4; row0 < M; row0 += NGW * 4) {
      f32x4 v[4][4];
#pragma unroll
      for (int q = 0; q < 4; ++q) { const int row = row0 + q;
        const float* xr = (row < MP) ? p.x_p + (size_t)row * D : p.x_s + (size_t)(row - MP) * D;
        const f32x4* x4 = (const f32x4*)xr + lane;
#pragma unroll
        for (int j = 0; j < 4; ++j) v[q][j] = x4[64 * j]; }
#pragma unroll
      for (int q = 0; q < 4; ++q) { const int row = row0 + q; float sq = 0.f;
#pragma unroll
        for (int j = 0; j < 4; ++j) sq += (v[q][j].x * v[q][j].x + v[q][j].y * v[q][j].y) + (v[q][j].z * v[q][j].z + v[q][j].w * v[q][j].w);
        sq = wave_sum(sq);
        if (lane == 0) rs0[row] = rsqrtf(sq * (1.f / D) + EPS);
        u32x2* o8 = (u32x2*)(RA + (size_t)row * D) + lane;
#pragma unroll
        for (int j = 0; j < 4; ++j) { u32x2 o = {pk2(v[q][j].x, v[q][j].y), pk2(v[q][j].z, v[q][j].w)}; o8[64 * j] = o; } }
    }
    for (int idx0 = gtid; idx0 < M * PLE / 4; idx0 += NT * 4) {
      f32x4 v[4];
#pragma unroll
      for (int q = 0; q < 4; ++q) { const int idx = idx0 + q * NT; if (idx < M * PLE / 4) { const size_t e = (size_t)idx * 4;
          v[q] = *(const f32x4*)((e < (size_t)MP * PLE) ? p.p_p + e : p.p_s + (e - (size_t)MP * PLE)); } }
#pragma unroll
      for (int q = 0; q < 4; ++q) { const int idx = idx0 + q * NT; if (idx < M * PLE / 4) st_bf16x4(pb + (size_t)idx * 4, v[q]); }
    }
    for (int idx = gtid; idx < 3 * M; idx += NT) ss[idx] = 0.f;
  }
  if (p.ws == nullptr) grid.sync();
  xcd_barrier(xb);
  { EpiIn e{rs0, RC, p.out}; gemm_phase(RA, wInT, M, NPROJ, D, e); }
  { const int G = gridDim.x, ntl = (M / BM) * (NPROJ / BM), rem = ntl % G, c = blockIdx.x;
    const int nidle = (rem == 0) ? G : G - rem, q = (rem == 0) ? c : c - rem;
    if (q >= 0) { EpiPe e{PE};
      for (int t = q; t < (M / BM) * (D / BM); t += nidle) gemm_tile(pb, wPlT, PLE, (t >> 2) * BM, (t & 3) * BM, e); } }
  xcd_barrier(xb);
  { PHASE_IDS
    constexpr int NU = (MP / 32 / 8) * NH;
    const int upb = (NU + gridDim.x - 1) / gridDim.x;
    for (int j = 0; j < upb; ++j) { const int u = blockIdx.x * upb + j; if (u >= NU) break;
      const int bh = u >> 5, g = u & 31; attn_task(p, (bh >> 3) * (SEQ / 32) + g * 8 + wave, bh & 7, lane); }
    for (int sb = 0; sb < MS / DSEQ; ++sb) if ((sb * 8 + (sb & 7)) % gridDim.x == blockIdx.x) attn_task(p, MP / 32 + sb, wave, lane); }
  conv_items(p);
  xcd_barrier(xb);
  {
    const int nM = M / BM, nN = D / BM;
    for (int i = 0;; ++i) { int pm, pn; if (!tile_order(i, gridDim.x, blockIdx.x, nM, nN, pm, pn)) break;
      acc_t acc = {};
      gemm_kloop(RB, wAoT, SBW, pm * BM, pn * BM, acc, SBW);
      { EpiGate<false> e{RC, 2048, nullptr}; epi_call(acc, pm * BM, pn * BM, e); }
      gemm_kloop(RB + (size_t)M * SBW, wCoT, CW, pm * BM, pn * BM, acc, CW);
      { EpiGate<true> e{RC, 3072, RA}; epi_call(acc, pm * BM, pn * BM, e); } }
    { const int G = gridDim.x, rem = (nM * nN) % G, c = blockIdx.x; const int nidle = (rem == 0) ? G : G - rem, q = (rem == 0) ? c : c - rem;
      if (q >= 0) { PHASE_IDS
        float* scr = (float*)dyn_lds + wave * (64 * 33);
        for (int it = q * 8 + wave; it < I3 + I4; it += nidle * 8) {
          if (it < I3) transpose_item<false>(p.w_o, nullptr, D, D, wOT, scr, it, lane);
          else transpose_item<false>(p.w_up, p.g_ffn, D, DFF, wUpT, scr, it - I3, lane); } } }
  }
  xcd_barrier(xb);
  { EpiRes<0> e{p.x_p, p.x_s, nullptr, RB, ss, nullptr, nullptr}; gemm_phase(RA, wOT, M, D, D, e); }
  xcd_barrier(xb);
  { EpiUp e{ss, RC}; gemm_phase(RB, wUpT, M, DFF, D, e); }
  { const int G = gridDim.x, rem = ((M / BM) * (DFF / BM)) % G, c = blockIdx.x; const int nidle = (rem == 0) ? G : G - rem, q = (rem == 0) ? c : c - rem;
    if (q >= 0) { PHASE_IDS
      float* scr = (float*)dyn_lds + wave * (64 * 33);
      for (int it = q * 8 + wave; it < I5 + I6; it += nidle * 8) {
        if (it < I5) transpose_item<false>(p.w_dn, nullptr, DFF, D, wDnT, scr, it, lane);
        else transpose_item<false>(p.w_pg, p.g_ple, D, D, wPgT, scr, it - I5, lane); } } }
  xcd_barrier(xb);
  { EpiRes<1> e{nullptr, nullptr, RB, RA, ss + M, nullptr, nullptr}; gemm_phase(RC, wDnT, MP, D, DFF, e); }
  { float* part = (float*)(ws + W_PB);
    for (int j = blockIdx.x; j < (MS / BM) * (D / BM) * 4; j += gridDim.x) { const int pm = j >> 4, pn = (j >> 2) & 3, kq = j & 3;
      acc_t acc = {};
      gemm_kloop(RC + (size_t)MP * DFF + kq * (DFF / 4), wDnT + kq * (DFF / 4), DFF / 4, pm * BM, pn * BM, acc, DFF);
      EpiPartial e{part + (size_t)kq * MS * D}; epi_call(acc, pm * BM, pn * BM, e); } }
  xcd_barrier(xb);
  { PHASE_IDS
    const float* part = (const float*)(ws + W_PB);
    for (int r = gw; r < MS; r += NGW) { const int row = MP + r; float sq = 0.f;
#pragma unroll
      for (int j = 0; j < 4; ++j) { const int col = j * 256 + lane * 4;
        f32x4 v = ld_bf16x4(RB + (size_t)row * D + col);
#pragma unroll
        for (int kq = 0; kq < 4; ++kq) v += *(const f32x4*)(part + ((size_t)kq * MS + r) * D + col);
        st_bf16x4(RA + (size_t)row * D + col, v); sq += (v.x * v.x + v.y * v.y) + (v.z * v.z + v.w * v.w); }
      sq = wave_sum(sq);
      if (lane == 0) ss[M + row] = sq; } }
  xcd_barrier(xb);
  { EpiRes<2> e{nullptr, nullptr, RA, RC, ss + 2 * M, ss + M, PE}; gemm_phase(RA, wPgT, M, D, D, e); }
  xcd_barrier(xb);
  { PHASE_IDS
  for (int idx0 = gtid; idx0 < M * (D / 8); idx0 += NT * 4) {
    u32x4 xv[4]; float rv[4];
#pragma unroll
    for (int q = 0; q < 4; ++q) { const int idx = idx0 + q * NT; if (idx < M * (D / 8)) { const int row = idx >> 7, c = (idx & 127) * 8;
        xv[q] = *(const u32x4*)(RC + (size_t)row * D + c); rv[q] = ss[2 * M + row]; } }
#pragma unroll
    for (int q = 0; q < 4; ++q) { const int idx = idx0 + q * NT; if (idx < M * (D / 8)) { const int row = idx >> 7, c = (idx & 127) * 8;
        const float r = rsqrtf(rv[q] * (1.f / D) + EPS); f32x4 a0, a1; unpack8(xv[q], a0, a1);
        const f32x4 g0 = *(const f32x4*)(p.g_final + c), g1 = *(const f32x4*)(p.g_final + c + 4);
        *(f32x4*)(y + (size_t)row * D + c) = a0 * r * g0; *(f32x4*)(y + (size_t)row * D + c + 4) = a1 * r * g1; } }
  } }
}

extern "C" void kernel_launch(void* const* d_in, const int* in_sizes, int n_in, void* d_out, int out_size, void* d_ws, size_t ws_size, hipStream_t stream) {
  static int grid_blocks = 0;
  if (grid_blocks == 0) {
    if (ws_size < W_END) { fprintf(stderr, "kernel_launch: workspace too small (%zu < %zu)\n", ws_size, (size_t)W_END); grid_blocks = -1; return; }
    int dev = 0, cus = 0, per_cu = 0;
    hipGetDevice(&dev);
    hipDeviceGetAttribute(&cus, hipDeviceAttributeMultiprocessorCount, dev);
    hipFuncSetAttribute((const void*)fwd_megakernel, hipFuncAttributeMaxDynamicSharedMemorySize, SHM_B);
    hipOccupancyMaxActiveBlocksPerMultiprocessor(&per_cu, (const void*)fwd_megakernel, 512, SHM_B);
    if (per_cu < 1) { fprintf(stderr, "kernel_launch: occupancy query says %d blocks/CU\n", per_cu); per_cu = 1; }
    grid_blocks = cus;
  }
  if (grid_blocks < 0) return;
  Params p{};
  p.x_p = (const float*)d_in[0]; p.x_s = (const float*)d_in[1]; p.p_p = (const float*)d_in[2]; p.p_s = (const float*)d_in[3];
  p.cache_k = (const float*)d_in[4]; p.cache_v = (const float*)d_in[5]; p.cache_conv = (const float*)d_in[6];
  p.g_mix = (const float*)d_in[7]; p.w_in = (const float*)d_in[8]; p.conv_w = (const float*)d_in[9]; p.w_ao = (const float*)d_in[10];
  p.w_co = (const float*)d_in[11]; p.w_o = (const float*)d_in[12]; p.g_ffn = (const float*)d_in[13]; p.w_up = (const float*)d_in[14];
  p.w_dn = (const float*)d_in[15]; p.g_ple = (const float*)d_in[16]; p.w_pg = (const float*)d_in[17]; p.w_pl = (const float*)d_in[18];
  p.g_final = (const float*)d_in[19];
  p.out = (float*)d_out; p.ws = (unsigned char*)d_ws;
  (void)hipMemsetAsync((unsigned char*)d_ws + W_BAR, 0, XCD_BAR_WORDS * 4, stream);
  void* args[] = {&p};
  hipError_t e = hipLaunchCooperativeKernel((const void*)fwd_megakernel, dim3(grid_blocks), dim3(512), args, SHM_B, stream);
  if (e != hipSuccess) fprintf(stderr, "cooperative launch failed: %s (grid %d)\n", hipGetErrorString(e), grid_blocks);
}
```

```cpp
#include <hip/hip_runtime.h>
#include <hip/hip_cooperative_groups.h>
#include <cstdio>
#include <cstdint>
namespace cg = cooperative_groups;

#define DI __device__ __forceinline__
typedef unsigned short bf16_t;
typedef short bf16x8 __attribute__((ext_vector_type(8)));
typedef float f32x4 __attribute__((ext_vector_type(4)));
typedef float f32x2 __attribute__((ext_vector_type(2)));
typedef float f32x16 __attribute__((ext_vector_type(16)));
typedef unsigned u32x4 __attribute__((ext_vector_type(4)));
typedef unsigned u32x2 __attribute__((ext_vector_type(2)));
typedef __bf16 bf16v2 __attribute__((ext_vector_type(2)));

constexpr int D = 1024, NPROJ = 5120, MP = 32768, MS = 1024, M = MP + MS, SEQ = 8192, DSEQ = 32, PAST = 2048;
constexpr int NH = 8, HD = 64, SBW = 512, CW = 512, PLE = 256, DFF = 4096, P4W = 4096;
constexpr float EPS = 1e-6f;
constexpr size_t O_Y = 0, O_KP = (size_t)M * D, O_VP = O_KP + (size_t)MP * SBW, O_CP = O_VP + (size_t)MP * SBW,
                 O_KS = O_CP + 4 * 2 * CW, O_VS = O_KS + (size_t)MS * SBW, O_CS = O_VS + (size_t)MS * SBW;
constexpr size_t W_IN = 0, W_AO = W_IN + (size_t)NPROJ * D * 2, W_CO = W_AO + (size_t)D * SBW * 2, W_O = W_CO + (size_t)D * CW * 2,
                 W_UP = W_O + (size_t)D * D * 2, W_DN = W_UP + (size_t)DFF * D * 2, W_PG = W_DN + (size_t)D * DFF * 2,
                 W_PL = W_PG + (size_t)D * D * 2, W_RS0 = W_PL + (size_t)D * PLE * 2, W_SS = W_RS0 + (size_t)M * 4,
                 W_PB = W_SS + (size_t)3 * M * 4, W_RA = W_PB + (size_t)M * PLE * 2, W_RB = W_RA + (size_t)M * D * 2,
                 W_RC = W_RB + (size_t)M * D * 2, W_BAR = W_RC + (size_t)M * P4W * 2, W_PE = W_BAR + 16384, W_END = W_PE + (size_t)M * D * 2;

struct Params {
  const float *x_p, *x_s, *p_p, *p_s, *cache_k, *cache_v, *cache_conv;
  const float *g_mix, *w_in, *conv_w, *w_ao, *w_co, *w_o, *g_ffn, *w_up, *w_dn, *g_ple, *w_pg, *w_pl, *g_final;
  float* out; unsigned char* ws;
};

extern __shared__ __attribute__((aligned(16))) unsigned char dyn_lds[];

DI unsigned pk2(float lo, float hi) { f32x2 f = {lo, hi}; bf16v2 b = __builtin_convertvector(f, bf16v2); return __builtin_bit_cast(unsigned, b); }
DI float bf2f(unsigned h16) { return __uint_as_float(h16 << 16); }
DI float bflo(unsigned u) { return __uint_as_float(u << 16); }
DI float bfhi(unsigned u) { return __uint_as_float(u & 0xffff0000u); }
DI bf16x8 cvt8(f32x4 a, f32x4 b) { u32x4 u = {pk2(a.x, a.y), pk2(a.z, a.w), pk2(b.x, b.y), pk2(b.z, b.w)}; return __builtin_bit_cast(bf16x8, u); }
DI float sigmoidf_(float v) { return 1.f / (1.f + __expf(-v)); }
DI float wave_sum(float v) {
#pragma unroll
  for (int o = 1; o < 64; o <<= 1) v += __shfl_xor(v, o);
  return v;
}

constexpr int BM = 256, BK = 64, HALF = 128, NXCD = 8, WGM = 8, HT = HALF * BK, SHM_B = 8 * HT * 2;
DI int lds_byte(int r, int c) { int st = (r >> 4) * 2 + (c >> 5), rr = r & 15, cc = c & 31, ob = rr * 64 + cc * 2; return st * 1024 + (ob ^ (((ob >> 9) & 1) << 5)); }
DI void stage_rc(int b, int& R, int& C) { int st = b / 1024, sb = b % 1024, swz = sb ^ (((sb >> 9) & 1) << 5); R = (st >> 1) * 16 + swz / 64; C = (st & 1) * 32 + (swz % 64) / 2; }

DI bool tile_order(int i, int G, int c, int nM, int nN, int& pm, int& pn) {
  const int nwg = nM * nN; const long L = (long)i * G + c; if (L >= nwg) return false;
  int wgid = (int)L; { const int q = nwg / NXCD, r = nwg % NXCD, xcd = wgid % NXCD, off = wgid / NXCD; wgid = (xcd < r ? xcd * (q + 1) : r * (q + 1) + (xcd - r) * q) + off; }
  const int nig = WGM * nN, gid = wgid / nig, fm = gid * WGM, gsz = (nM - fm) < WGM ? (nM - fm) : WGM;
  pm = fm + ((wgid % nig) % gsz); pn = (wgid % nig) / gsz; return true;
}

typedef f32x4 acc_t[2][2][4][2];
struct Item { const char* cA; const char* cB; int brow, bcol, nt, tag; };
template <class F>
DI void epi_call(acc_t& acc, const int brow, const int bcol, const F& f) {
  int tid2 = threadIdx.x, brow2 = brow, bcol2 = bcol;
  asm volatile("" : "+v"(tid2), "+s"(brow2), "+s"(bcol2));
  const int wid2 = tid2 >> 6, lane2 = tid2 & 63;
  f(acc, brow2, bcol2, wid2 >> 2, wid2 & 3, lane2 & 15, lane2 >> 4);
}
template <class Sched>
DI void gemm_stream(const int ld, const Sched& sch) {
  char* lds = (char*)dyn_lds;
  int tid = threadIdx.x; asm volatile("" : "+v"(tid));
  const int wid = tid >> 6, lane = tid & 63, wr = wid >> 2, wc = wid & 3, fr = lane & 15, fq = lane >> 4;
  const int wbase = __builtin_amdgcn_readfirstlane((tid & ~63) * 16);
  unsigned voff0, voff1;
  { int r_, c_; stage_rc(tid * 16, r_, c_); voff0 = (unsigned)(r_ * ld + c_) * 2u; stage_rc(tid * 16 + 8192, r_, c_); voff1 = (unsigned)(r_ * ld + c_) * 2u; }
  const size_t kstep = (size_t)BK * 2, hstep = (size_t)HALF * ld * 2;
#define SA(b, h) (((b) * 2 + (h)) * (HT * 2))
#define SB(b, h) ((4 + (b) * 2 + (h)) * (HT * 2))
#define STAGE(bufoff, gbase) do { const char* _ub = (gbase); \
    __builtin_amdgcn_global_load_lds((const unsigned*)(_ub + voff0), (unsigned*)(lds + (bufoff) + wbase), 16, 0, 0); \
    __builtin_amdgcn_global_load_lds((const unsigned*)(_ub + voff1), (unsigned*)(lds + (bufoff) + wbase + 8192), 16, 0, 0); } while (0)
#define LDA(dst, b, h) for (int m = 0; m < 4; ++m) for (int k = 0; k < 2; ++k) \
    dst[m][k] = *reinterpret_cast<const bf16x8*>(lds + SA(b, h) + lds_byte(wr * 64 + m * 16 + fr, k * 32 + fq * 8))
#define LDB(dst, b, h) for (int n = 0; n < 2; ++n) for (int k = 0; k < 2; ++k) \
    dst[n][k] = *reinterpret_cast<const bf16x8*>(lds + SB(b, h) + lds_byte(wc * 32 + n * 16 + fr, k * 32 + fq * 8))
#define MMA(ai, bj, At_, Bt_) do { __builtin_amdgcn_s_setprio(1); \
    for (int m = 0; m < 4; ++m) for (int n = 0; n < 2; ++n) for (int k = 0; k < 2; ++k) \
      acc[ai][bj][m][n] = __builtin_amdgcn_mfma_f32_16x16x32_bf16(Bt_[n][k], At_[m][k], acc[ai][bj][m][n], 0, 0, 0); \
    __builtin_amdgcn_s_setprio(0); } while (0)
#define WAIT_V(n) asm volatile("s_waitcnt vmcnt(" #n ")" ::: "memory")
#define WAIT_L(n) asm volatile("s_waitcnt lgkmcnt(" #n ")" ::: "memory")
#define BAR __builtin_amdgcn_s_barrier()
#define SCHED __builtin_amdgcn_sched_barrier(0)
  Item cur, nxt; int ui = 0;
  if (!sch.next(0, cur)) return;
  acc_t acc = {};
  bf16x8 At[4][2], B0[2][2], B1[2][2];
  const char* cA = cur.cA; const char* cB = cur.cB;
  STAGE(SB(0, 0), cB); STAGE(SA(0, 0), cA); STAGE(SB(0, 1), cB + hstep); STAGE(SA(0, 1), cA + hstep);
  if (wr == 1) BAR;
  WAIT_V(4); BAR;
  STAGE(SB(1, 0), cB + kstep); STAGE(SA(1, 0), cA + kstep); STAGE(SB(1, 1), cB + hstep + kstep);
  WAIT_V(6); BAR;
  for (;;) {
    const bool has_next = sch.next(ui + 1, nxt);
    const char* nA = has_next ? nxt.cA : cA; const char* nB = has_next ? nxt.cB : cB;
    const int nt = cur.nt;
    for (int t = 0; t < nt; t += 2) {
      const bool last = (t == nt - 2);
      const char* a1 = cA + (size_t)(t + 1) * kstep;
      const char* a2 = last ? nA : cA + (size_t)(t + 2) * kstep; const char* b2 = last ? nB : cB + (size_t)(t + 2) * kstep;
      const char* a3 = a2 + kstep; const char* b3 = b2 + kstep;
      LDB(B0, 0, 0); SCHED; LDA(At, 0, 0); STAGE(SA(1, 1), a1 + hstep);
      WAIT_L(8); BAR; WAIT_L(0); MMA(0, 0, At, B0); BAR; SCHED;
      LDB(B1, 0, 1); STAGE(SB(0, 0), b2);
      BAR; WAIT_L(0); MMA(0, 1, At, B1); BAR;
      LDA(At, 0, 1); STAGE(SA(0, 0), a2);
      BAR; WAIT_L(0); MMA(1, 0, At, B0); BAR; SCHED;
      STAGE(SB(0, 1), b2 + hstep);
      WAIT_V(6); BAR; MMA(1, 1, At, B1); BAR;
      LDB(B0, 1, 0); SCHED; LDA(At, 1, 0); STAGE(SA(0, 1), a2 + hstep);
      WAIT_L(8); BAR; WAIT_L(0); MMA(0, 0, At, B0); BAR; SCHED;
      LDB(B1, 1, 1); STAGE(SB(1, 0), b3);
      BAR; WAIT_L(0); MMA(0, 1, At, B1); BAR;
      LDA(At, 1, 1); STAGE(SA(1, 0), a3);
      BAR; WAIT_L(0); MMA(1, 0, At, B0); BAR; SCHED;
      STAGE(SB(1, 1), b3 + hstep);
      WAIT_V(6); BAR; MMA(1, 1, At, B1); BAR;
    }
    const bool keep = sch.epi(acc, cur);
    if (!has_next) break;
    if (!keep) {
#pragma unroll
      for (int a_ = 0; a_ < 2; ++a_)
#pragma unroll
        for (int b_ = 0; b_ < 2; ++b_)
#pragma unroll
          for (int m = 0; m < 4; ++m)
#pragma unroll
            for (int n = 0; n < 2; ++n) acc[a_][b_][m][n] = (f32x4){0.f, 0.f, 0.f, 0.f}; }
    cur = nxt; cA = nA; cB = nB; ++ui;
  }
  WAIT_V(0);
  if (wr == 0) BAR;
  BAR;
}
template <class Epi>
struct SchedStd {
  const bf16_t* A; const bf16_t* Bt; int nM, nN, K; Epi e;
  DI bool next(int i, Item& it) const { int pm, pn; if (!tile_order(i, gridDim.x, blockIdx.x, nM, nN, pm, pn)) return false;
    it.brow = pm * BM; it.bcol = pn * BM; it.cA = (const char*)(A + (size_t)it.brow * K); it.cB = (const char*)(Bt + (size_t)it.bcol * K); it.nt = K / BK; it.tag = 0; return true; }
  DI bool epi(acc_t& acc, const Item& it) const { epi_call(acc, it.brow, it.bcol, e); return false; }
};
template <class Epi>
DI void gemm_phase(const bf16_t* A, const bf16_t* Bt, int Mrows, int N, int K, const Epi& epi) {
  const SchedStd<Epi> sch{A, Bt, Mrows / BM, N / BM, K, epi};
  gemm_stream(K, sch);
}

DI void st_bf16x4(bf16_t* p, f32x4 v) { u32x2 u = {pk2(v.x, v.y), pk2(v.z, v.w)}; *(u32x2*)p = u; }
DI f32x4 ld_bf16x4(const bf16_t* p) { u32x2 u = *(const u32x2*)p; f32x4 v = {bflo(u.x), bfhi(u.x), bflo(u.y), bfhi(u.y)}; return v; }

#define EPI_ROWS for (int ai = 0; ai < 2; ++ai) for (int m = 0; m < 4; ++m)
#define EPI_COLS for (int bj = 0; bj < 2; ++bj) for (int n = 0; n < 2; ++n)
#define EPI_BJ for (int bj = 0; bj < 2; ++bj)
#define EPI_ROW (brow + ai * HALF + wr * 64 + m * 16 + fr)
#define EPI_COL (bcol + bj * HALF + wc * 32 + n * 16 + fq * 4)
#define EPI_COL8 (bcol + bj * HALF + wc * 32 + fq * 8)
DI void st_bf16x8(bf16_t* p, f32x4 a, f32x4 b) { u32x4 u = {pk2(a.x, a.y), pk2(a.z, a.w), pk2(b.x, b.y), pk2(b.z, b.w)}; *(u32x4*)p = u; }
DI void unpack8(const u32x4 u, f32x4& a, f32x4& b) { a = (f32x4){bflo(u.x), bfhi(u.x), bflo(u.y), bfhi(u.y)}; b = (f32x4){bflo(u.z), bfhi(u.z), bflo(u.w), bfhi(u.w)}; }

struct EpiIn {
  const float* rs0; bf16_t* proj4; float* out;
  DI void operator()(const acc_t& acc, int brow, int bcol, int wr, int wc, int fr, int fq) const {
    float rr[2][4];
#pragma unroll
    EPI_ROWS rr[ai][m] = rs0[EPI_ROW];
    if (bcol >= 512 && bcol < 1536) {
#pragma unroll
      EPI_ROWS { const int row = EPI_ROW; const float r = rr[ai][m];
#pragma unroll
        EPI_COLS { const int col = EPI_COL; f32x4 v = acc[ai][bj][m][n] * r;
          const int isv = bcol >= 1024; const int c = col - (isv ? 1024 : 512);
          float* dst = (row < MP) ? out + (isv ? O_VP : O_KP) + (size_t)row * SBW + c : out + (isv ? O_VS : O_KS) + (size_t)(row - MP) * SBW + c;
          *(f32x4*)dst = v; } }
    } else if (bcol < 2048) {
      const float sc = (bcol < 512) ? 0.18033688011112042f   : 1.f; const int sh = (bcol < 512) ? 0 : 1024;
#pragma unroll
      EPI_ROWS { const int row = EPI_ROW; const float r = rr[ai][m] * sc;
#pragma unroll
        EPI_BJ { st_bf16x8(proj4 + (size_t)row * P4W + (EPI_COL8 - sh), acc[ai][bj][m][0] * r, acc[ai][bj][m][1] * r); } }
    } else {
      const bool gate = bcol >= 3072; const int t = ((bcol - (gate ? 3072 : 2048)) >> 8) * 128;
#pragma unroll
      EPI_ROWS { const int row = EPI_ROW; const float r = rr[ai][m]; const int ch = t + wc * 32 + fq * 8;
        const f32x4 a0 = acc[ai][0][m][0] * r, a1 = acc[ai][0][m][1] * r, b0 = acc[ai][1][m][0] * r, b1 = acc[ai][1][m][1] * r;
        if (!gate) { st_bf16x8(proj4 + (size_t)row * P4W + 1024 + ch, a0 * b0, a1 * b1); }
        else { f32x4 rho0, rho1, sg0, sg1;
#pragma unroll
          for (int e = 0; e < 4; ++e) {
            { const float ea = __expf(-a0[e]), eb = __expf(-fmaxf(b0[e], -80.f)); sg0[e] = 1.f / (1.f + eb); rho0[e] = (1.f + eb) / (1.f + ea); }
            { const float ea = __expf(-a1[e]), eb = __expf(-fmaxf(b1[e], -80.f)); sg1[e] = 1.f / (1.f + eb); rho1[e] = (1.f + eb) / (1.f + ea); } }
          st_bf16x8(proj4 + (size_t)row * P4W + 2048 + ch, rho0, rho1); st_bf16x8(proj4 + (size_t)row * P4W + 3072 + ch, sg0, sg1); } }
    }
  }
};
template <bool FINAL>
struct EpiGate {
  const bf16_t* proj4; int off; bf16_t* merged;
  DI void operator()(acc_t& acc, int brow, int bcol, int wr, int wc, int fr, int fq) const {
    u32x4 g[2][4][2];
#pragma unroll
    EPI_ROWS { const int row = EPI_ROW;
#pragma unroll
      EPI_BJ g[ai][m][bj] = *(const u32x4*)(proj4 + (size_t)row * P4W + off + EPI_COL8); }
#pragma unroll
    EPI_ROWS { const int row = EPI_ROW;
#pragma unroll
      EPI_BJ { f32x4 g0, g1; unpack8(g[ai][m][bj], g0, g1);
        if (FINAL) st_bf16x8(merged + (size_t)row * D + EPI_COL8, acc[ai][bj][m][0] * g0, acc[ai][bj][m][1] * g1);
        else { acc[ai][bj][m][0] *= g0; acc[ai][bj][m][1] *= g1; } } }
  }
};
template <int MODE>
struct EpiRes {
  const float *x_p, *x_s; const bf16_t* resb; bf16_t* outb; float* ss; const float* ssprev; const bf16_t* pe;
  DI void operator()(const acc_t& acc, int brow, int bcol, int wr, int wc, int fr, int fq) const {
#pragma unroll
    for (int ai = 0; ai < 2; ++ai) {
      f32x4 resf[4][2][2]; u32x4 resh[4][2], peh[4][2]; float rr[4];
#pragma unroll
      for (int m = 0; m < 4; ++m) { const int row = EPI_ROW;
        if (MODE == 2) rr[m] = ssprev[row];
#pragma unroll
        EPI_BJ { const int col = EPI_COL8;
          if (MODE == 0) { const float* xp = (row < MP) ? x_p + (size_t)row * D + col : x_s + (size_t)(row - MP) * D + col;
            resf[m][bj][0] = *(const f32x4*)xp; resf[m][bj][1] = *(const f32x4*)(xp + 4); }
          else resh[m][bj] = *(const u32x4*)(resb + (size_t)row * D + col);
          if (MODE == 2) peh[m][bj] = *(const u32x4*)(pe + (size_t)row * D + col); } }
#pragma unroll
      for (int m = 0; m < 4; ++m) { const int row = EPI_ROW; float part = 0.f; float r = 0.f;
        if (MODE == 2) r = rsqrtf(rr[m] * (1.f / D) + EPS);
#pragma unroll
        EPI_BJ { const int col = EPI_COL8; f32x4 a0 = acc[ai][bj][m][0], a1 = acc[ai][bj][m][1]; f32x4 r0, r1;
          if (MODE == 0) { r0 = resf[m][bj][0]; r1 = resf[m][bj][1]; } else unpack8(resh[m][bj], r0, r1);
          if (MODE == 2) { f32x4 e0, e1; unpack8(peh[m][bj], e0, e1); a0 = a0 * r; a1 = a1 * r;
            const f32x4 s0 = {sigmoidf_(a0.x), sigmoidf_(a0.y), sigmoidf_(a0.z), sigmoidf_(a0.w)}, s1 = {sigmoidf_(a1.x), sigmoidf_(a1.y), sigmoidf_(a1.z), sigmoidf_(a1.w)};
            a0 = s0 * e0; a1 = s1 * e1; }
          const f32x4 o0 = r0 + a0, o1 = r1 + a1;
          st_bf16x8(outb + (size_t)row * D + col, o0, o1);
          part += (o0.x * o0.x + o0.y * o0.y + o0.z * o0.z + o0.w * o0.w) + (o1.x * o1.x + o1.y * o1.y + o1.z * o1.z + o1.w * o1.w); }
        part += __shfl_xor(part, 16); part += __shfl_xor(part, 32);
        if (fq == 0) atomicAdd(ss + row, part); }
    }
  }
};
struct EpiUp {
  const float* ss1; bf16_t* u;
  DI void operator()(const acc_t& acc, int brow, int bcol, int wr, int wc, int fr, int fq) const {
    float rr[2][4];
#pragma unroll
    EPI_ROWS rr[ai][m] = ss1[EPI_ROW];
#pragma unroll
    EPI_ROWS { const int row = EPI_ROW; const float r = rsqrtf(rr[ai][m] * (1.f / D) + EPS);
#pragma unroll
      EPI_BJ { f32x4 a0 = acc[ai][bj][m][0] * r, a1 = acc[ai][bj][m][1] * r;
        const f32x4 z0 = {fmaxf(a0.x, 0.f), fmaxf(a0.y, 0.f), fmaxf(a0.z, 0.f), fmaxf(a0.w, 0.f)}, z1 = {fmaxf(a1.x, 0.f), fmaxf(a1.y, 0.f), fmaxf(a1.z, 0.f), fmaxf(a1.w, 0.f)};
        st_bf16x8(u + (size_t)row * DFF + EPI_COL8, z0 * z0, z1 * z1); } }
  }
};
struct EpiPartial {
  float* part;
  DI void operator()(const acc_t& acc, int brow, int bcol, int wr, int wc, int fr, int fq) const {
#pragma unroll
    EPI_ROWS { const int row = EPI_ROW;
#pragma unroll
      EPI_BJ { float* d = part + (size_t)row * D + EPI_COL8; *(f32x4*)d = acc[ai][bj][m][0]; *(f32x4*)(d + 4) = acc[ai][bj][m][1]; } }
  }
};
struct EpiPe {
  bf16_t* pe;
  DI void operator()(const acc_t& acc, int brow, int bcol, int wr, int wc, int fr, int fq) const {
#pragma unroll
    EPI_ROWS { const int row = EPI_ROW;
#pragma unroll
      EPI_BJ { st_bf16x8(pe + (size_t)row * D + EPI_COL8, acc[ai][bj][m][0], acc[ai][bj][m][1]); } }
  }
};

DI int win_perm(int n) {
  if (n < 2048) return n;
  if (n < 3072) { const int r = n - 2048, c = r & 511; return 2048 + 256 * (c >> 7) + ((r >> 9) ? 128 : 0) + (c & 127); }
  const int r = n - 3072, c = r & 1023; return 3072 + 256 * (c >> 7) + ((r >> 10) ? 128 : 0) + (c & 127);
}
template <bool PERM>
DI void transpose_item(const float* __restrict__ W, const float* __restrict__ g, int K, int N, bf16_t* __restrict__ WT, float* scr, int item, int lane) {
  const int nblk = N / 32, kb = item / nblk, nb = item % nblk, k0 = 64 * kb, n0 = 32 * nb;
  const int n0d = PERM ? win_perm(n0) : n0;
  const bool p32 = !(PERM && n0 >= 512 && n0 < 1536);
  float wv[32];
#pragma unroll
  for (int i = 0; i < 32; ++i) { const int kk = 2 * i + (lane >> 5); wv[i] = W[(size_t)(k0 + kk) * N + n0 + (lane & 31)]; }
  if (g) {
#pragma unroll
    for (int i = 0; i < 32; ++i) wv[i] *= g[k0 + 2 * i + (lane >> 5)]; }
#pragma unroll
  for (int i = 0; i < 32; ++i) scr[(2 * i + (lane >> 5)) * 33 + (lane & 31)] = wv[i];
  asm volatile("s_waitcnt lgkmcnt(0)" ::: "memory");
  const int c = lane & 7;
#pragma unroll
  for (int j = 0; j < 4; ++j) { const int n = (lane >> 3) + 8 * j; const int ns = p32 ? (8 * ((n & 15) >> 2) + 4 * (n >> 4) + (n & 3)) : n; const float* s = scr + (8 * c) * 33 + ns;
    u32x4 o = {pk2(s[0 * 33], s[1 * 33]), pk2(s[2 * 33], s[3 * 33]), pk2(s[4 * 33], s[5 * 33]), pk2(s[6 * 33], s[7 * 33])};
    *(u32x4*)(WT + (size_t)(n0d + n) * K + k0 + 8 * c) = o; }
  asm volatile("s_waitcnt lgkmcnt(0)" ::: "memory");
}

#define MFMA32(a, b, c) __builtin_amdgcn_mfma_f32_32x32x16_bf16((a), (b), (c), 0, 0, 0)
DI void attn_load(const float* __restrict__ Kp, const float* __restrict__ Vp, int i, int half, f32x4 (&kr)[8], float (&vr)[32]) {
#pragma unroll
  for (int s = 0; s < 4; ++s) { const f32x4* kp = (const f32x4*)(Kp + (size_t)i * SBW + 16 * s + 8 * half); kr[2 * s] = kp[0]; kr[2 * s + 1] = kp[1]; }
#pragma unroll
  for (int s = 0; s < 2; ++s)
#pragma unroll
    for (int jj = 0; jj < 8; ++jj) { const int key = 16 * s + 8 * (jj >> 2) + 4 * half + (jj & 3);
      vr[(2 * s) * 8 + jj] = Vp[(size_t)key * SBW + i]; vr[(2 * s + 1) * 8 + jj] = Vp[(size_t)key * SBW + 32 + i]; }
}
template <bool DIAG>
DI void attn_weights(const f32x16& sacc, int i, int half, float& C, float (&a)[16]) {
  float be[16], om[16];
#pragma unroll
  for (int r = 0; r < 16; ++r) { const float z = sacc[r];
    const float e = __builtin_amdgcn_exp2f(-fabsf(z)), rc = __builtin_amdgcn_rcpf(1.f + e), er = e * rc;
    float b = (z >= 0.f) ? rc : er, o = (z >= 0.f) ? er : rc;
    if (DIAG) { const int key = (r & 3) + 8 * (r >> 2) + 4 * half; const bool valid = key < i; b = valid ? b : 0.f; o = valid ? o : 1.f; }
    be[r] = b; om[r] = o; }
  float G[4], Pn[4];
#pragma unroll
  for (int g = 0; g < 4; ++g) { G[g] = (om[4 * g] * om[4 * g + 1]) * (om[4 * g + 2] * om[4 * g + 3]); Pn[g] = __shfl_xor(G[g], 32); }
  float run = C;
#pragma unroll
  for (int g = 3; g >= 0; --g) { float t = half ? run : run * Pn[g];
#pragma unroll
    for (int u = 3; u >= 0; --u) { a[4 * g + u] = be[4 * g + u] * t; t *= om[4 * g + u]; }
    run *= G[g] * Pn[g]; }
  C = run;
}
DI void attn_task(const Params& p, const int qb, const int h, int lane) {
  const bf16_t* proj4 = (const bf16_t*)(p.ws + W_RC);
  bf16_t* attn = (bf16_t*)(p.ws + W_RB);
  const int i = lane & 31, half = lane >> 5;
  int qtok0, nblk; const float *k0p, *v0p, *k1p, *v1p;
  if (qb < MP / 32) { const int b = qb >> 8, t0 = (qb & 255) * 32; qtok0 = b * SEQ + t0; nblk = (t0 >> 5) + 1;
    k0p = p.out + O_KP + (size_t)qtok0 * SBW; v0p = p.out + O_VP + (size_t)qtok0 * SBW; k1p = k0p; v1p = v0p; }
  else { const int b = qb - MP / 32; qtok0 = MP + b * DSEQ; nblk = 1 + PAST / 32;
    k0p = p.out + O_KS + (size_t)(b * DSEQ) * SBW; v0p = p.out + O_VS + (size_t)(b * DSEQ) * SBW;
    k1p = p.cache_k + (size_t)(b * PAST + PAST) * SBW; v1p = p.cache_v + (size_t)(b * PAST + PAST) * SBW; }
  k0p += h * HD; v0p += h * HD; k1p += h * HD; v1p += h * HD;
  bf16x8 qf[4];
  { const bf16_t* qp = proj4 + (size_t)(qtok0 + i) * P4W + h * HD + 8 * half;
#pragma unroll
    for (int s = 0; s < 4; ++s) qf[s] = *(const bf16x8*)(qp + 16 * s); }
  f32x16 o0 = {}, o1 = {};
  float C = 1.f;
  f32x4 kr[8]; float vr[32];
  bf16x8 kf[4], vf[4];
#define ATTN_CVT() do { _Pragma("unroll") for (int s = 0; s < 4; ++s) kf[s] = cvt8(kr[2 * s], kr[2 * s + 1]); \
    _Pragma("unroll") for (int q = 0; q < 4; ++q) { u32x4 v = {pk2(vr[8 * q], vr[8 * q + 1]), pk2(vr[8 * q + 2], vr[8 * q + 3]), pk2(vr[8 * q + 4], vr[8 * q + 5]), pk2(vr[8 * q + 6], vr[8 * q + 7])}; \
      vf[q] = __builtin_bit_cast(bf16x8, v); } } while (0)
  attn_load(k0p, v0p, i, half, kr, vr);
  ATTN_CVT();
  for (int it = 0; it < nblk; ++it) {
    { const int itn = (it + 1 < nblk) ? it + 1 : it;
      attn_load(k1p - (size_t)itn * 32 * SBW, v1p - (size_t)itn * 32 * SBW, i, half, kr, vr); }
    __builtin_amdgcn_sched_barrier(0);
    f32x16 sacc = {};
#pragma unroll
    for (int s = 0; s < 4; ++s) sacc = MFMA32(kf[s], qf[s], sacc);
    float a[16];
    if (it == 0) attn_weights<true>(sacc, i, half, C, a); else attn_weights<false>(sacc, i, half, C, a);
#pragma unroll
    for (int s = 0; s < 2; ++s) {
      u32x4 pu = {pk2(a[8 * s], a[8 * s + 1]), pk2(a[8 * s + 2], a[8 * s + 3]), pk2(a[8 * s + 4], a[8 * s + 5]), pk2(a[8 * s + 6], a[8 * s + 7])};
      const bf16x8 pf = __builtin_bit_cast(bf16x8, pu);
      o0 = MFMA32(vf[2 * s], pf, o0);
      o1 = MFMA32(vf[2 * s + 1], pf, o1); }
    if (__all(C == 0.f)) break;
    __builtin_amdgcn_sched_barrier(0);
    ATTN_CVT();
  }
  bf16_t* op = attn + (size_t)(qtok0 + i) * SBW + h * HD + 4 * half;
#pragma unroll
  for (int g = 0; g < 4; ++g) {
    f32x4 a0 = {o0[4 * g], o0[4 * g + 1], o0[4 * g + 2], o0[4 * g + 3]}; st_bf16x4(op + 8 * g, a0);
    f32x4 a1 = {o1[4 * g], o1[4 * g + 1], o1[4 * g + 2], o1[4 * g + 3]}; st_bf16x4(op + 32 + 8 * g, a1); }
}

DI void conv_items(const Params& p) {
  const bf16_t* proj4 = (const bf16_t*)(p.ws + W_RC);
  bf16_t* convg = (bf16_t*)(p.ws + W_RB) + (size_t)M * SBW;
  const int total = (M / 8) * (CW / 8);
  int rank = blockIdx.x, nact = gridDim.x;
  if (gridDim.x == 256) {
    const int c = blockIdx.x; if ((c & 7) == ((c >> 3) & 7)) return;
    rank = c - (8 * (c >> 6) + ((c & 63) + 8) / 9); nact = 256 - 32; }
  for (int idx = rank * blockDim.x + threadIdx.x; idx < total; idx += nact * blockDim.x) {
    const int tok0 = (idx >> 6) * 8, c0 = (idx & 63) * 8;
    int b, t0, T; const float* buf; float* nb;
    if (tok0 < MP) { b = tok0 >> 13; t0 = tok0 & (SEQ - 1); T = SEQ; buf = nullptr; nb = p.out + O_CP + (size_t)b * 2 * CW; }
    else { const int s = tok0 - MP; b = s >> 5; t0 = s & (DSEQ - 1); T = DSEQ; buf = p.cache_conv + (size_t)b * 2 * CW; nb = p.out + O_CS + (size_t)b * 2 * CW; }
    const bf16_t* row = proj4 + (size_t)tok0 * P4W + c0;
    u32x4 ur[10], cr[8];
#pragma unroll
    for (int j = 0; j < 8; ++j) { ur[j + 2] = *(const u32x4*)(row + (size_t)j * P4W + 1024); cr[j] = *(const u32x4*)(row + (size_t)j * P4W + 512); }
    float w0[8], w1[8], w2[8];
#pragma unroll
    for (int e = 0; e < 8; ++e) { w0[e] = p.conv_w[c0 + e]; w1[e] = p.conv_w[CW + c0 + e]; w2[e] = p.conv_w[2 * CW + c0 + e]; }
    float um2[8], um1[8];
    if (t0 > 0) { const u32x4 x2 = *(const u32x4*)(row - 2 * (size_t)P4W + 1024), x1 = *(const u32x4*)(row - (size_t)P4W + 1024);
#pragma unroll
      for (int e = 0; e < 4; ++e) { um2[2 * e] = bflo(x2[e]); um2[2 * e + 1] = bfhi(x2[e]); um1[2 * e] = bflo(x1[e]); um1[2 * e + 1] = bfhi(x1[e]); } }
    else {
#pragma unroll
      for (int e = 0; e < 8; ++e) { um2[e] = buf ? buf[c0 + e] : 0.f; um1[e] = buf ? buf[CW + c0 + e] : 0.f; } }
#pragma unroll
    for (int j = 0; j < 8; ++j) {
      float u0[8], cbv[8], o[8];
#pragma unroll
      for (int e = 0; e < 4; ++e) { u0[2 * e] = bflo(ur[j + 2][e]); u0[2 * e + 1] = bfhi(ur[j + 2][e]); cbv[2 * e] = bflo(cr[j][e]); cbv[2 * e + 1] = bfhi(cr[j][e]); }
#pragma unroll
      for (int e = 0; e < 8; ++e) o[e] = cbv[e] * (w0[e] * um2[e] + w1[e] * um1[e] + w2[e] * u0[e]);
      u32x4 ov = {pk2(o[0], o[1]), pk2(o[2], o[3]), pk2(o[4], o[5]), pk2(o[6], o[7])};
      *(u32x4*)(convg + (size_t)(tok0 + j) * CW + c0) = ov;
      if (t0 + j >= T - 2) { float* d = nb + (size_t)(t0 + j - (T - 2)) * CW + c0;
#pragma unroll
        for (int e = 0; e < 8; ++e) d[e] = u0[e]; }
#pragma unroll
      for (int e = 0; e < 8; ++e) { um2[e] = um1[e]; um1[e] = u0[e]; }
    }
  }
}

#define XB_TMO      128
#define XB_XCNT(j)  (256  + 64 * (j))
#define XB_XSUB(j)  (1280 + 64 * (j))
#define XB_XGEN(j)  (2304 + 64 * (j))
#define XB_TOP      3328
#define XB_TOPGEN   3392
#define XCD_BAR_WORDS 3456
#define XB_SPIN_CAP (1u << 18)
#define LAS __attribute__((address_space(3)))
DI unsigned xb_ld(unsigned* p) { return __hip_atomic_load(p, __ATOMIC_RELAXED, __HIP_MEMORY_SCOPE_AGENT); }
DI unsigned xb_add(unsigned* p, unsigned v) { return __hip_atomic_fetch_add(p, v, __ATOMIC_RELAXED, __HIP_MEMORY_SCOPE_AGENT); }
DI unsigned xb_xcc_id() { return (unsigned)__builtin_amdgcn_s_getreg((3 << 11) | 20) & 0xFu; }
#define XB_SPIN(cond, bar) do { unsigned _sp = 0; while (cond) { __builtin_amdgcn_s_sleep(1); \
    if ((++_sp & 255u) == 0u) { if (xb_ld(&(bar)[XB_TMO])) break; if (_sp > XB_SPIN_CAP) { atomicAdd(&(bar)[XB_TMO], 1u); break; } } } } while (0)
struct XcdBarrier { unsigned* bar; unsigned x; volatile LAS unsigned* st; };
DI XcdBarrier xcd_barrier_post(unsigned* bar, volatile LAS unsigned* st) {
  XcdBarrier b; b.bar = bar; b.x = xb_xcc_id(); b.st = st;
  if (threadIdx.x == 0) (void)xb_add(&bar[XB_XCNT(b.x)], 1u);
  return b;
}
DI void xcd_barrier_complete(unsigned* bar, unsigned x, unsigned& nloc, unsigned& nx) {
  const unsigned G = gridDim.x * gridDim.y * gridDim.z;
  unsigned sum, cnt, mine, sp = 0u;
  for (;;) {
    sum = 0u; cnt = 0u; mine = 0u;
#pragma unroll
    for (unsigned j = 0; j < 16; ++j) { const unsigned c = xb_ld(&bar[XB_XCNT(j)]); sum += c; cnt += (c > 0u) ? 1u : 0u; mine = (j == x) ? c : mine; }
    if (sum == G) break;
    __builtin_amdgcn_s_sleep(1);
    if ((++sp & 255u) == 0u) { if (xb_ld(&bar[XB_TMO])) break; if (sp > XB_SPIN_CAP) { atomicAdd(&bar[XB_TMO], 1u); break; } }
  }
  nloc = mine > 0u ? mine : 1u; nx = cnt > 0u ? cnt : 1u;
}
DI void xcd_barrier(const XcdBarrier& b) {
  asm volatile("s_waitcnt vmcnt(0)" ::: "memory");
  __syncthreads();
  if (threadIdx.x == 0) {
    unsigned* bar = b.bar;
    __builtin_amdgcn_s_waitcnt(0);
    unsigned nloc = b.st[0], nx = b.st[1];
    if (nloc == 0u) { xcd_barrier_complete(bar, b.x, nloc, nx); b.st[0] = nloc; b.st[1] = nx; }
    const unsigned old = xb_add(&bar[XB_XSUB(b.x)], 1u);
    const unsigned gen = old / nloc;
    if (old + 1u == (gen + 1u) * nloc) {
      __builtin_amdgcn_fence(__ATOMIC_RELEASE, "agent");
      asm volatile("s_waitcnt vmcnt(0)" ::: "memory");
      const unsigned og = xb_add(&bar[XB_TOP], 1u);
      const unsigned tg = og / nx;
      if (og + 1u == (tg + 1u) * nx) xb_add(&bar[XB_TOPGEN], 1u);
      else XB_SPIN(xb_ld(&bar[XB_TOPGEN]) == tg, bar);
      __builtin_amdgcn_fence(__ATOMIC_ACQUIRE, "agent");
      xb_add(&bar[XB_XGEN(b.x)], 1u);
      asm volatile("s_waitcnt vmcnt(0)" ::: "memory");
    } else {
      XB_SPIN(xb_ld(&bar[XB_XGEN(b.x)]) == gen, bar);
      __builtin_amdgcn_fence(__ATOMIC_ACQUIRE, "agent");
      asm volatile("s_waitcnt vmcnt(0)" ::: "memory");
    }
  }
  __syncthreads();
}

struct SchedPe {
  const bf16_t* pb; const bf16_t* wPlT; int q, nidle; EpiPe e;
  DI bool next(int i, Item& it) const { const int t = q + i * nidle; if (q < 0 || t >= (M / BM) * (D / BM)) return false;
    it.brow = (t >> 2) * BM; it.bcol = (t & 3) * BM; it.cA = (const char*)(pb + (size_t)it.brow * PLE); it.cB = (const char*)(wPlT + (size_t)it.bcol * PLE); it.nt = PLE / BK; it.tag = 0; return true; }
  DI bool epi(acc_t& acc, const Item& it) const { epi_call(acc, it.brow, it.bcol, e); return false; }
};
struct SchedP3 {
  const bf16_t *attn, *convg, *wAoT, *wCoT; const bf16_t* proj4; bf16_t* merged;
  DI bool next(int i, Item& it) const { int pm, pn; if (!tile_order(i >> 1, gridDim.x, blockIdx.x, M / BM, D / BM, pm, pn)) return false;
    it.brow = pm * BM; it.bcol = pn * BM; it.tag = i & 1; it.nt = SBW / BK;
    it.cA = (const char*)(((i & 1) ? convg : attn) + (size_t)it.brow * SBW); it.cB = (const char*)(((i & 1) ? wCoT : wAoT) + (size_t)it.bcol * SBW); return true; }
  DI bool epi(acc_t& acc, const Item& it) const {
    if (it.tag == 0) { const EpiGate<false> e{proj4, 2048, nullptr}; epi_call(acc, it.brow, it.bcol, e); return true; }
    const EpiGate<true> e{proj4, 3072, merged}; epi_call(acc, it.brow, it.bcol, e); return false; }
};
struct SchedP6 {
  const bf16_t *u, *wDnT; float* part; EpiRes<1> e;
  DI bool next(int i, Item& it) const { const int G = gridDim.x, c = blockIdx.x; int pm, pn;
    if (tile_order(i, G, c, MP / BM, D / BM, pm, pn)) { it.brow = pm * BM; it.bcol = pn * BM; it.nt = DFF / BK; it.tag = 0;
      it.cA = (const char*)(u + (size_t)it.brow * DFF); it.cB = (const char*)(wDnT + (size_t)it.bcol * DFF); return true; }
    const int ntl = (MP / BM) * (D / BM), nmine = (c < ntl) ? (ntl - c + G - 1) / G : 0, j = c + (i - nmine) * G;
    if (j >= (MS / BM) * (D / BM) * 4) return false;
    const int kq = j & 3; it.brow = (j >> 4) * BM; it.bcol = ((j >> 2) & 3) * BM; it.nt = DFF / 4 / BK; it.tag = 1 + kq;
    it.cA = (const char*)(u + (size_t)(MP + it.brow) * DFF + kq * (DFF / 4)); it.cB = (const char*)(wDnT + (size_t)it.bcol * DFF + kq * (DFF / 4)); return true; }
  DI bool epi(acc_t& acc, const Item& it) const {
    if (it.tag == 0) { epi_call(acc, it.brow, it.bcol, e); return false; }
    const EpiPartial ep{part + (size_t)(it.tag - 1) * MS * D}; epi_call(acc, it.brow, it.bcol, ep); return false; }
};

struct SchedP7 {
  const bf16_t *x2b, *wPgT; float* part; EpiRes<2> e;
  DI bool next(int i, Item& it) const { const int G = gridDim.x, c = blockIdx.x; int pm, pn;
    if (tile_order(i, G, c, MP / BM, D / BM, pm, pn)) { it.brow = pm * BM; it.bcol = pn * BM; it.nt = D / BK; it.tag = 0;
      it.cA = (const char*)(x2b + (size_t)it.brow * D); it.cB = (const char*)(wPgT + (size_t)it.bcol * D); return true; }
    const int ntl = (MP / BM) * (D / BM), nmine = (c < ntl) ? (ntl - c + G - 1) / G : 0, j = c + (i - nmine) * G;
    if (j >= (MS / BM) * (D / BM) * 4) return false;
    const int kq = j & 3; it.brow = (j >> 4) * BM; it.bcol = ((j >> 2) & 3) * BM; it.nt = D / 4 / BK; it.tag = 1 + kq;
    it.cA = (const char*)(x2b + (size_t)(MP + it.brow) * D + kq * (D / 4)); it.cB = (const char*)(wPgT + (size_t)it.bcol * D + kq * (D / 4)); return true; }
  DI bool epi(acc_t& acc, const Item& it) const {
    if (it.tag == 0) { epi_call(acc, it.brow, it.bcol, e); return false; }
    const EpiPartial ep{part + (size_t)(it.tag - 1) * MS * D}; epi_call(acc, it.brow, it.bcol, ep); return false; }
};

__global__ void __launch_bounds__(512, 2) fwd_megakernel(Params p) {
  cg::grid_group grid = cg::this_grid();
  const int NGW = gridDim.x * 8, NT = gridDim.x * blockDim.x;
#define PHASE_IDS int tid_ = threadIdx.x; asm volatile("" : "+v"(tid_)); const int lane = tid_ & 63, wave = tid_ >> 6, gw = blockIdx.x * 8 + wave, gtid = blockIdx.x * 512 + tid_; (void)lane; (void)wave; (void)gw; (void)gtid;
  unsigned char* ws = p.ws;
  bf16_t *wInT = (bf16_t*)(ws + W_IN), *wAoT = (bf16_t*)(ws + W_AO), *wCoT = (bf16_t*)(ws + W_CO), *wOT = (bf16_t*)(ws + W_O),
         *wUpT = (bf16_t*)(ws + W_UP), *wDnT = (bf16_t*)(ws + W_DN), *wPgT = (bf16_t*)(ws + W_PG), *wPlT = (bf16_t*)(ws + W_PL);
  float* rs0 = (float*)(ws + W_RS0); float* ss = (float*)(ws + W_SS);
  bf16_t* PE = (bf16_t*)(ws + W_PE);
  bf16_t *pb = (bf16_t*)(ws + W_PB), *RA = (bf16_t*)(ws + W_RA), *RB = (bf16_t*)(ws + W_RB), *RC = (bf16_t*)(ws + W_RC);
  float* y = p.out + O_Y;
  constexpr int I0 = (D / 64) * (NPROJ / 32), I1 = (SBW / 64) * (D / 32), I2 = I1, I3 = (D / 64) * (D / 32), I4 = (D / 64) * (DFF / 32),
                  I5 = (DFF / 64) * (D / 32), I6 = I3, I7 = (PLE / 64) * (D / 32), NI = I0 + I1 + I2 + I3 + I4 + I5 + I6 + I7;
  __shared__ uint4 xb_words;
  if (threadIdx.x == 0) xb_words = make_uint4(0u, 0u, 0u, 0u);
  __syncthreads();
  const XcdBarrier xb = xcd_barrier_post((unsigned*)(ws + W_BAR), (volatile LAS unsigned*)&xb_words);

  {
    PHASE_IDS
    float* scr = (float*)dyn_lds + wave * (64 * 33);
    for (int it = gw; it < I0 + I1 + I2 + I7; it += NGW) {
      int r = it;
      if (r < I0) { transpose_item<true>(p.w_in, p.g_mix, D, NPROJ, wInT, scr, r, lane); continue; } r -= I0;
      if (r < I1) { transpose_item<false>(p.w_ao, nullptr, SBW, D, wAoT, scr, r, lane); continue; } r -= I1;
      if (r < I2) { transpose_item<false>(p.w_co, nullptr, CW, D, wCoT, scr, r, lane); continue; } r -= I2;
      transpose_item<false>(p.w_pl, nullptr, PLE, D, wPlT, scr, r, lane);
    }
    for (int row0 = gw * 4; row0 < M; row0 += NGW * 4) {
      f32x4 v[4][4];
#pragma unroll
      for (int q = 0; q < 4; ++q) { const int row = row0 + q;
        const float* xr = (row < MP) ? p.x_p + (size_t)row * D : p.x_s + (size_t)(row - MP) * D;
        const f32x4* x4 = (const f32x4*)xr + lane;
#pragma unroll
        for (int j = 0; j < 4; ++j) v[q][j] = x4[64 * j]; }
#pragma unroll
      for (int q = 0; q < 4; ++q) { const int row = row0 + q; float sq = 0.f;
#pragma unroll
        for (int j = 0; j < 4; ++j) sq += (v[q][j].x * v[q][j].x + v[q][j].y * v[q][j].y) + (v[q][j].z * v[q][j].z + v[q][j].w * v[q][j].w);
        sq = wave_sum(sq);
        if (lane == 0) rs0[row] = rsqrtf(sq * (1.f / D) + EPS);
        u32x2* o8 = (u32x2*)(RA + (size_t)row * D) + lane;
#pragma unroll
        for (int j = 0; j < 4; ++j) { u32x2 o = {pk2(v[q][j].x, v[q][j].y), pk2(v[q][j].z, v[q][j].w)}; o8[64 * j] = o; } }
    }
    for (int idx0 = gtid; idx0 < M * PLE / 4; idx0 += NT * 4) {
      f32x4 v[4];
#pragma unroll
      for (int q = 0; q < 4; ++q) { const int idx = idx0 + q * NT; if (idx < M * PLE / 4) { const size_t e = (size_t)idx * 4;
          v[q] = *(const f32x4*)((e < (size_t)MP * PLE) ? p.p_p + e : p.p_s + (e - (size_t)MP * PLE)); } }
#pragma unroll
      for (int q = 0; q < 4; ++q) { const int idx = idx0 + q * NT; if (idx < M * PLE / 4) st_bf16x4(pb + (size_t)idx * 4, v[q]); }
    }
    for (int idx = gtid; idx < 3 * M; idx += NT) ss[idx] = 0.f;
  }
  if (p.ws == nullptr) grid.sync();
  xcd_barrier(xb);
  { EpiIn e{rs0, RC, p.out}; gemm_phase(RA, wInT, M, NPROJ, D, e); }
  { const int G = gridDim.x, ntl = (M / BM) * (NPROJ / BM), rem = ntl % G, c = blockIdx.x;
    const int nidle = (rem == 0) ? G : G - rem, q = (rem == 0) ? c : c - rem;
    const SchedPe sp{pb, wPlT, q, nidle, EpiPe{PE}}; gemm_stream(PLE, sp); }
  xcd_barrier(xb);
  { PHASE_IDS
    constexpr int NU = (MP / 32 / 8) * NH;
    const int upb = (NU + gridDim.x - 1) / gridDim.x;
    for (int j = 0; j < upb; ++j) { const int u = blockIdx.x * upb + j; if (u >= NU) break;
      const int bh = u >> 5, g = u & 31; attn_task(p, (bh >> 3) * (SEQ / 32) + g * 8 + wave, bh & 7, lane); }
    for (int sb = 0; sb < MS / DSEQ; ++sb) if ((sb * 8 + (sb & 7)) % gridDim.x == blockIdx.x) attn_task(p, MP / 32 + sb, wave, lane); }
  conv_items(p);
  xcd_barrier(xb);
  {
    const int nM = M / BM, nN = D / BM;
    { const SchedP3 s3{RB, RB + (size_t)M * SBW, wAoT, wCoT, RC, RA}; gemm_stream(SBW, s3); }
    { const int G = gridDim.x, rem = (nM * nN) % G, c = blockIdx.x; const int nidle = (rem == 0) ? G : G - rem, q = (rem == 0) ? c : c - rem;
      if (q >= 0) { PHASE_IDS
        float* scr = (float*)dyn_lds + wave * (64 * 33);
        for (int it = q * 8 + wave; it < I3 + I4; it += nidle * 8) {
          if (it < I3) transpose_item<false>(p.w_o, nullptr, D, D, wOT, scr, it, lane);
          else transpose_item<false>(p.w_up, p.g_ffn, D, DFF, wUpT, scr, it - I3, lane); } } }
  }
  xcd_barrier(xb);
  { EpiRes<0> e{p.x_p, p.x_s, nullptr, RB, ss, nullptr, nullptr}; gemm_phase(RA, wOT, M, D, D, e); }
  xcd_barrier(xb);
  { EpiUp e{ss, RC}; gemm_phase(RB, wUpT, M, DFF, D, e); }
  { const int G = gridDim.x, rem = ((M / BM) * (DFF / BM)) % G, c = blockIdx.x; const int nidle = (rem == 0) ? G : G - rem, q = (rem == 0) ? c : c - rem;
    if (q >= 0) { PHASE_IDS
      float* scr = (float*)dyn_lds + wave * (64 * 33);
      for (int it = q * 8 + wave; it < I5 + I6; it += nidle * 8) {
        if (it < I5) transpose_item<false>(p.w_dn, nullptr, DFF, D, wDnT, scr, it, lane);
        else transpose_item<false>(p.w_pg, p.g_ple, D, D, wPgT, scr, it - I5, lane); } } }
  xcd_barrier(xb);
  { const SchedP6 s6{RC, wDnT, (float*)(ws + W_PB), EpiRes<1>{nullptr, nullptr, RB, RA, ss + M, nullptr, nullptr}}; gemm_stream(DFF, s6); }
  xcd_barrier(xb);
  { PHASE_IDS
    const float* part = (const float*)(ws + W_PB);
    for (int r = gw; r < MS; r += NGW) { const int row = MP + r; float sq = 0.f;
#pragma unroll
      for (int j = 0; j < 4; ++j) { const int col = j * 256 + lane * 4;
        f32x4 v = ld_bf16x4(RB + (size_t)row * D + col);
#pragma unroll
        for (int kq = 0; kq < 4; ++kq) v += *(const f32x4*)(part + ((size_t)kq * MS + r) * D + col);
        st_bf16x4(RA + (size_t)row * D + col, v); sq += (v.x * v.x + v.y * v.y) + (v.z * v.z + v.w * v.w); }
      sq = wave_sum(sq);
      if (lane == 0) ss[M + row] = sq; } }
  xcd_barrier(xb);
  { const SchedP7 s7{RA, wPgT, (float*)(ws + W_PB), EpiRes<2>{nullptr, nullptr, RA, RC, ss + 2 * M, ss + M, PE}}; gemm_stream(D, s7); }
  xcd_barrier(xb);
  { PHASE_IDS
  for (int idx0 = gtid; idx0 < MP * (D / 8); idx0 += NT * 4) {
    u32x4 xv[4]; float rv[4];
#pragma unroll
    for (int q = 0; q < 4; ++q) { const int idx = idx0 + q * NT; if (idx < MP * (D / 8)) { const int row = idx >> 7, c = (idx & 127) * 8;
        xv[q] = *(const u32x4*)(RC + (size_t)row * D + c); rv[q] = ss[2 * M + row]; } }
#pragma unroll
    for (int q = 0; q < 4; ++q) { const int idx = idx0 + q * NT; if (idx < MP * (D / 8)) { const int row = idx >> 7, c = (idx & 127) * 8;
        const float r = rsqrtf(rv[q] * (1.f / D) + EPS); f32x4 a0, a1; unpack8(xv[q], a0, a1);
        const f32x4 g0 = *(const f32x4*)(p.g_final + c), g1 = *(const f32x4*)(p.g_final + c + 4);
        *(f32x4*)(y + (size_t)row * D + c) = a0 * r * g0; *(f32x4*)(y + (size_t)row * D + c + 4) = a1 * r * g1; } }
  }
  { const float* part = (const float*)(ws + W_PB);
    for (int r = NGW - 1 - gw; r < MS; r += NGW) { const int row = MP + r; const float r2 = rsqrtf(ss[M + row] * (1.f / D) + EPS);
      f32x4 x3[4]; float sq = 0.f;
#pragma unroll
      for (int j = 0; j < 4; ++j) { const int col = j * 256 + lane * 4;
        f32x4 gsum = *(const f32x4*)(part + (size_t)r * D + col);
#pragma unroll
        for (int kq = 1; kq < 4; ++kq) gsum += *(const f32x4*)(part + ((size_t)kq * MS + r) * D + col);
        const f32x4 x2 = ld_bf16x4(RA + (size_t)row * D + col), pe4 = ld_bf16x4(PE + (size_t)row * D + col);
        gsum = gsum * r2;
        const f32x4 sg = {sigmoidf_(gsum.x), sigmoidf_(gsum.y), sigmoidf_(gsum.z), sigmoidf_(gsum.w)};
        x3[j] = x2 + sg * pe4; sq += (x3[j].x * x3[j].x + x3[j].y * x3[j].y) + (x3[j].z * x3[j].z + x3[j].w * x3[j].w); }
      sq = wave_sum(sq); const float r3 = rsqrtf(sq * (1.f / D) + EPS);
#pragma unroll
      for (int j = 0; j < 4; ++j) { const int col = j * 256 + lane * 4; const f32x4 g = *(const f32x4*)(p.g_final + col);
        *(f32x4*)(y + (size_t)row * D + col) = x3[j] * r3 * g; } } }
  }
}

extern "C" void kernel_launch(void* const* d_in, const int* in_sizes, int n_in, void* d_out, int out_size, void* d_ws, size_t ws_size, hipStream_t stream) {
  static int grid_blocks = 0;
  if (grid_blocks == 0) {
    if (ws_size < W_END) { fprintf(stderr, "kernel_launch: workspace too small (%zu < %zu)\n", ws_size, (size_t)W_END); grid_blocks = -1; return; }
    int dev = 0, cus = 0, per_cu = 0;
    hipGetDevice(&dev);
    hipDeviceGetAttribute(&cus, hipDeviceAttributeMultiprocessorCount, dev);
    hipFuncSetAttribute((const void*)fwd_megakernel, hipFuncAttributeMaxDynamicSharedMemorySize, SHM_B);
    hipOccupancyMaxActiveBlocksPerMultiprocessor(&per_cu, (const void*)fwd_megakernel, 512, SHM_B);
    if (per_cu < 1) { fprintf(stderr, "kernel_launch: occupancy query says %d blocks/CU\n", per_cu); per_cu = 1; }
    grid_blocks = cus;
  }
  if (grid_blocks < 0) return;
  Params p{};
  p.x_p = (const float*)d_in[0]; p.x_s = (const float*)d_in[1]; p.p_p = (const float*)d_in[2]; p.p_s = (const float*)d_in[3];
  p.cache_k = (const float*)d_in[4]; p.cache_v = (const float*)d_in[5]; p.cache_conv = (const float*)d_in[6];
  p.g_mix = (const float*)d_in[7]; p.w_in = (const float*)d_in[8]; p.conv_w = (const float*)d_in[9]; p.w_ao = (const float*)d_in[10];
  p.w_co = (const float*)d_in[11]; p.w_o = (const float*)d_in[12]; p.g_ffn = (const float*)d_in[13]; p.w_up = (const float*)d_in[14];
  p.w_dn = (const float*)d_in[15]; p.g_ple = (const float*)d_in[16]; p.w_pg = (const float*)d_in[17]; p.w_pl = (const float*)d_in[18];
  p.g_final = (const float*)d_in[19];
  p.out = (float*)d_out; p.ws = (unsigned char*)d_ws;
  (void)hipMemsetAsync((unsigned char*)d_ws + W_BAR, 0, XCD_BAR_WORDS * 4, stream);
  void* args[] = {&p};
  hipError_t e = hipLaunchCooperativeKernel((const void*)fwd_megakernel, dim3(grid_blocks), dim3(512), args, SHM_B, stream);
  if (e != hipSuccess) fprintf(stderr, "cooperative launch failed: %s (grid %d)\n", hipGetErrorString(e), grid_blocks);
}
```

```cpp
#include <hip/hip_runtime.h>
#include <hip/hip_cooperative_groups.h>
#include <cstdio>
#include <cstdint>
namespace cg = cooperative_groups;

#define DI __device__ __forceinline__
typedef unsigned short bf16_t;
typedef short bf16x8 __attribute__((ext_vector_type(8)));
typedef float f32x4 __attribute__((ext_vector_type(4)));
typedef float f32x2 __attribute__((ext_vector_type(2)));
typedef float f32x16 __attribute__((ext_vector_type(16)));
typedef unsigned u32x4 __attribute__((ext_vector_type(4)));
typedef unsigned u32x2 __attribute__((ext_vector_type(2)));
typedef __bf16 bf16v2 __attribute__((ext_vector_type(2)));

constexpr int D = 1024, NPROJ = 5120, MP = 32768, MS = 1024, M = MP + MS, SEQ = 8192, DSEQ = 32, PAST = 2048;
constexpr int NH = 8, HD = 64, SBW = 512, CW = 512, PLE = 256, DFF = 4096, P4W = 4096;
constexpr float EPS = 1e-6f;
constexpr size_t O_Y = 0, O_KP = (size_t)M * D, O_VP = O_KP + (size_t)MP * SBW, O_CP = O_VP + (size_t)MP * SBW,
                 O_KS = O_CP + 4 * 2 * CW, O_VS = O_KS + (size_t)MS * SBW, O_CS = O_VS + (size_t)MS * SBW;
constexpr size_t W_IN = 0, W_AO = W_IN + (size_t)NPROJ * D * 2, W_CO = W_AO + (size_t)D * SBW * 2, W_O = W_CO + (size_t)D * CW * 2,
                 W_UP = W_O + (size_t)D * D * 2, W_DN = W_UP + (size_t)DFF * D * 2, W_PG = W_DN + (size_t)D * DFF * 2,
                 W_PL = W_PG + (size_t)D * D * 2, W_RS0 = W_PL + (size_t)D * PLE * 2, W_SS = W_RS0 + (size_t)M * 4,
                 W_PB = W_SS + (size_t)3 * M * 4, W_RA = W_PB + (size_t)M * PLE * 2, W_RB = W_RA + (size_t)M * D * 2,
                 W_RC = W_RB + (size_t)M * D * 2, W_BAR = W_RC + (size_t)M * P4W * 2, W_PE = W_BAR + 16384, W_END = W_PE + (size_t)M * D * 2;

struct Params {
  const float *x_p, *x_s, *p_p, *p_s, *cache_k, *cache_v, *cache_conv;
  const float *g_mix, *w_in, *conv_w, *w_ao, *w_co, *w_o, *g_ffn, *w_up, *w_dn, *g_ple, *w_pg, *w_pl, *g_final;
  float* out; unsigned char* ws;
};

extern __shared__ __attribute__((aligned(16))) unsigned char dyn_lds[];

DI unsigned pk2(float lo, float hi) { f32x2 f = {lo, hi}; bf16v2 b = __builtin_convertvector(f, bf16v2); return __builtin_bit_cast(unsigned, b); }
DI float bf2f(unsigned h16) { return __uint_as_float(h16 << 16); }
DI float bflo(unsigned u) { return __uint_as_float(u << 16); }
DI float bfhi(unsigned u) { return __uint_as_float(u & 0xffff0000u); }
DI bf16x8 cvt8(f32x4 a, f32x4 b) { u32x4 u = {pk2(a.x, a.y), pk2(a.z, a.w), pk2(b.x, b.y), pk2(b.z, b.w)}; return __builtin_bit_cast(bf16x8, u); }
DI float sigmoidf_(float v) { return __builtin_amdgcn_rcpf(1.f + __expf(-v)); }
DI float wave_sum(float v) {
#pragma unroll
  for (int o = 1; o < 64; o <<= 1) v += __shfl_xor(v, o);
  return v;
}

constexpr int BM = 256, BK = 64, HALF = 128, NXCD = 8, WGM = 8, HT = HALF * BK, SHM_B = 8 * HT * 2;
DI int lds_byte(int r, int c) { int st = (r >> 4) * 2 + (c >> 5), rr = r & 15, cc = c & 31, ob = rr * 64 + cc * 2; return st * 1024 + (ob ^ (((ob >> 9) & 1) << 5)); }
DI void stage_rc(int b, int& R, int& C) { int st = b / 1024, sb = b % 1024, swz = sb ^ (((sb >> 9) & 1) << 5); R = (st >> 1) * 16 + swz / 64; C = (st & 1) * 32 + (swz % 64) / 2; }

DI bool tile_order(int i, int G, int c, int nM, int nN, int& pm, int& pn) {
  const int nwg = nM * nN; const long L = (long)i * G + c; if (L >= nwg) return false;
  int wgid = (int)L; { const int q = nwg / NXCD, r = nwg % NXCD, xcd = wgid % NXCD, off = wgid / NXCD; wgid = (xcd < r ? xcd * (q + 1) : r * (q + 1) + (xcd - r) * q) + off; }
  const int nig = WGM * nN, gid = wgid / nig, fm = gid * WGM, gsz = (nM - fm) < WGM ? (nM - fm) : WGM;
  pm = fm + ((wgid % nig) % gsz); pn = (wgid % nig) / gsz; return true;
}

typedef f32x4 acc_t[2][2][4][2];
struct Item { const char* cA; const char* cB; int brow, bcol, nt, tag; };
template <class F>
DI void epi_call(acc_t& acc, const int brow, const int bcol, const F& f) {
  int tid2 = threadIdx.x, brow2 = brow, bcol2 = bcol;
  asm volatile("" : "+v"(tid2), "+s"(brow2), "+s"(bcol2));
  const int wid2 = tid2 >> 6, lane2 = tid2 & 63;
  f(acc, brow2, bcol2, wid2 >> 2, wid2 & 3, lane2 & 15, lane2 >> 4);
}
template <class Sched>
DI void gemm_stream(const int ld, const Sched& sch) {
  char* lds = (char*)dyn_lds;
  int tid = threadIdx.x; asm volatile("" : "+v"(tid));
  const int wid = tid >> 6, lane = tid & 63, wr = wid >> 2, wc = wid & 3, fr = lane & 15, fq = lane >> 4;
  const int wbase = __builtin_amdgcn_readfirstlane((tid & ~63) * 16);
  unsigned voff0, voff1;
  { int r_, c_; stage_rc(tid * 16, r_, c_); voff0 = (unsigned)(r_ * ld + c_) * 2u; stage_rc(tid * 16 + 8192, r_, c_); voff1 = (unsigned)(r_ * ld + c_) * 2u; }
  const size_t kstep = (size_t)BK * 2, hstep = (size_t)HALF * ld * 2;
#define SA(b, h) (((b) * 2 + (h)) * (HT * 2))
#define SB(b, h) ((4 + (b) * 2 + (h)) * (HT * 2))
#define STAGE(bufoff, gbase) do { const char* _ub = (gbase); \
    __builtin_amdgcn_global_load_lds((const unsigned*)(_ub + voff0), (unsigned*)(lds + (bufoff) + wbase), 16, 0, 0); \
    __builtin_amdgcn_global_load_lds((const unsigned*)(_ub + voff1), (unsigned*)(lds + (bufoff) + wbase + 8192), 16, 0, 0); } while (0)
#define LDA(dst, b, h) for (int m = 0; m < 4; ++m) for (int k = 0; k < 2; ++k) \
    dst[m][k] = *reinterpret_cast<const bf16x8*>(lds + SA(b, h) + lds_byte(wr * 64 + m * 16 + fr, k * 32 + fq * 8))
#define LDB(dst, b, h) for (int n = 0; n < 2; ++n) for (int k = 0; k < 2; ++k) \
    dst[n][k] = *reinterpret_cast<const bf16x8*>(lds + SB(b, h) + lds_byte(wc * 32 + n * 16 + fr, k * 32 + fq * 8))
#define MMA(ai, bj, At_, Bt_) do { __builtin_amdgcn_s_setprio(1); \
    for (int m = 0; m < 4; ++m) for (int n = 0; n < 2; ++n) for (int k = 0; k < 2; ++k) \
      acc[ai][bj][m][n] = __builtin_amdgcn_mfma_f32_16x16x32_bf16(Bt_[n][k], At_[m][k], acc[ai][bj][m][n], 0, 0, 0); \
    __builtin_amdgcn_s_setprio(0); } while (0)
#define WAIT_V(n) asm volatile("s_waitcnt vmcnt(" #n ")" ::: "memory")
#define WAIT_L(n) asm volatile("s_waitcnt lgkmcnt(" #n ")" ::: "memory")
#define BAR __builtin_amdgcn_s_barrier()
#define SCHED __builtin_amdgcn_sched_barrier(0)
  Item cur, nxt; int ui = 0;
  if (!sch.next(0, cur)) return;
  acc_t acc = {};
  bf16x8 At[4][2], B0[2][2], B1[2][2];
  const char* cA = cur.cA; const char* cB = cur.cB;
  STAGE(SB(0, 0), cB); STAGE(SA(0, 0), cA); STAGE(SB(0, 1), cB + hstep); STAGE(SA(0, 1), cA + hstep);
  if (wr == 1) BAR;
  WAIT_V(4); BAR;
  STAGE(SB(1, 0), cB + kstep); STAGE(SA(1, 0), cA + kstep); STAGE(SB(1, 1), cB + hstep + kstep);
  WAIT_V(6); BAR;
  for (;;) {
    const bool has_next = sch.next(ui + 1, nxt);
    const char* nA = has_next ? nxt.cA : cA; const char* nB = has_next ? nxt.cB : cB;
    const int nt = cur.nt;
    for (int t = 0; t < nt; t += 2) {
      const bool last = (t == nt - 2);
      const char* a1 = cA + (size_t)(t + 1) * kstep;
      const char* a2 = last ? nA : cA + (size_t)(t + 2) * kstep; const char* b2 = last ? nB : cB + (size_t)(t + 2) * kstep;
      const char* a3 = a2 + kstep; const char* b3 = b2 + kstep;
      LDB(B0, 0, 0); SCHED; LDA(At, 0, 0); STAGE(SA(1, 1), a1 + hstep);
      WAIT_L(8); BAR; WAIT_L(0); MMA(0, 0, At, B0); BAR; SCHED;
      LDB(B1, 0, 1); STAGE(SB(0, 0), b2);
      BAR; WAIT_L(0); MMA(0, 1, At, B1); BAR;
      LDA(At, 0, 1); STAGE(SA(0, 0), a2);
      BAR; WAIT_L(0); MMA(1, 0, At, B0); BAR; SCHED;
      STAGE(SB(0, 1), b2 + hstep);
      WAIT_V(6); BAR; MMA(1, 1, At, B1); BAR;
      LDB(B0, 1, 0); SCHED; LDA(At, 1, 0); STAGE(SA(0, 1), a2 + hstep);
      WAIT_L(8); BAR; WAIT_L(0); MMA(0, 0, At, B0); BAR; SCHED;
      LDB(B1, 1, 1); STAGE(SB(1, 0), b3);
      BAR; WAIT_L(0); MMA(0, 1, At, B1); BAR;
      LDA(At, 1, 1); STAGE(SA(1, 0), a3);
      BAR; WAIT_L(0); MMA(1, 0, At, B0); BAR; SCHED;
      STAGE(SB(1, 1), b3 + hstep);
      WAIT_V(6); BAR; MMA(1, 1, At, B1); BAR;
    }
    const bool keep = sch.epi(acc, cur);
    if (!has_next) break;
    if (!keep) {
#pragma unroll
      for (int a_ = 0; a_ < 2; ++a_)
#pragma unroll
        for (int b_ = 0; b_ < 2; ++b_)
#pragma unroll
          for (int m = 0; m < 4; ++m)
#pragma unroll
            for (int n = 0; n < 2; ++n) acc[a_][b_][m][n] = (f32x4){0.f, 0.f, 0.f, 0.f}; }
    cur = nxt; cA = nA; cB = nB; ++ui;
  }
  WAIT_V(0);
  if (wr == 0) BAR;
  BAR;
}
template <class Epi>
struct SchedStd {
  const bf16_t* A; const bf16_t* Bt; int nM, nN, K; Epi e;
  DI bool next(int i, Item& it) const { int pm, pn; if (!tile_order(i, gridDim.x, blockIdx.x, nM, nN, pm, pn)) return false;
    it.brow = pm * BM; it.bcol = pn * BM; it.cA = (const char*)(A + (size_t)it.brow * K); it.cB = (const char*)(Bt + (size_t)it.bcol * K); it.nt = K / BK; it.tag = 0; return true; }
  DI bool epi(acc_t& acc, const Item& it) const { epi_call(acc, it.brow, it.bcol, e); return false; }
};
template <class Epi>
DI void gemm_phase(const bf16_t* A, const bf16_t* Bt, int Mrows, int N, int K, const Epi& epi) {
  const SchedStd<Epi> sch{A, Bt, Mrows / BM, N / BM, K, epi};
  gemm_stream(K, sch);
}

DI void st_bf16x4(bf16_t* p, f32x4 v) { u32x2 u = {pk2(v.x, v.y), pk2(v.z, v.w)}; *(u32x2*)p = u; }
DI f32x4 ld_bf16x4(const bf16_t* p) { u32x2 u = *(const u32x2*)p; f32x4 v = {bflo(u.x), bfhi(u.x), bflo(u.y), bfhi(u.y)}; return v; }

#define EPI_ROWS for (int ai = 0; ai < 2; ++ai) for (int m = 0; m < 4; ++m)
#define EPI_COLS for (int bj = 0; bj < 2; ++bj) for (int n = 0; n < 2; ++n)
#define EPI_BJ for (int bj = 0; bj < 2; ++bj)
#define EPI_ROW (brow + ai * HALF + wr * 64 + m * 16 + fr)
#define EPI_COL (bcol + bj * HALF + wc * 32 + n * 16 + fq * 4)
#define EPI_COL8 (bcol + bj * HALF + wc * 32 + fq * 8)
DI void st_bf16x8(bf16_t* p, f32x4 a, f32x4 b) { u32x4 u = {pk2(a.x, a.y), pk2(a.z, a.w), pk2(b.x, b.y), pk2(b.z, b.w)}; *(u32x4*)p = u; }
DI void unpack8(const u32x4 u, f32x4& a, f32x4& b) { a = (f32x4){bflo(u.x), bfhi(u.x), bflo(u.y), bfhi(u.y)}; b = (f32x4){bflo(u.z), bfhi(u.z), bflo(u.w), bfhi(u.w)}; }

struct EpiIn {
  const float* rs0; bf16_t* proj4; float* out;
  DI void operator()(const acc_t& acc, int brow, int bcol, int wr, int wc, int fr, int fq) const {
    float rr[2][4];
#pragma unroll
    EPI_ROWS rr[ai][m] = rs0[EPI_ROW];
    if (bcol >= 512 && bcol < 1536) {
#pragma unroll
      EPI_ROWS { const int row = EPI_ROW; const float r = rr[ai][m];
#pragma unroll
        EPI_COLS { const int col = EPI_COL; f32x4 v = acc[ai][bj][m][n] * r;
          const int isv = bcol >= 1024; const int c = col - (isv ? 1024 : 512);
          float* dst = (row < MP) ? out + (isv ? O_VP : O_KP) + (size_t)row * SBW + c : out + (isv ? O_VS : O_KS) + (size_t)(row - MP) * SBW + c;
          *(f32x4*)dst = v; } }
    } else if (bcol < 2048) {
      const float sc = (bcol < 512) ? 0.18033688011112042f   : 1.f; const int sh = (bcol < 512) ? 0 : 1024;
#pragma unroll
      EPI_ROWS { const int row = EPI_ROW; const float r = rr[ai][m] * sc;
#pragma unroll
        EPI_BJ { st_bf16x8(proj4 + (size_t)row * P4W + (EPI_COL8 - sh), acc[ai][bj][m][0] * r, acc[ai][bj][m][1] * r); } }
    } else {
      const bool gate = bcol >= 3072; const int t = ((bcol - (gate ? 3072 : 2048)) >> 8) * 128;
#pragma unroll
      EPI_ROWS { const int row = EPI_ROW; const float r = rr[ai][m]; const int ch = t + wc * 32 + fq * 8;
        const f32x4 a0 = acc[ai][0][m][0] * r, a1 = acc[ai][0][m][1] * r, b0 = acc[ai][1][m][0] * r, b1 = acc[ai][1][m][1] * r;
        if (!gate) { st_bf16x8(proj4 + (size_t)row * P4W + 1024 + ch, a0 * b0, a1 * b1); }
        else { f32x4 rho0, rho1, sg0, sg1;
#pragma unroll
          for (int e = 0; e < 4; ++e) {
            { const float ea = __expf(-a0[e]), eb = __expf(-fmaxf(b0[e], -80.f)); sg0[e] = __builtin_amdgcn_rcpf(1.f + eb); rho0[e] = (1.f + eb) * __builtin_amdgcn_rcpf(1.f + ea); }
            { const float ea = __expf(-a1[e]), eb = __expf(-fmaxf(b1[e], -80.f)); sg1[e] = __builtin_amdgcn_rcpf(1.f + eb); rho1[e] = (1.f + eb) * __builtin_amdgcn_rcpf(1.f + ea); } }
          st_bf16x8(proj4 + (size_t)row * P4W + 2048 + ch, rho0, rho1); st_bf16x8(proj4 + (size_t)row * P4W + 3072 + ch, sg0, sg1); } }
    }
  }
};
template <bool FINAL>
struct EpiGate {
  const bf16_t* proj4; int off; bf16_t* merged;
  DI void operator()(acc_t& acc, int brow, int bcol, int wr, int wc, int fr, int fq) const {
    u32x4 g[2][4][2];
#pragma unroll
    EPI_ROWS { const int row = EPI_ROW;
#pragma unroll
      EPI_BJ g[ai][m][bj] = *(const u32x4*)(proj4 + (size_t)row * P4W + off + EPI_COL8); }
#pragma unroll
    EPI_ROWS { const int row = EPI_ROW;
#pragma unroll
      EPI_BJ { f32x4 g0, g1; unpack8(g[ai][m][bj], g0, g1);
        if (FINAL) st_bf16x8(merged + (size_t)row * D + EPI_COL8, acc[ai][bj][m][0] * g0, acc[ai][bj][m][1] * g1);
        else { acc[ai][bj][m][0] *= g0; acc[ai][bj][m][1] *= g1; } } }
  }
};
template <int MODE>
struct EpiRes {
  const float *x_p, *x_s; const bf16_t* resb; bf16_t* outb; float* ss; const float* ssprev; const bf16_t* pe;
  DI void operator()(const acc_t& acc, int brow, int bcol, int wr, int wc, int fr, int fq) const {
#pragma unroll
    for (int ai = 0; ai < 2; ++ai) {
      f32x4 resf[4][2][2]; u32x4 resh[4][2], peh[4][2]; float rr[4];
#pragma unroll
      for (int m = 0; m < 4; ++m) { const int row = EPI_ROW;
        if (MODE == 2) rr[m] = ssprev[row];
#pragma unroll
        EPI_BJ { const int col = EPI_COL8;
          if (MODE == 0) { const float* xp = (row < MP) ? x_p + (size_t)row * D + col : x_s + (size_t)(row - MP) * D + col;
            resf[m][bj][0] = *(const f32x4*)xp; resf[m][bj][1] = *(const f32x4*)(xp + 4); }
          else resh[m][bj] = *(const u32x4*)(resb + (size_t)row * D + col);
          if (MODE == 2) peh[m][bj] = *(const u32x4*)(pe + (size_t)row * D + col); } }
#pragma unroll
      for (int m = 0; m < 4; ++m) { const int row = EPI_ROW; float part = 0.f; float r = 0.f;
        if (MODE == 2) r = rsqrtf(rr[m] * (1.f / D) + EPS);
#pragma unroll
        EPI_BJ { const int col = EPI_COL8; f32x4 a0 = acc[ai][bj][m][0], a1 = acc[ai][bj][m][1]; f32x4 r0, r1;
          if (MODE == 0) { r0 = resf[m][bj][0]; r1 = resf[m][bj][1]; } else unpack8(resh[m][bj], r0, r1);
          if (MODE == 2) { f32x4 e0, e1; unpack8(peh[m][bj], e0, e1); a0 = a0 * r; a1 = a1 * r;
            const f32x4 s0 = {sigmoidf_(a0.x), sigmoidf_(a0.y), sigmoidf_(a0.z), sigmoidf_(a0.w)}, s1 = {sigmoidf_(a1.x), sigmoidf_(a1.y), sigmoidf_(a1.z), sigmoidf_(a1.w)};
            a0 = s0 * e0; a1 = s1 * e1; }
          const f32x4 o0 = r0 + a0, o1 = r1 + a1;
          st_bf16x8(outb + (size_t)row * D + col, o0, o1);
          part += (o0.x * o0.x + o0.y * o0.y + o0.z * o0.z + o0.w * o0.w) + (o1.x * o1.x + o1.y * o1.y + o1.z * o1.z + o1.w * o1.w); }
        part += __shfl_xor(part, 16); part += __shfl_xor(part, 32);
        if (fq == 0) atomicAdd(ss + row, part); }
    }
  }
};
struct EpiUp {
  const float* ss1; bf16_t* u;
  DI void operator()(const acc_t& acc, int brow, int bcol, int wr, int wc, int fr, int fq) const {
    float rr[2][4];
#pragma unroll
    EPI_ROWS rr[ai][m] = ss1[EPI_ROW];
#pragma unroll
    EPI_ROWS { const int row = EPI_ROW; const float r = rsqrtf(rr[ai][m] * (1.f / D) + EPS);
#pragma unroll
      EPI_BJ { f32x4 a0 = acc[ai][bj][m][0] * r, a1 = acc[ai][bj][m][1] * r;
        const f32x4 z0 = {fmaxf(a0.x, 0.f), fmaxf(a0.y, 0.f), fmaxf(a0.z, 0.f), fmaxf(a0.w, 0.f)}, z1 = {fmaxf(a1.x, 0.f), fmaxf(a1.y, 0.f), fmaxf(a1.z, 0.f), fmaxf(a1.w, 0.f)};
        st_bf16x8(u + (size_t)row * DFF + EPI_COL8, z0 * z0, z1 * z1); } }
  }
};
struct EpiPartial {
  float* part;
  DI void operator()(const acc_t& acc, int brow, int bcol, int wr, int wc, int fr, int fq) const {
#pragma unroll
    EPI_ROWS { const int row = EPI_ROW;
#pragma unroll
      EPI_BJ { float* d = part + (size_t)row * D + EPI_COL8; *(f32x4*)d = acc[ai][bj][m][0]; *(f32x4*)(d + 4) = acc[ai][bj][m][1]; } }
  }
};
struct EpiPe {
  bf16_t* pe;
  DI void operator()(const acc_t& acc, int brow, int bcol, int wr, int wc, int fr, int fq) const {
#pragma unroll
    EPI_ROWS { const int row = EPI_ROW;
#pragma unroll
      EPI_BJ { st_bf16x8(pe + (size_t)row * D + EPI_COL8, acc[ai][bj][m][0], acc[ai][bj][m][1]); } }
  }
};

DI int win_perm(int n) {
  if (n < 2048) return n;
  if (n < 3072) { const int r = n - 2048, c = r & 511; return 2048 + 256 * (c >> 7) + ((r >> 9) ? 128 : 0) + (c & 127); }
  const int r = n - 3072, c = r & 1023; return 3072 + 256 * (c >> 7) + ((r >> 10) ? 128 : 0) + (c & 127);
}
template <bool PERM>
DI void transpose_item(const float* __restrict__ W, const float* __restrict__ g, int K, int N, bf16_t* __restrict__ WT, float* scr, int item, int lane) {
  const int nblk = N / 32, kb = item / nblk, nb = item % nblk, k0 = 64 * kb, n0 = 32 * nb;
  const int n0d = PERM ? win_perm(n0) : n0;
  const bool p32 = !(PERM && n0 >= 512 && n0 < 1536);
  float wv[32];
#pragma unroll
  for (int i = 0; i < 32; ++i) { const int kk = 2 * i + (lane >> 5); wv[i] = W[(size_t)(k0 + kk) * N + n0 + (lane & 31)]; }
  if (g) {
#pragma unroll
    for (int i = 0; i < 32; ++i) wv[i] *= g[k0 + 2 * i + (lane >> 5)]; }
#pragma unroll
  for (int i = 0; i < 32; ++i) scr[(2 * i + (lane >> 5)) * 33 + (lane & 31)] = wv[i];
  asm volatile("s_waitcnt lgkmcnt(0)" ::: "memory");
  const int c = lane & 7;
#pragma unroll
  for (int j = 0; j < 4; ++j) { const int n = (lane >> 3) + 8 * j; const int ns = p32 ? (8 * ((n & 15) >> 2) + 4 * (n >> 4) + (n & 3)) : n; const float* s = scr + (8 * c) * 33 + ns;
    u32x4 o = {pk2(s[0 * 33], s[1 * 33]), pk2(s[2 * 33], s[3 * 33]), pk2(s[4 * 33], s[5 * 33]), pk2(s[6 * 33], s[7 * 33])};
    *(u32x4*)(WT + (size_t)(n0d + n) * K + k0 + 8 * c) = o; }
  asm volatile("s_waitcnt lgkmcnt(0)" ::: "memory");
}

#define MFMA32(a, b, c) __builtin_amdgcn_mfma_f32_32x32x16_bf16((a), (b), (c), 0, 0, 0)
DI void attn_load(const float* __restrict__ Kp, const float* __restrict__ Vp, int i, int half, f32x4 (&kr)[8], float (&vr)[32]) {
#pragma unroll
  for (int s = 0; s < 4; ++s) { const f32x4* kp = (const f32x4*)(Kp + (size_t)i * SBW + 16 * s + 8 * half); kr[2 * s] = kp[0]; kr[2 * s + 1] = kp[1]; }
#pragma unroll
  for (int s = 0; s < 2; ++s)
#pragma unroll
    for (int jj = 0; jj < 8; ++jj) { const int key = 16 * s + 8 * (jj >> 2) + 4 * half + (jj & 3);
      vr[(2 * s) * 8 + jj] = Vp[(size_t)key * SBW + i]; vr[(2 * s + 1) * 8 + jj] = Vp[(size_t)key * SBW + 32 + i]; }
}
template <bool DIAG>
DI void attn_weights(const f32x16& sacc, int i, int half, float& C, float (&a)[16]) {
  float be[16], om[16];
#pragma unroll
  for (int r = 0; r < 16; ++r) { const float z = sacc[r];
    const float e = __builtin_amdgcn_exp2f(-fabsf(z)), rc = __builtin_amdgcn_rcpf(1.f + e), er = e * rc;
    float b = (z >= 0.f) ? rc : er, o = (z >= 0.f) ? er : rc;
    if (DIAG) { const int key = (r & 3) + 8 * (r >> 2) + 4 * half; const bool valid = key < i; b = valid ? b : 0.f; o = valid ? o : 1.f; }
    be[r] = b; om[r] = o; }
  float G[4], Pn[4];
#pragma unroll
  for (int g = 0; g < 4; ++g) { G[g] = (om[4 * g] * om[4 * g + 1]) * (om[4 * g + 2] * om[4 * g + 3]); Pn[g] = __shfl_xor(G[g], 32); }
  float run = C;
#pragma unroll
  for (int g = 3; g >= 0; --g) { float t = half ? run : run * Pn[g];
#pragma unroll
    for (int u = 3; u >= 0; --u) { a[4 * g + u] = be[4 * g + u] * t; t *= om[4 * g + u]; }
    run *= G[g] * Pn[g]; }
  C = run;
}
DI void attn_task(const Params& p, const int qb, const int h, int lane) {
  const bf16_t* proj4 = (const bf16_t*)(p.ws + W_RC);
  bf16_t* attn = (bf16_t*)(p.ws + W_RB);
  const int i = lane & 31, half = lane >> 5;
  int qtok0, nblk; const float *k0p, *v0p, *k1p, *v1p;
  if (qb < MP / 32) { const int b = qb >> 8, t0 = (qb & 255) * 32; qtok0 = b * SEQ + t0; nblk = (t0 >> 5) + 1;
    k0p = p.out + O_KP + (size_t)qtok0 * SBW; v0p = p.out + O_VP + (size_t)qtok0 * SBW; k1p = k0p; v1p = v0p; }
  else { const int b = qb - MP / 32; qtok0 = MP + b * DSEQ; nblk = 1 + PAST / 32;
    k0p = p.out + O_KS + (size_t)(b * DSEQ) * SBW; v0p = p.out + O_VS + (size_t)(b * DSEQ) * SBW;
    k1p = p.cache_k + (size_t)(b * PAST + PAST) * SBW; v1p = p.cache_v + (size_t)(b * PAST + PAST) * SBW; }
  k0p += h * HD; v0p += h * HD; k1p += h * HD; v1p += h * HD;
  bf16x8 qf[4];
  { const bf16_t* qp = proj4 + (size_t)(qtok0 + i) * P4W + h * HD + 8 * half;
#pragma unroll
    for (int s = 0; s < 4; ++s) qf[s] = *(const bf16x8*)(qp + 16 * s); }
  f32x16 o0 = {}, o1 = {};
  float C = 1.f;
  f32x4 kr[8]; float vr[32];
  bf16x8 kf[4], vf[4];
#define ATTN_CVT() do { _Pragma("unroll") for (int s = 0; s < 4; ++s) kf[s] = cvt8(kr[2 * s], kr[2 * s + 1]); \
    _Pragma("unroll") for (int q = 0; q < 4; ++q) { u32x4 v = {pk2(vr[8 * q], vr[8 * q + 1]), pk2(vr[8 * q + 2], vr[8 * q + 3]), pk2(vr[8 * q + 4], vr[8 * q + 5]), pk2(vr[8 * q + 6], vr[8 * q + 7])}; \
      vf[q] = __builtin_bit_cast(bf16x8, v); } } while (0)
  attn_load(k0p, v0p, i, half, kr, vr);
  ATTN_CVT();
  for (int it = 0; it < nblk; ++it) {
    { const int itn = (it + 1 < nblk) ? it + 1 : it;
      attn_load(k1p - (size_t)itn * 32 * SBW, v1p - (size_t)itn * 32 * SBW, i, half, kr, vr); }
    __builtin_amdgcn_sched_barrier(0);
    f32x16 sacc = {};
#pragma unroll
    for (int s = 0; s < 4; ++s) sacc = MFMA32(kf[s], qf[s], sacc);
    float a[16];
    if (it == 0) attn_weights<true>(sacc, i, half, C, a); else attn_weights<false>(sacc, i, half, C, a);
#pragma unroll
    for (int s = 0; s < 2; ++s) {
      u32x4 pu = {pk2(a[8 * s], a[8 * s + 1]), pk2(a[8 * s + 2], a[8 * s + 3]), pk2(a[8 * s + 4], a[8 * s + 5]), pk2(a[8 * s + 6], a[8 * s + 7])};
      const bf16x8 pf = __builtin_bit_cast(bf16x8, pu);
      o0 = MFMA32(vf[2 * s], pf, o0);
      o1 = MFMA32(vf[2 * s + 1], pf, o1); }
    if (__all(C == 0.f)) break;
    __builtin_amdgcn_sched_barrier(0);
    ATTN_CVT();
  }
  bf16_t* op = attn + (size_t)(qtok0 + i) * SBW + h * HD + 4 * half;
#pragma unroll
  for (int g = 0; g < 4; ++g) {
    f32x4 a0 = {o0[4 * g], o0[4 * g + 1], o0[4 * g + 2], o0[4 * g + 3]}; st_bf16x4(op + 8 * g, a0);
    f32x4 a1 = {o1[4 * g], o1[4 * g + 1], o1[4 * g + 2], o1[4 * g + 3]}; st_bf16x4(op + 32 + 8 * g, a1); }
}

DI void conv_items(const Params& p) {
  const bf16_t* proj4 = (const bf16_t*)(p.ws + W_RC);
  bf16_t* convg = (bf16_t*)(p.ws + W_RB) + (size_t)M * SBW;
  const int total = (M / 8) * (CW / 8);
  int rank = blockIdx.x, nact = gridDim.x;
  if (gridDim.x == 256) {
    const int c = blockIdx.x; if ((c & 7) == ((c >> 3) & 7)) return;
    rank = c - (8 * (c >> 6) + ((c & 63) + 8) / 9); nact = 256 - 32; }
  for (int idx = rank * blockDim.x + threadIdx.x; idx < total; idx += nact * blockDim.x) {
    const int tok0 = (idx >> 6) * 8, c0 = (idx & 63) * 8;
    int b, t0, T; const float* buf; float* nb;
    if (tok0 < MP) { b = tok0 >> 13; t0 = tok0 & (SEQ - 1); T = SEQ; buf = nullptr; nb = p.out + O_CP + (size_t)b * 2 * CW; }
    else { const int s = tok0 - MP; b = s >> 5; t0 = s & (DSEQ - 1); T = DSEQ; buf = p.cache_conv + (size_t)b * 2 * CW; nb = p.out + O_CS + (size_t)b * 2 * CW; }
    const bf16_t* row = proj4 + (size_t)tok0 * P4W + c0;
    u32x4 ur[10], cr[8];
#pragma unroll
    for (int j = 0; j < 8; ++j) { ur[j + 2] = *(const u32x4*)(row + (size_t)j * P4W + 1024); cr[j] = *(const u32x4*)(row + (size_t)j * P4W + 512); }
    float w0[8], w1[8], w2[8];
#pragma unroll
    for (int e = 0; e < 8; ++e) { w0[e] = p.conv_w[c0 + e]; w1[e] = p.conv_w[CW + c0 + e]; w2[e] = p.conv_w[2 * CW + c0 + e]; }
    float um2[8], um1[8];
    if (t0 > 0) { const u32x4 x2 = *(const u32x4*)(row - 2 * (size_t)P4W + 1024), x1 = *(const u32x4*)(row - (size_t)P4W + 1024);
#pragma unroll
      for (int e = 0; e < 4; ++e) { um2[2 * e] = bflo(x2[e]); um2[2 * e + 1] = bfhi(x2[e]); um1[2 * e] = bflo(x1[e]); um1[2 * e + 1] = bfhi(x1[e]); } }
    else {
#pragma unroll
      for (int e = 0; e < 8; ++e) { um2[e] = buf ? buf[c0 + e] : 0.f; um1[e] = buf ? buf[CW + c0 + e] : 0.f; } }
#pragma unroll
    for (int j = 0; j < 8; ++j) {
      float u0[8], cbv[8], o[8];
#pragma unroll
      for (int e = 0; e < 4; ++e) { u0[2 * e] = bflo(ur[j + 2][e]); u0[2 * e + 1] = bfhi(ur[j + 2][e]); cbv[2 * e] = bflo(cr[j][e]); cbv[2 * e + 1] = bfhi(cr[j][e]); }
#pragma unroll
      for (int e = 0; e < 8; ++e) o[e] = cbv[e] * (w0[e] * um2[e] + w1[e] * um1[e] + w2[e] * u0[e]);
      u32x4 ov = {pk2(o[0], o[1]), pk2(o[2], o[3]), pk2(o[4], o[5]), pk2(o[6], o[7])};
      *(u32x4*)(convg + (size_t)(tok0 + j) * CW + c0) = ov;
      if (t0 + j >= T - 2) { float* d = nb + (size_t)(t0 + j - (T - 2)) * CW + c0;
#pragma unroll
        for (int e = 0; e < 8; ++e) d[e] = u0[e]; }
#pragma unroll
      for (int e = 0; e < 8; ++e) { um2[e] = um1[e]; um1[e] = u0[e]; }
    }
  }
}

#define XB_TMO      128
#define XB_XCNT(j)  (256  + 64 * (j))
#define XB_XSUB(j)  (1280 + 64 * (j))
#define XB_XGEN(j)  (2304 + 64 * (j))
#define XB_TOP      3328
#define XB_TOPGEN   3392
#define XCD_BAR_WORDS 3456
#define XB_SPIN_CAP (1u << 18)
#define LAS __attribute__((address_space(3)))
DI unsigned xb_ld(unsigned* p) { return __hip_atomic_load(p, __ATOMIC_RELAXED, __HIP_MEMORY_SCOPE_AGENT); }
DI unsigned xb_add(unsigned* p, unsigned v) { return __hip_atomic_fetch_add(p, v, __ATOMIC_RELAXED, __HIP_MEMORY_SCOPE_AGENT); }
DI unsigned xb_xcc_id() { return (unsigned)__builtin_amdgcn_s_getreg((3 << 11) | 20) & 0xFu; }
#define XB_SPIN(cond, bar) do { unsigned _sp = 0; while (cond) { __builtin_amdgcn_s_sleep(1); \
    if ((++_sp & 255u) == 0u) { if (xb_ld(&(bar)[XB_TMO])) break; if (_sp > XB_SPIN_CAP) { atomicAdd(&(bar)[XB_TMO], 1u); break; } } } } while (0)
struct XcdBarrier { unsigned* bar; unsigned x; volatile LAS unsigned* st; };
DI XcdBarrier xcd_barrier_post(unsigned* bar, volatile LAS unsigned* st) {
  XcdBarrier b; b.bar = bar; b.x = xb_xcc_id(); b.st = st;
  if (threadIdx.x == 0) (void)xb_add(&bar[XB_XCNT(b.x)], 1u);
  return b;
}
DI void xcd_barrier_complete(unsigned* bar, unsigned x, unsigned& nloc, unsigned& nx) {
  const unsigned G = gridDim.x * gridDim.y * gridDim.z;
  unsigned sum, cnt, mine, sp = 0u;
  for (;;) {
    sum = 0u; cnt = 0u; mine = 0u;
#pragma unroll
    for (unsigned j = 0; j < 16; ++j) { const unsigned c = xb_ld(&bar[XB_XCNT(j)]); sum += c; cnt += (c > 0u) ? 1u : 0u; mine = (j == x) ? c : mine; }
    if (sum == G) break;
    __builtin_amdgcn_s_sleep(1);
    if ((++sp & 255u) == 0u) { if (xb_ld(&bar[XB_TMO])) break; if (sp > XB_SPIN_CAP) { atomicAdd(&bar[XB_TMO], 1u); break; } }
  }
  nloc = mine > 0u ? mine : 1u; nx = cnt > 0u ? cnt : 1u;
}
DI void xcd_barrier(const XcdBarrier& b) {
  asm volatile("s_waitcnt vmcnt(0)" ::: "memory");
  __syncthreads();
  if (threadIdx.x == 0) {
    unsigned* bar = b.bar;
    __builtin_amdgcn_s_waitcnt(0);
    unsigned nloc = b.st[0], nx = b.st[1];
    if (nloc == 0u) { xcd_barrier_complete(bar, b.x, nloc, nx); b.st[0] = nloc; b.st[1] = nx; }
    const unsigned old = xb_add(&bar[XB_XSUB(b.x)], 1u);
    const unsigned gen = old / nloc;
    if (old + 1u == (gen + 1u) * nloc) {
      __builtin_amdgcn_fence(__ATOMIC_RELEASE, "agent");
      asm volatile("s_waitcnt vmcnt(0)" ::: "memory");
      const unsigned og = xb_add(&bar[XB_TOP], 1u);
      const unsigned tg = og / nx;
      if (og + 1u == (tg + 1u) * nx) xb_add(&bar[XB_TOPGEN], 1u);
      else XB_SPIN(xb_ld(&bar[XB_TOPGEN]) == tg, bar);
      __builtin_amdgcn_fence(__ATOMIC_ACQUIRE, "agent");
      xb_add(&bar[XB_XGEN(b.x)], 1u);
      asm volatile("s_waitcnt vmcnt(0)" ::: "memory");
    } else {
      XB_SPIN(xb_ld(&bar[XB_XGEN(b.x)]) == gen, bar);
      __builtin_amdgcn_fence(__ATOMIC_ACQUIRE, "agent");
      asm volatile("s_waitcnt vmcnt(0)" ::: "memory");
    }
  }
  __syncthreads();
}

struct SchedPe {
  const bf16_t* pb; const bf16_t* wPlT; int q, nidle; EpiPe e;
  DI bool next(int i, Item& it) const { const int t = q + i * nidle; if (q < 0 || t >= (M / BM) * (D / BM)) return false;
    it.brow = (t >> 2) * BM; it.bcol = (t & 3) * BM; it.cA = (const char*)(pb + (size_t)it.brow * PLE); it.cB = (const char*)(wPlT + (size_t)it.bcol * PLE); it.nt = PLE / BK; it.tag = 0; return true; }
  DI bool epi(acc_t& acc, const Item& it) const { epi_call(acc, it.brow, it.bcol, e); return false; }
};
struct SchedP3 {
  const bf16_t *attn, *convg, *wAoT, *wCoT; const bf16_t* proj4; bf16_t* merged;
  DI bool next(int i, Item& it) const { int pm, pn; if (!tile_order(i >> 1, gridDim.x, blockIdx.x, M / BM, D / BM, pm, pn)) return false;
    it.brow = pm * BM; it.bcol = pn * BM; it.tag = i & 1; it.nt = SBW / BK;
    it.cA = (const char*)(((i & 1) ? convg : attn) + (size_t)it.brow * SBW); it.cB = (const char*)(((i & 1) ? wCoT : wAoT) + (size_t)it.bcol * SBW); return true; }
  DI bool epi(acc_t& acc, const Item& it) const {
    if (it.tag == 0) { const EpiGate<false> e{proj4, 2048, nullptr}; epi_call(acc, it.brow, it.bcol, e); return true; }
    const EpiGate<true> e{proj4, 3072, merged}; epi_call(acc, it.brow, it.bcol, e); return false; }
};
struct SchedP6 {
  const bf16_t *u, *wDnT; float* part; EpiRes<1> e;
  DI bool next(int i, Item& it) const { const int G = gridDim.x, c = blockIdx.x; int pm, pn;
    if (tile_order(i, G, c, MP / BM, D / BM, pm, pn)) { it.brow = pm * BM; it.bcol = pn * BM; it.nt = DFF / BK; it.tag = 0;
      it.cA = (const char*)(u + (size_t)it.brow * DFF); it.cB = (const char*)(wDnT + (size_t)it.bcol * DFF); return true; }
    const int ntl = (MP / BM) * (D / BM), nmine = (c < ntl) ? (ntl - c + G - 1) / G : 0, j = c + (i - nmine) * G;
    if (j >= (MS / BM) * (D / BM) * 4) return false;
    const int kq = j & 3; it.brow = (j >> 4) * BM; it.bcol = ((j >> 2) & 3) * BM; it.nt = DFF / 4 / BK; it.tag = 1 + kq;
    it.cA = (const char*)(u + (size_t)(MP + it.brow) * DFF + kq * (DFF / 4)); it.cB = (const char*)(wDnT + (size_t)it.bcol * DFF + kq * (DFF / 4)); return true; }
  DI bool epi(acc_t& acc, const Item& it) const {
    if (it.tag == 0) { epi_call(acc, it.brow, it.bcol, e); return false; }
    const EpiPartial ep{part + (size_t)(it.tag - 1) * MS * D}; epi_call(acc, it.brow, it.bcol, ep); return false; }
};

struct SchedP7 {
  const bf16_t *x2b, *wPgT; float* part; EpiRes<2> e;
  DI bool next(int i, Item& it) const { const int G = gridDim.x, c = blockIdx.x; int pm, pn;
    if (tile_order(i, G, c, MP / BM, D / BM, pm, pn)) { it.brow = pm * BM; it.bcol = pn * BM; it.nt = D / BK; it.tag = 0;
      it.cA = (const char*)(x2b + (size_t)it.brow * D); it.cB = (const char*)(wPgT + (size_t)it.bcol * D); return true; }
    const int ntl = (MP / BM) * (D / BM), nmine = (c < ntl) ? (ntl - c + G - 1) / G : 0, j = c + (i - nmine) * G;
    if (j >= (MS / BM) * (D / BM) * 4) return false;
    const int kq = j & 3; it.brow = (j >> 4) * BM; it.bcol = ((j >> 2) & 3) * BM; it.nt = D / 4 / BK; it.tag = 1 + kq;
    it.cA = (const char*)(x2b + (size_t)(MP + it.brow) * D + kq * (D / 4)); it.cB = (const char*)(wPgT + (size_t)it.bcol * D + kq * (D / 4)); return true; }
  DI bool epi(acc_t& acc, const Item& it) const {
    if (it.tag == 0) { epi_call(acc, it.brow, it.bcol, e); return false; }
    const EpiPartial ep{part + (size_t)(it.tag - 1) * MS * D}; epi_call(acc, it.brow, it.bcol, ep); return false; }
};

__global__ void __launch_bounds__(512, 2) fwd_megakernel(Params p) {
  cg::grid_group grid = cg::this_grid();
  const int NGW = gridDim.x * 8, NT = gridDim.x * blockDim.x;
#define PHASE_IDS int tid_ = threadIdx.x; asm volatile("" : "+v"(tid_)); const int lane = tid_ & 63, wave = tid_ >> 6, gw = blockIdx.x * 8 + wave, gtid = blockIdx.x * 512 + tid_; (void)lane; (void)wave; (void)gw; (void)gtid;
  unsigned char* ws = p.ws;
  bf16_t *wInT = (bf16_t*)(ws + W_IN), *wAoT = (bf16_t*)(ws + W_AO), *wCoT = (bf16_t*)(ws + W_CO), *wOT = (bf16_t*)(ws + W_O),
         *wUpT = (bf16_t*)(ws + W_UP), *wDnT = (bf16_t*)(ws + W_DN), *wPgT = (bf16_t*)(ws + W_PG), *wPlT = (bf16_t*)(ws + W_PL);
  float* rs0 = (float*)(ws + W_RS0); float* ss = (float*)(ws + W_SS);
  bf16_t* PE = (bf16_t*)(ws + W_PE);
  bf16_t *pb = (bf16_t*)(ws + W_PB), *RA = (bf16_t*)(ws + W_RA), *RB = (bf16_t*)(ws + W_RB), *RC = (bf16_t*)(ws + W_RC);
  float* y = p.out + O_Y;
  constexpr int I0 = (D / 64) * (NPROJ / 32), I1 = (SBW / 64) * (D / 32), I2 = I1, I3 = (D / 64) * (D / 32), I4 = (D / 64) * (DFF / 32),
                  I5 = (DFF / 64) * (D / 32), I6 = I3, I7 = (PLE / 64) * (D / 32), NI = I0 + I1 + I2 + I3 + I4 + I5 + I6 + I7;
  __shared__ uint4 xb_words;
  if (threadIdx.x == 0) xb_words = make_uint4(0u, 0u, 0u, 0u);
  __syncthreads();
  const XcdBarrier xb = xcd_barrier_post((unsigned*)(ws + W_BAR), (volatile LAS unsigned*)&xb_words);

  {
    PHASE_IDS
    float* scr = (float*)dyn_lds + wave * (64 * 33);
    for (int it = gw; it < I0 + I1 + I2 + I7; it += NGW) {
      int r = it;
      if (r < I0) { transpose_item<true>(p.w_in, p.g_mix, D, NPROJ, wInT, scr, r, lane); continue; } r -= I0;
      if (r < I1) { transpose_item<false>(p.w_ao, nullptr, SBW, D, wAoT, scr, r, lane); continue; } r -= I1;
      if (r < I2) { transpose_item<false>(p.w_co, nullptr, CW, D, wCoT, scr, r, lane); continue; } r -= I2;
      transpose_item<false>(p.w_pl, nullptr, PLE, D, wPlT, scr, r, lane);
    }
    for (int row0 = gw * 4; row0 < M; row0 += NGW * 4) {
      f32x4 v[4][4];
#pragma unroll
      for (int q = 0; q < 4; ++q) { const int row = row0 + q;
        const float* xr = (row < MP) ? p.x_p + (size_t)row * D : p.x_s + (size_t)(row - MP) * D;
        const f32x4* x4 = (const f32x4*)xr + lane;
#pragma unroll
        for (int j = 0; j < 4; ++j) v[q][j] = x4[64 * j]; }
#pragma unroll
      for (int q = 0; q < 4; ++q) { const int row = row0 + q; float sq = 0.f;
#pragma unroll
        for (int j = 0; j < 4; ++j) sq += (v[q][j].x * v[q][j].x + v[q][j].y * v[q][j].y) + (v[q][j].z * v[q][j].z + v[q][j].w * v[q][j].w);
        sq = wave_sum(sq);
        if (lane == 0) rs0[row] = rsqrtf(sq * (1.f / D) + EPS);
        u32x2* o8 = (u32x2*)(RA + (size_t)row * D) + lane;
#pragma unroll
        for (int j = 0; j < 4; ++j) { u32x2 o = {pk2(v[q][j].x, v[q][j].y), pk2(v[q][j].z, v[q][j].w)}; o8[64 * j] = o; } }
    }
    for (int idx0 = gtid; idx0 < M * PLE / 4; idx0 += NT * 4) {
      f32x4 v[4];
#pragma unroll
      for (int q = 0; q < 4; ++q) { const int idx = idx0 + q * NT; if (idx < M * PLE / 4) { const size_t e = (size_t)idx * 4;
          v[q] = *(const f32x4*)((e < (size_t)MP * PLE) ? p.p_p + e : p.p_s + (e - (size_t)MP * PLE)); } }
#pragma unroll
      for (int q = 0; q < 4; ++q) { const int idx = idx0 + q * NT; if (idx < M * PLE / 4) st_bf16x4(pb + (size_t)idx * 4, v[q]); }
    }
    for (int idx = gtid; idx < 3 * M; idx += NT) ss[idx] = 0.f;
  }
  if (p.ws == nullptr) grid.sync();
  xcd_barrier(xb);
  { EpiIn e{rs0, RC, p.out}; gemm_phase(RA, wInT, M, NPROJ, D, e); }
  { const int G = gridDim.x, ntl = (M / BM) * (NPROJ / BM), rem = ntl % G, c = blockIdx.x;
    const int nidle = (rem == 0) ? G : G - rem, q = (rem == 0) ? c : c - rem;
    const SchedPe sp{pb, wPlT, q, nidle, EpiPe{PE}}; gemm_stream(PLE, sp); }
  xcd_barrier(xb);
  { PHASE_IDS
    constexpr int NU = (MP / 32 / 8) * NH;
    const int upb = (NU + gridDim.x - 1) / gridDim.x;
    for (int j = 0; j < upb; ++j) { const int u = blockIdx.x * upb + j; if (u >= NU) break;
      const int bh = u >> 5, g = u & 31; attn_task(p, (bh >> 3) * (SEQ / 32) + g * 8 + wave, bh & 7, lane); }
    for (int sb = 0; sb < MS / DSEQ; ++sb) if ((sb * 8 + (sb & 7)) % gridDim.x == blockIdx.x) attn_task(p, MP / 32 + sb, wave, lane); }
  conv_items(p);
  xcd_barrier(xb);
  {
    const int nM = M / BM, nN = D / BM;
    { const SchedP3 s3{RB, RB + (size_t)M * SBW, wAoT, wCoT, RC, RA}; gemm_stream(SBW, s3); }
    { const int G = gridDim.x, rem = (nM * nN) % G, c = blockIdx.x; const int nidle = (rem == 0) ? G : G - rem, q = (rem == 0) ? c : c - rem;
      if (q >= 0) { PHASE_IDS
        float* scr = (float*)dyn_lds + wave * (64 * 33);
        for (int it = q * 8 + wave; it < I3 + I4; it += nidle * 8) {
          if (it < I3) transpose_item<false>(p.w_o, nullptr, D, D, wOT, scr, it, lane);
          else transpose_item<false>(p.w_up, p.g_ffn, D, DFF, wUpT, scr, it - I3, lane); } } }
  }
  xcd_barrier(xb);
  { EpiRes<0> e{p.x_p, p.x_s, nullptr, RB, ss, nullptr, nullptr}; gemm_phase(RA, wOT, M, D, D, e); }
  xcd_barrier(xb);
  { EpiUp e{ss, RC}; gemm_phase(RB, wUpT, M, DFF, D, e); }
  { const int G = gridDim.x, rem = ((M / BM) * (DFF / BM)) % G, c = blockIdx.x; const int nidle = (rem == 0) ? G : G - rem, q = (rem == 0) ? c : c - rem;
    if (q >= 0) { PHASE_IDS
      float* scr = (float*)dyn_lds + wave * (64 * 33);
      for (int it = q * 8 + wave; it < I5 + I6; it += nidle * 8) {
        if (it < I5) transpose_item<false>(p.w_dn, nullptr, DFF, D, wDnT, scr, it, lane);
        else transpose_item<false>(p.w_pg, p.g_ple, D, D, wPgT, scr, it - I5, lane); } } }
  xcd_barrier(xb);
  { const SchedP6 s6{RC, wDnT, (float*)(ws + W_PB), EpiRes<1>{nullptr, nullptr, RB, RA, ss + M, nullptr, nullptr}}; gemm_stream(DFF, s6); }
  xcd_barrier(xb);
  { PHASE_IDS
    const float* part = (const float*)(ws + W_PB);
    for (int r = gw; r < MS; r += NGW) { const int row = MP + r; float sq = 0.f;
#pragma unroll
      for (int j = 0; j < 4; ++j) { const int col = j * 256 + lane * 4;
        f32x4 v = ld_bf16x4(RB + (size_t)row * D + col);
#pragma unroll
        for (int kq = 0; kq < 4; ++kq) v += *(const f32x4*)(part + ((size_t)kq * MS + r) * D + col);
        st_bf16x4(RA + (size_t)row * D + col, v); sq += (v.x * v.x + v.y * v.y) + (v.z * v.z + v.w * v.w); }
      sq = wave_sum(sq);
      if (lane == 0) ss[M + row] = sq; } }
  xcd_barrier(xb);
  { const SchedP7 s7{RA, wPgT, (float*)(ws + W_PB), EpiRes<2>{nullptr, nullptr, RA, RC, ss + 2 * M, ss + M, PE}}; gemm_stream(D, s7); }
  xcd_barrier(xb);
  { PHASE_IDS
  for (int idx0 = gtid; idx0 < MP * (D / 8); idx0 += NT * 4) {
    u32x4 xv[4]; float rv[4];
#pragma unroll
    for (int q = 0; q < 4; ++q) { const int idx = idx0 + q * NT; if (idx < MP * (D / 8)) { const int row = idx >> 7, c = (idx & 127) * 8;
        xv[q] = *(const u32x4*)(RC + (size_t)row * D + c); rv[q] = ss[2 * M + row]; } }
#pragma unroll
    for (int q = 0; q < 4; ++q) { const int idx = idx0 + q * NT; if (idx < MP * (D / 8)) { const int row = idx >> 7, c = (idx & 127) * 8;
        const float r = rsqrtf(rv[q] * (1.f / D) + EPS); f32x4 a0, a1; unpack8(xv[q], a0, a1);
        const f32x4 g0 = *(const f32x4*)(p.g_final + c), g1 = *(const f32x4*)(p.g_final + c + 4);
        *(f32x4*)(y + (size_t)row * D + c) = a0 * r * g0; *(f32x4*)(y + (size_t)row * D + c + 4) = a1 * r * g1; } }
  }
  { const float* part = (const float*)(ws + W_PB);
    for (int r = NGW - 1 - gw; r < MS; r += NGW) { const int row = MP + r; const float r2 = rsqrtf(ss[M + row] * (1.f / D) + EPS);
      f32x4 x3[4]; float sq = 0.f;
#pragma unroll
      for (int j = 0; j < 4; ++j) { const int col = j * 256 + lane * 4;
        f32x4 gsum = *(const f32x4*)(part + (size_t)r * D + col);
#pragma unroll
        for (int kq = 1; kq < 4; ++kq) gsum += *(const f32x4*)(part + ((size_t)kq * MS + r) * D + col);
        const f32x4 x2 = ld_bf16x4(RA + (size_t)row * D + col), pe4 = ld_bf16x4(PE + (size_t)row * D + col);
        gsum = gsum * r2;
        const f32x4 sg = {sigmoidf_(gsum.x), sigmoidf_(gsum.y), sigmoidf_(gsum.z), sigmoidf_(gsum.w)};
        x3[j] = x2 + sg * pe4; sq += (x3[j].x * x3[j].x + x3[j].y * x3[j].y) + (x3[j].z * x3[j].z + x3[j].w * x3[j].w); }
      sq = wave_sum(sq); const float r3 = rsqrtf(sq * (1.f / D) + EPS);
#pragma unroll
      for (int j = 0; j < 4; ++j) { const int col = j * 256 + lane * 4; const f32x4 g = *(const f32x4*)(p.g_final + col);
        *(f32x4*)(y + (size_t)row * D + col) = x3[j] * r3 * g; } } }
  }
}

extern "C" void kernel_launch(void* const* d_in, const int* in_sizes, int n_in, void* d_out, int out_size, void* d_ws, size_t ws_size, hipStream_t stream) {
  static int grid_blocks = 0;
  if (grid_blocks == 0) {
    if (ws_size < W_END) { fprintf(stderr, "kernel_launch: workspace too small (%zu < %zu)\n", ws_size, (size_t)W_END); grid_blocks = -1; return; }
    int dev = 0, cus = 0, per_cu = 0;
    hipGetDevice(&dev);
    hipDeviceGetAttribute(&cus, hipDeviceAttributeMultiprocessorCount, dev);
    hipFuncSetAttribute((const void*)fwd_megakernel, hipFuncAttributeMaxDynamicSharedMemorySize, SHM_B);
    hipOccupancyMaxActiveBlocksPerMultiprocessor(&per_cu, (const void*)fwd_megakernel, 512, SHM_B);
    if (per_cu < 1) { fprintf(stderr, "kernel_launch: occupancy query says %d blocks/CU\n", per_cu); per_cu = 1; }
    grid_blocks = cus;
  }
  if (grid_blocks < 0) return;
  Params p{};
  p.x_p = (const float*)d_in[0]; p.x_s = (const float*)d_in[1]; p.p_p = (const float*)d_in[2]; p.p_s = (const float*)d_in[3];
  p.cache_k = (const float*)d_in[4]; p.cache_v = (const float*)d_in[5]; p.cache_conv = (const float*)d_in[6];
  p.g_mix = (const float*)d_in[7]; p.w_in = (const float*)d_in[8]; p.conv_w = (const float*)d_in[9]; p.w_ao = (const float*)d_in[10];
  p.w_co = (const float*)d_in[11]; p.w_o = (const float*)d_in[12]; p.g_ffn = (const float*)d_in[13]; p.w_up = (const float*)d_in[14];
  p.w_dn = (const float*)d_in[15]; p.g_ple = (const float*)d_in[16]; p.w_pg = (const float*)d_in[17]; p.w_pl = (const float*)d_in[18];
  p.g_final = (const float*)d_in[19];
  p.out = (float*)d_out; p.ws = (unsigned char*)d_ws;
  (void)hipMemsetAsync((unsigned char*)d_ws + W_BAR, 0, XCD_BAR_WORDS * 4, stream);
  void* args[] = {&p};
  hipError_t e = hipLaunchCooperativeKernel((const void*)fwd_megakernel, dim3(grid_blocks), dim3(512), args, SHM_B, stream);
  if (e != hipSuccess) fprintf(stderr, "cooperative launch failed: %s (grid %d)\n", hipGetErrorString(e), grid_blocks);
}
```

```cpp
#include <hip/hip_runtime.h>
#include <hip/hip_cooperative_groups.h>
#include <cstdio>
#include <cstdint>
namespace cg = cooperative_groups;

#define DI __device__ __forceinline__
typedef unsigned short bf16_t;
typedef short bf16x8 __attribute__((ext_vector_type(8)));
typedef float f32x4 __attribute__((ext_vector_type(4)));
typedef float f32x2 __attribute__((ext_vector_type(2)));
typedef float f32x16 __attribute__((ext_vector_type(16)));
typedef unsigned u32x4 __attribute__((ext_vector_type(4)));
typedef unsigned u32x2 __attribute__((ext_vector_type(2)));
typedef __bf16 bf16v2 __attribute__((ext_vector_type(2)));

constexpr int D = 1024, NPROJ = 5120, MP = 32768, MS = 1024, M = MP + MS, SEQ = 8192, DSEQ = 32, PAST = 2048;
constexpr int NH = 8, HD = 64, SBW = 512, CW = 512, PLE = 256, DFF = 4096, P4W = 4096;
constexpr float EPS = 1e-6f;
constexpr size_t O_Y = 0, O_KP = (size_t)M * D, O_VP = O_KP + (size_t)MP * SBW, O_CP = O_VP + (size_t)MP * SBW,
                 O_KS = O_CP + 4 * 2 * CW, O_VS = O_KS + (size_t)MS * SBW, O_CS = O_VS + (size_t)MS * SBW;
constexpr size_t W_IN = 0, W_AO = W_IN + (size_t)NPROJ * D * 2, W_CO = W_AO + (size_t)D * SBW * 2, W_O = W_CO + (size_t)D * CW * 2,
                 W_UP = W_O + (size_t)D * D * 2, W_DN = W_UP + (size_t)DFF * D * 2, W_PG = W_DN + (size_t)D * DFF * 2,
                 W_PL = W_PG + (size_t)D * D * 2, W_RS0 = W_PL + (size_t)D * PLE * 2, W_SS = W_RS0 + (size_t)M * 4,
                 W_PB = W_SS + (size_t)3 * M * 4, W_RA = W_PB + (size_t)M * PLE * 2, W_RB = W_RA + (size_t)M * D * 2,
                 W_RC = W_RB + (size_t)M * D * 2, W_BAR = W_RC + (size_t)M * P4W * 2, W_PE = W_BAR + 16384, W_END = W_PE + (size_t)M * D * 2;

struct Params {
  const float *x_p, *x_s, *p_p, *p_s, *cache_k, *cache_v, *cache_conv;
  const float *g_mix, *w_in, *conv_w, *w_ao, *w_co, *w_o, *g_ffn, *w_up, *w_dn, *g_ple, *w_pg, *w_pl, *g_final;
  float* out; unsigned char* ws;
};

extern __shared__ __attribute__((aligned(16))) unsigned char dyn_lds[];

DI unsigned pk2(float lo, float hi) { f32x2 f = {lo, hi}; bf16v2 b = __builtin_convertvector(f, bf16v2); return __builtin_bit_cast(unsigned, b); }
DI float bf2f(unsigned h16) { return __uint_as_float(h16 << 16); }
DI float bflo(unsigned u) { return __uint_as_float(u << 16); }
DI float bfhi(unsigned u) { return __uint_as_float(u & 0xffff0000u); }
DI bf16x8 cvt8(f32x4 a, f32x4 b) { u32x4 u = {pk2(a.x, a.y), pk2(a.z, a.w), pk2(b.x, b.y), pk2(b.z, b.w)}; return __builtin_bit_cast(bf16x8, u); }
DI float sigmoidf_(float v) { return __builtin_amdgcn_rcpf(1.f + __expf(-v)); }
DI float wave_sum(float v) {
#pragma unroll
  for (int o = 1; o < 64; o <<= 1) v += __shfl_xor(v, o);
  return v;
}

constexpr int BM = 256, BK = 64, HALF = 128, NXCD = 8, WGM = 8, HT = HALF * BK, SHM_B = 8 * HT * 2;
DI int lds_byte(int r, int c) { int st = (r >> 4) * 2 + (c >> 5), rr = r & 15, cc = c & 31, ob = rr * 64 + cc * 2; return st * 1024 + (ob ^ (((ob >> 9) & 1) << 5)); }
DI void stage_rc(int b, int& R, int& C) { int st = b / 1024, sb = b % 1024, swz = sb ^ (((sb >> 9) & 1) << 5); R = (st >> 1) * 16 + swz / 64; C = (st & 1) * 32 + (swz % 64) / 2; }

DI bool tile_order(int i, int G, int c, int nM, int nN, int& pm, int& pn) {
  const int nwg = nM * nN; const long L = (long)i * G + c; if (L >= nwg) return false;
  int wgid = (int)L; { const int q = nwg / NXCD, r = nwg % NXCD, xcd = wgid % NXCD, off = wgid / NXCD; wgid = (xcd < r ? xcd * (q + 1) : r * (q + 1) + (xcd - r) * q) + off; }
  const int nig = WGM * nN, gid = wgid / nig, fm = gid * WGM, gsz = (nM - fm) < WGM ? (nM - fm) : WGM;
  pm = fm + ((wgid % nig) % gsz); pn = (wgid % nig) / gsz; return true;
}

typedef f32x4 acc_t[2][2][4][2];
struct Item { const char* cA; const char* cB; int brow, bcol, nt, tag; };
template <class F>
DI void epi_call(acc_t& acc, const int brow, const int bcol, const F& f) {
  int tid2 = threadIdx.x, brow2 = brow, bcol2 = bcol;
  asm volatile("" : "+v"(tid2), "+s"(brow2), "+s"(bcol2));
  const int wid2 = tid2 >> 6, lane2 = tid2 & 63;
  f(acc, brow2, bcol2, wid2 >> 2, wid2 & 3, lane2 & 15, lane2 >> 4);
}
template <class Sched>
DI void gemm_stream(const int ld, const Sched& sch) {
  char* lds = (char*)dyn_lds;
  int tid = threadIdx.x; asm volatile("" : "+v"(tid));
  const int wid = tid >> 6, lane = tid & 63, wr = wid >> 2, wc = wid & 3, fr = lane & 15, fq = lane >> 4;
  const int wbase = __builtin_amdgcn_readfirstlane((tid & ~63) * 16);
  unsigned voff0, voff1;
  { int r_, c_; stage_rc(tid * 16, r_, c_); voff0 = (unsigned)(r_ * ld + c_) * 2u; stage_rc(tid * 16 + 8192, r_, c_); voff1 = (unsigned)(r_ * ld + c_) * 2u; }
  const size_t kstep = (size_t)BK * 2, hstep = (size_t)HALF * ld * 2;
#define SA(b, h) (((b) * 2 + (h)) * (HT * 2))
#define SB(b, h) ((4 + (b) * 2 + (h)) * (HT * 2))
#define STAGE(bufoff, gbase) do { const char* _ub = (gbase); \
    __builtin_amdgcn_global_load_lds((const unsigned*)(_ub + voff0), (unsigned*)(lds + (bufoff) + wbase), 16, 0, 0); \
    __builtin_amdgcn_global_load_lds((const unsigned*)(_ub + voff1), (unsigned*)(lds + (bufoff) + wbase + 8192), 16, 0, 0); } while (0)
#define LDA(dst, b, h) for (int m = 0; m < 4; ++m) for (int k = 0; k < 2; ++k) \
    dst[m][k] = *reinterpret_cast<const bf16x8*>(lds + SA(b, h) + lds_byte(wr * 64 + m * 16 + fr, k * 32 + fq * 8))
#define LDB(dst, b, h) for (int n = 0; n < 2; ++n) for (int k = 0; k < 2; ++k) \
    dst[n][k] = *reinterpret_cast<const bf16x8*>(lds + SB(b, h) + lds_byte(wc * 32 + n * 16 + fr, k * 32 + fq * 8))
#define MMA(ai, bj, At_, Bt_) do { __builtin_amdgcn_s_setprio(1); \
    for (int m = 0; m < 4; ++m) for (int n = 0; n < 2; ++n) for (int k = 0; k < 2; ++k) \
      acc[ai][bj][m][n] = __builtin_amdgcn_mfma_f32_16x16x32_bf16(Bt_[n][k], At_[m][k], acc[ai][bj][m][n], 0, 0, 0); \
    __builtin_amdgcn_s_setprio(0); } while (0)
#define WAIT_V(n) asm volatile("s_waitcnt vmcnt(" #n ")" ::: "memory")
#define WAIT_L(n) asm volatile("s_waitcnt lgkmcnt(" #n ")" ::: "memory")
#define BAR __builtin_amdgcn_s_barrier()
#define SCHED __builtin_amdgcn_sched_barrier(0)
  Item cur, nxt; int ui = 0;
  if (!sch.next(0, cur)) return;
  acc_t acc = {};
  bf16x8 At[4][2], B0[2][2], B1[2][2];
  const char* cA = cur.cA; const char* cB = cur.cB;
  STAGE(SB(0, 0), cB); STAGE(SA(0, 0), cA); STAGE(SB(0, 1), cB + hstep); STAGE(SA(0, 1), cA + hstep);
  if (wr == 1) BAR;
  WAIT_V(4); BAR;
  STAGE(SB(1, 0), cB + kstep); STAGE(SA(1, 0), cA + kstep); STAGE(SB(1, 1), cB + hstep + kstep);
  WAIT_V(6); BAR;
  for (;;) {
    const bool has_next = sch.next(ui + 1, nxt);
    const char* nA = has_next ? nxt.cA : cA; const char* nB = has_next ? nxt.cB : cB;
    const int nt = cur.nt;
    for (int t = 0; t < nt; t += 2) {
      const bool last = (t == nt - 2);
      const char* a1 = cA + (size_t)(t + 1) * kstep;
      const char* a2 = last ? nA : cA + (size_t)(t + 2) * kstep; const char* b2 = last ? nB : cB + (size_t)(t + 2) * kstep;
      const char* a3 = a2 + kstep; const char* b3 = b2 + kstep;
      LDB(B0, 0, 0); SCHED; LDA(At, 0, 0); STAGE(SA(1, 1), a1 + hstep);
      WAIT_L(8); BAR; WAIT_L(0); MMA(0, 0, At, B0); BAR; SCHED;
      LDB(B1, 0, 1); STAGE(SB(0, 0), b2);
      BAR; WAIT_L(0); MMA(0, 1, At, B1); BAR;
      LDA(At, 0, 1); STAGE(SA(0, 0), a2);
      BAR; WAIT_L(0); MMA(1, 0, At, B0); BAR; SCHED;
      STAGE(SB(0, 1), b2 + hstep);
      WAIT_V(6); BAR; MMA(1, 1, At, B1); BAR;
      LDB(B0, 1, 0); SCHED; LDA(At, 1, 0); STAGE(SA(0, 1), a2 + hstep);
      WAIT_L(8); BAR; WAIT_L(0); MMA(0, 0, At, B0); BAR; SCHED;
      LDB(B1, 1, 1); STAGE(SB(1, 0), b3);
      BAR; WAIT_L(0); MMA(0, 1, At, B1); BAR;
      LDA(At, 1, 1); STAGE(SA(1, 0), a3);
      BAR; WAIT_L(0); MMA(1, 0, At, B0); BAR; SCHED;
      STAGE(SB(1, 1), b3 + hstep);
      WAIT_V(6); BAR; MMA(1, 1, At, B1); BAR;
    }
    const bool keep = sch.epi(acc, cur);
    if (!has_next) break;
    if (!keep) {
#pragma unroll
      for (int a_ = 0; a_ < 2; ++a_)
#pragma unroll
        for (int b_ = 0; b_ < 2; ++b_)
#pragma unroll
          for (int m = 0; m < 4; ++m)
#pragma unroll
            for (int n = 0; n < 2; ++n) acc[a_][b_][m][n] = (f32x4){0.f, 0.f, 0.f, 0.f}; }
    cur = nxt; cA = nA; cB = nB; ++ui;
  }
  WAIT_V(0);
  if (wr == 0) BAR;
  BAR;
}
template <class Epi>
struct SchedStd {
  const bf16_t* A; const bf16_t* Bt; int nM, nN, K; Epi e; const bf16_t* A2; int msplit;
  DI bool next(int i, Item& it) const { int pm, pn; if (!tile_order(i, gridDim.x, blockIdx.x, nM, nN, pm, pn)) return false;
    it.brow = pm * BM; it.bcol = pn * BM; it.cA = (const char*)((it.brow < msplit ? A : A2) + (size_t)it.brow * K); it.cB = (const char*)(Bt + (size_t)it.bcol * K); it.nt = K / BK; it.tag = 0; return true; }
  DI bool epi(acc_t& acc, const Item& it) const { epi_call(acc, it.brow, it.bcol, e); return false; }
};
template <class Epi>
DI void gemm_phase(const bf16_t* A, const bf16_t* Bt, int Mrows, int N, int K, const Epi& epi, const bf16_t* A2 = nullptr, int msplit = 1 << 30) {
  const SchedStd<Epi> sch{A, Bt, Mrows / BM, N / BM, K, epi, A2, msplit};
  gemm_stream(K, sch);
}

DI void st_bf16x4(bf16_t* p, f32x4 v) { u32x2 u = {pk2(v.x, v.y), pk2(v.z, v.w)}; *(u32x2*)p = u; }
DI f32x4 ld_bf16x4(const bf16_t* p) { u32x2 u = *(const u32x2*)p; f32x4 v = {bflo(u.x), bfhi(u.x), bflo(u.y), bfhi(u.y)}; return v; }

#define EPI_ROWS for (int ai = 0; ai < 2; ++ai) for (int m = 0; m < 4; ++m)
#define EPI_COLS for (int bj = 0; bj < 2; ++bj) for (int n = 0; n < 2; ++n)
#define EPI_BJ for (int bj = 0; bj < 2; ++bj)
#define EPI_ROW (brow + ai * HALF + wr * 64 + m * 16 + fr)
#define EPI_COL (bcol + bj * HALF + wc * 32 + n * 16 + fq * 4)
#define EPI_COL8 (bcol + bj * HALF + wc * 32 + fq * 8)
DI void st_bf16x8(bf16_t* p, f32x4 a, f32x4 b) { u32x4 u = {pk2(a.x, a.y), pk2(a.z, a.w), pk2(b.x, b.y), pk2(b.z, b.w)}; *(u32x4*)p = u; }
DI void unpack8(const u32x4 u, f32x4& a, f32x4& b) { a = (f32x4){bflo(u.x), bfhi(u.x), bflo(u.y), bfhi(u.y)}; b = (f32x4){bflo(u.z), bfhi(u.z), bflo(u.w), bfhi(u.w)}; }

struct EpiIn {
  const float* rs0; bf16_t* proj4; float* out;
  DI void operator()(const acc_t& acc, int brow, int bcol, int wr, int wc, int fr, int fq) const {
    float rr[2][4];
#pragma unroll
    EPI_ROWS rr[ai][m] = rs0[EPI_ROW];
    if (bcol >= 512 && bcol < 1536) {
#pragma unroll
      EPI_ROWS { const int row = EPI_ROW; const float r = rr[ai][m];
#pragma unroll
        EPI_COLS { const int col = EPI_COL; f32x4 v = acc[ai][bj][m][n] * r;
          const int isv = bcol >= 1024; const int c = col - (isv ? 1024 : 512);
          float* dst = (row < MP) ? out + (isv ? O_VP : O_KP) + (size_t)row * SBW + c : out + (isv ? O_VS : O_KS) + (size_t)(row - MP) * SBW + c;
          *(f32x4*)dst = v; } }
    } else if (bcol < 2048) {
      const float sc = (bcol < 512) ? 0.18033688011112042f   : 1.f; const int sh = (bcol < 512) ? 0 : 1024;
#pragma unroll
      EPI_ROWS { const int row = EPI_ROW; const float r = rr[ai][m] * sc;
#pragma unroll
        EPI_BJ { st_bf16x8(proj4 + (size_t)row * P4W + (EPI_COL8 - sh), acc[ai][bj][m][0] * r, acc[ai][bj][m][1] * r); } }
    } else {
      const bool gate = bcol >= 3072; const int t = ((bcol - (gate ? 3072 : 2048)) >> 8) * 128;
#pragma unroll
      EPI_ROWS { const int row = EPI_ROW; const float r = rr[ai][m]; const int ch = t + wc * 32 + fq * 8;
        const f32x4 a0 = acc[ai][0][m][0] * r, a1 = acc[ai][0][m][1] * r, b0 = acc[ai][1][m][0] * r, b1 = acc[ai][1][m][1] * r;
        if (!gate) { st_bf16x8(proj4 + (size_t)row * P4W + 1024 + ch, a0 * b0, a1 * b1); }
        else { f32x4 rho0, rho1, sg0, sg1;
#pragma unroll
          for (int e = 0; e < 4; ++e) {
            { const float ea = __expf(-a0[e]), eb = __expf(-fmaxf(b0[e], -80.f)); sg0[e] = __builtin_amdgcn_rcpf(1.f + eb); rho0[e] = (1.f + eb) * __builtin_amdgcn_rcpf(1.f + ea); }
            { const float ea = __expf(-a1[e]), eb = __expf(-fmaxf(b1[e], -80.f)); sg1[e] = __builtin_amdgcn_rcpf(1.f + eb); rho1[e] = (1.f + eb) * __builtin_amdgcn_rcpf(1.f + ea); } }
          st_bf16x8(proj4 + (size_t)row * P4W + 2048 + ch, rho0, rho1); st_bf16x8(proj4 + (size_t)row * P4W + 3072 + ch, sg0, sg1); } }
    }
  }
};
template <bool FINAL>
struct EpiGate {
  const bf16_t* proj4; int off; bf16_t* merged;
  DI void operator()(acc_t& acc, int brow, int bcol, int wr, int wc, int fr, int fq) const {
    u32x4 g[2][4][2];
#pragma unroll
    EPI_ROWS { const int row = EPI_ROW;
#pragma unroll
      EPI_BJ g[ai][m][bj] = *(const u32x4*)(proj4 + (size_t)row * P4W + off + EPI_COL8); }
#pragma unroll
    EPI_ROWS { const int row = EPI_ROW;
#pragma unroll
      EPI_BJ { f32x4 g0, g1; unpack8(g[ai][m][bj], g0, g1);
        if (FINAL) st_bf16x8(merged + (size_t)row * D + EPI_COL8, acc[ai][bj][m][0] * g0, acc[ai][bj][m][1] * g1);
        else { acc[ai][bj][m][0] *= g0; acc[ai][bj][m][1] *= g1; } } }
  }
};
template <int MODE>
struct EpiRes {
  const float *x_p, *x_s; const bf16_t* resb; bf16_t* outb; float* ss; const float* ssprev; const bf16_t* pe;
  DI void operator()(const acc_t& acc, int brow, int bcol, int wr, int wc, int fr, int fq) const {
#pragma unroll
    for (int ai = 0; ai < 2; ++ai) {
      f32x4 resf[4][2][2]; u32x4 resh[4][2], peh[4][2]; float rr[4];
#pragma unroll
      for (int m = 0; m < 4; ++m) { const int row = EPI_ROW;
        if (MODE == 2) rr[m] = ssprev[row];
#pragma unroll
        EPI_BJ { const int col = EPI_COL8;
          if (MODE == 0) { const float* xp = (row < MP) ? x_p + (size_t)row * D + col : x_s + (size_t)(row - MP) * D + col;
            resf[m][bj][0] = *(const f32x4*)xp; resf[m][bj][1] = *(const f32x4*)(xp + 4); }
          else resh[m][bj] = *(const u32x4*)(resb + (size_t)row * D + col);
          if (MODE == 2) peh[m][bj] = *(const u32x4*)(pe + (size_t)row * D + col); } }
#pragma unroll
      for (int m = 0; m < 4; ++m) { const int row = EPI_ROW; float part = 0.f; float r = 0.f;
        if (MODE == 2) r = rsqrtf(rr[m] * (1.f / D) + EPS);
#pragma unroll
        EPI_BJ { const int col = EPI_COL8; f32x4 a0 = acc[ai][bj][m][0], a1 = acc[ai][bj][m][1]; f32x4 r0, r1;
          if (MODE == 0) { r0 = resf[m][bj][0]; r1 = resf[m][bj][1]; } else unpack8(resh[m][bj], r0, r1);
          if (MODE == 2) { f32x4 e0, e1; unpack8(peh[m][bj], e0, e1); a0 = a0 * r; a1 = a1 * r;
            const f32x4 s0 = {sigmoidf_(a0.x), sigmoidf_(a0.y), sigmoidf_(a0.z), sigmoidf_(a0.w)}, s1 = {sigmoidf_(a1.x), sigmoidf_(a1.y), sigmoidf_(a1.z), sigmoidf_(a1.w)};
            a0 = s0 * e0; a1 = s1 * e1; }
          const f32x4 o0 = r0 + a0, o1 = r1 + a1;
          st_bf16x8(outb + (size_t)row * D + col, o0, o1);
          part += (o0.x * o0.x + o0.y * o0.y + o0.z * o0.z + o0.w * o0.w) + (o1.x * o1.x + o1.y * o1.y + o1.z * o1.z + o1.w * o1.w); }
        part += __shfl_xor(part, 16); part += __shfl_xor(part, 32);
        if (fq == 0) atomicAdd(ss + row, part); }
    }
  }
};
struct EpiUp {
  const float* ss1; bf16_t* u;
  DI void operator()(const acc_t& acc, int brow, int bcol, int wr, int wc, int fr, int fq) const {
    float rr[2][4];
#pragma unroll
    EPI_ROWS rr[ai][m] = ss1[EPI_ROW];
#pragma unroll
    EPI_ROWS { const int row = EPI_ROW; const float r = rsqrtf(rr[ai][m] * (1.f / D) + EPS);
#pragma unroll
      EPI_BJ { f32x4 a0 = acc[ai][bj][m][0] * r, a1 = acc[ai][bj][m][1] * r;
        const f32x4 z0 = {fmaxf(a0.x, 0.f), fmaxf(a0.y, 0.f), fmaxf(a0.z, 0.f), fmaxf(a0.w, 0.f)}, z1 = {fmaxf(a1.x, 0.f), fmaxf(a1.y, 0.f), fmaxf(a1.z, 0.f), fmaxf(a1.w, 0.f)};
        st_bf16x8(u + (size_t)row * DFF + EPI_COL8, z0 * z0, z1 * z1); } }
  }
};
struct EpiPartial {
  float* part;
  DI void operator()(const acc_t& acc, int brow, int bcol, int wr, int wc, int fr, int fq) const {
#pragma unroll
    EPI_ROWS { const int row = EPI_ROW;
#pragma unroll
      EPI_BJ { float* d = part + (size_t)row * D + EPI_COL8; *(f32x4*)d = acc[ai][bj][m][0]; *(f32x4*)(d + 4) = acc[ai][bj][m][1]; } }
  }
};
struct EpiPe {
  bf16_t* pe;
  DI void operator()(const acc_t& acc, int brow, int bcol, int wr, int wc, int fr, int fq) const {
#pragma unroll
    EPI_ROWS { const int row = EPI_ROW;
#pragma unroll
      EPI_BJ { st_bf16x8(pe + (size_t)row * D + EPI_COL8, acc[ai][bj][m][0], acc[ai][bj][m][1]); } }
  }
};

DI int win_perm(int n) {
  if (n < 2048) return n;
  if (n < 3072) { const int r = n - 2048, c = r & 511; return 2048 + 256 * (c >> 7) + ((r >> 9) ? 128 : 0) + (c & 127); }
  const int r = n - 3072, c = r & 1023; return 3072 + 256 * (c >> 7) + ((r >> 10) ? 128 : 0) + (c & 127);
}
template <bool PERM>
DI void transpose_item(const float* __restrict__ W, const float* __restrict__ g, int K, int N, bf16_t* __restrict__ WT, float* scr, int item, int lane) {
  const int nblk = N / 32, kb = item / nblk, nb = item % nblk, k0 = 64 * kb, n0 = 32 * nb;
  const int n0d = PERM ? win_perm(n0) : n0;
  const bool p32 = !(PERM && n0 >= 512 && n0 < 1536);
  float wv[32];
#pragma unroll
  for (int i = 0; i < 32; ++i) { const int kk = 2 * i + (lane >> 5); wv[i] = W[(size_t)(k0 + kk) * N + n0 + (lane & 31)]; }
  if (g) {
#pragma unroll
    for (int i = 0; i < 32; ++i) wv[i] *= g[k0 + 2 * i + (lane >> 5)]; }
#pragma unroll
  for (int i = 0; i < 32; ++i) scr[(2 * i + (lane >> 5)) * 33 + (lane & 31)] = wv[i];
  asm volatile("s_waitcnt lgkmcnt(0)" ::: "memory");
  const int c = lane & 7;
#pragma unroll
  for (int j = 0; j < 4; ++j) { const int n = (lane >> 3) + 8 * j; const int ns = p32 ? (8 * ((n & 15) >> 2) + 4 * (n >> 4) + (n & 3)) : n; const float* s = scr + (8 * c) * 33 + ns;
    u32x4 o = {pk2(s[0 * 33], s[1 * 33]), pk2(s[2 * 33], s[3 * 33]), pk2(s[4 * 33], s[5 * 33]), pk2(s[6 * 33], s[7 * 33])};
    *(u32x4*)(WT + (size_t)(n0d + n) * K + k0 + 8 * c) = o; }
  asm volatile("s_waitcnt lgkmcnt(0)" ::: "memory");
}

#define MFMA32(a, b, c) __builtin_amdgcn_mfma_f32_32x32x16_bf16((a), (b), (c), 0, 0, 0)
DI void attn_load(const float* __restrict__ Kp, const float* __restrict__ Vp, int i, int half, f32x4 (&kr)[8], float (&vr)[32]) {
#pragma unroll
  for (int s = 0; s < 4; ++s) { const f32x4* kp = (const f32x4*)(Kp + (size_t)i * SBW + 16 * s + 8 * half); kr[2 * s] = kp[0]; kr[2 * s + 1] = kp[1]; }
#pragma unroll
  for (int s = 0; s < 2; ++s)
#pragma unroll
    for (int jj = 0; jj < 8; ++jj) { const int key = 16 * s + 8 * (jj >> 2) + 4 * half + (jj & 3);
      vr[(2 * s) * 8 + jj] = Vp[(size_t)key * SBW + i]; vr[(2 * s + 1) * 8 + jj] = Vp[(size_t)key * SBW + 32 + i]; }
}
template <bool DIAG>
DI void attn_weights(const f32x16& sacc, int i, int half, float& C, float (&a)[16]) {
  float be[16], om[16];
#pragma unroll
  for (int r = 0; r < 16; ++r) { const float z = sacc[r];
    const float e = __builtin_amdgcn_exp2f(-fabsf(z)), rc = __builtin_amdgcn_rcpf(1.f + e), er = e * rc;
    float b = (z >= 0.f) ? rc : er, o = (z >= 0.f) ? er : rc;
    if (DIAG) { const int key = (r & 3) + 8 * (r >> 2) + 4 * half; const bool valid = key < i; b = valid ? b : 0.f; o = valid ? o : 1.f; }
    be[r] = b; om[r] = o; }
  float G[4], Pn[4];
#pragma unroll
  for (int g = 0; g < 4; ++g) { G[g] = (om[4 * g] * om[4 * g + 1]) * (om[4 * g + 2] * om[4 * g + 3]); Pn[g] = __shfl_xor(G[g], 32); }
  float run = C;
#pragma unroll
  for (int g = 3; g >= 0; --g) { float t = half ? run : run * Pn[g];
#pragma unroll
    for (int u = 3; u >= 0; --u) { a[4 * g + u] = be[4 * g + u] * t; t *= om[4 * g + u]; }
    run *= G[g] * Pn[g]; }
  C = run;
}
DI void attn_task(const Params& p, const int qb, const int h, int lane) {
  const bf16_t* proj4 = (const bf16_t*)(p.ws + W_RC);
  bf16_t* attn = (bf16_t*)(p.ws + W_RB);
  const int i = lane & 31, half = lane >> 5;
  int qtok0, nblk; const float *k0p, *v0p, *k1p, *v1p;
  if (qb < MP / 32) { const int b = qb >> 8, t0 = (qb & 255) * 32; qtok0 = b * SEQ + t0; nblk = (t0 >> 5) + 1;
    k0p = p.out + O_KP + (size_t)qtok0 * SBW; v0p = p.out + O_VP + (size_t)qtok0 * SBW; k1p = k0p; v1p = v0p; }
  else { const int b = qb - MP / 32; qtok0 = MP + b * DSEQ; nblk = 1 + PAST / 32;
    k0p = p.out + O_KS + (size_t)(b * DSEQ) * SBW; v0p = p.out + O_VS + (size_t)(b * DSEQ) * SBW;
    k1p = p.cache_k + (size_t)(b * PAST + PAST) * SBW; v1p = p.cache_v + (size_t)(b * PAST + PAST) * SBW; }
  k0p += h * HD; v0p += h * HD; k1p += h * HD; v1p += h * HD;
  bf16x8 qf[4];
  { const bf16_t* qp = proj4 + (size_t)(qtok0 + i) * P4W + h * HD + 8 * half;
#pragma unroll
    for (int s = 0; s < 4; ++s) qf[s] = *(const bf16x8*)(qp + 16 * s); }
  f32x16 o0 = {}, o1 = {};
  float C = 1.f;
  f32x4 kr[8]; float vr[32];
  bf16x8 kf[4], vf[4];
#define ATTN_CVT() do { _Pragma("unroll") for (int s = 0; s < 4; ++s) kf[s] = cvt8(kr[2 * s], kr[2 * s + 1]); \
    _Pragma("unroll") for (int q = 0; q < 4; ++q) { u32x4 v = {pk2(vr[8 * q], vr[8 * q + 1]), pk2(vr[8 * q + 2], vr[8 * q + 3]), pk2(vr[8 * q + 4], vr[8 * q + 5]), pk2(vr[8 * q + 6], vr[8 * q + 7])}; \
      vf[q] = __builtin_bit_cast(bf16x8, v); } } while (0)
  attn_load(k0p, v0p, i, half, kr, vr);
  ATTN_CVT();
  for (int it = 0; it < nblk; ++it) {
    { const int itn = (it + 1 < nblk) ? it + 1 : it;
      attn_load(k1p - (size_t)itn * 32 * SBW, v1p - (size_t)itn * 32 * SBW, i, half, kr, vr); }
    __builtin_amdgcn_sched_barrier(0);
    f32x16 sacc = {};
#pragma unroll
    for (int s = 0; s < 4; ++s) sacc = MFMA32(kf[s], qf[s], sacc);
    float a[16];
    if (it == 0) attn_weights<true>(sacc, i, half, C, a); else attn_weights<false>(sacc, i, half, C, a);
#pragma unroll
    for (int s = 0; s < 2; ++s) {
      u32x4 pu = {pk2(a[8 * s], a[8 * s + 1]), pk2(a[8 * s + 2], a[8 * s + 3]), pk2(a[8 * s + 4], a[8 * s + 5]), pk2(a[8 * s + 6], a[8 * s + 7])};
      const bf16x8 pf = __builtin_bit_cast(bf16x8, pu);
      o0 = MFMA32(vf[2 * s], pf, o0);
      o1 = MFMA32(vf[2 * s + 1], pf, o1); }
    if (__all(C == 0.f)) break;
    __builtin_amdgcn_sched_barrier(0);
    ATTN_CVT();
  }
  bf16_t* op = attn + (size_t)(qtok0 + i) * SBW + h * HD + 4 * half;
#pragma unroll
  for (int g = 0; g < 4; ++g) {
    f32x4 a0 = {o0[4 * g], o0[4 * g + 1], o0[4 * g + 2], o0[4 * g + 3]}; st_bf16x4(op + 8 * g, a0);
    f32x4 a1 = {o1[4 * g], o1[4 * g + 1], o1[4 * g + 2], o1[4 * g + 3]}; st_bf16x4(op + 32 + 8 * g, a1); }
}

DI void conv_range(const Params& p, const int idx_begin, const int idx_end, const int start, const int stride) {
  const bf16_t* proj4 = (const bf16_t*)(p.ws + W_RC);
  bf16_t* convg = (bf16_t*)(p.ws + W_RB) + (size_t)M * SBW;
  for (int idx = idx_begin + start; idx < idx_end; idx += stride) {
    const int tok0 = (idx >> 6) * 8, c0 = (idx & 63) * 8;
    int b, t0, T; const float* buf; float* nb;
    if (tok0 < MP) { b = tok0 >> 13; t0 = tok0 & (SEQ - 1); T = SEQ; buf = nullptr; nb = p.out + O_CP + (size_t)b * 2 * CW; }
    else { const int s = tok0 - MP; b = s >> 5; t0 = s & (DSEQ - 1); T = DSEQ; buf = p.cache_conv + (size_t)b * 2 * CW; nb = p.out + O_CS + (size_t)b * 2 * CW; }
    const bf16_t* row = proj4 + (size_t)tok0 * P4W + c0;
    u32x4 ur[10], cr[8];
#pragma unroll
    for (int j = 0; j < 8; ++j) { ur[j + 2] = *(const u32x4*)(row + (size_t)j * P4W + 1024); cr[j] = *(const u32x4*)(row + (size_t)j * P4W + 512); }
    float w0[8], w1[8], w2[8];
#pragma unroll
    for (int e = 0; e < 8; ++e) { w0[e] = p.conv_w[c0 + e]; w1[e] = p.conv_w[CW + c0 + e]; w2[e] = p.conv_w[2 * CW + c0 + e]; }
    float um2[8], um1[8];
    if (t0 > 0) { const u32x4 x2 = *(const u32x4*)(row - 2 * (size_t)P4W + 1024), x1 = *(const u32x4*)(row - (size_t)P4W + 1024);
#pragma unroll
      for (int e = 0; e < 4; ++e) { um2[2 * e] = bflo(x2[e]); um2[2 * e + 1] = bfhi(x2[e]); um1[2 * e] = bflo(x1[e]); um1[2 * e + 1] = bfhi(x1[e]); } }
    else {
#pragma unroll
      for (int e = 0; e < 8; ++e) { um2[e] = buf ? buf[c0 + e] : 0.f; um1[e] = buf ? buf[CW + c0 + e] : 0.f; } }
#pragma unroll
    for (int j = 0; j < 8; ++j) {
      float u0[8], cbv[8], o[8];
#pragma unroll
      for (int e = 0; e < 4; ++e) { u0[2 * e] = bflo(ur[j + 2][e]); u0[2 * e + 1] = bfhi(ur[j + 2][e]); cbv[2 * e] = bflo(cr[j][e]); cbv[2 * e + 1] = bfhi(cr[j][e]); }
#pragma unroll
      for (int e = 0; e < 8; ++e) o[e] = cbv[e] * (w0[e] * um2[e] + w1[e] * um1[e] + w2[e] * u0[e]);
      u32x4 ov = {pk2(o[0], o[1]), pk2(o[2], o[3]), pk2(o[4], o[5]), pk2(o[6], o[7])};
      *(u32x4*)(convg + (size_t)(tok0 + j) * CW + c0) = ov;
      if (t0 + j >= T - 2) { float* d = nb + (size_t)(t0 + j - (T - 2)) * CW + c0;
#pragma unroll
        for (int e = 0; e < 8; ++e) d[e] = u0[e]; }
#pragma unroll
      for (int e = 0; e < 8; ++e) { um2[e] = um1[e]; um1[e] = u0[e]; }
    }
  }
}

#define XB_TMO      128
#define XB_XCNT(j)  (256  + 64 * (j))
#define XB_XSUB(j)  (1280 + 64 * (j))
#define XB_XGEN(j)  (2304 + 64 * (j))
#define XB_TOP      3328
#define XB_TOPGEN   3392
#define XCD_BAR_WORDS 3456
#define XB_SPIN_CAP (1u << 18)
#define LAS __attribute__((address_space(3)))
DI unsigned xb_ld(unsigned* p) { return __hip_atomic_load(p, __ATOMIC_RELAXED, __HIP_MEMORY_SCOPE_AGENT); }
DI unsigned xb_add(unsigned* p, unsigned v) { return __hip_atomic_fetch_add(p, v, __ATOMIC_RELAXED, __HIP_MEMORY_SCOPE_AGENT); }
DI unsigned xb_xcc_id() { return (unsigned)__builtin_amdgcn_s_getreg((3 << 11) | 20) & 0xFu; }
#define XB_SPIN(cond, bar) do { unsigned _sp = 0; while (cond) { __builtin_amdgcn_s_sleep(1); \
    if ((++_sp & 255u) == 0u) { if (xb_ld(&(bar)[XB_TMO])) break; if (_sp > XB_SPIN_CAP) { atomicAdd(&(bar)[XB_TMO], 1u); break; } } } } while (0)
struct XcdBarrier { unsigned* bar; unsigned x; volatile LAS unsigned* st; };
DI XcdBarrier xcd_barrier_post(unsigned* bar, volatile LAS unsigned* st) {
  XcdBarrier b; b.bar = bar; b.x = xb_xcc_id(); b.st = st;
  if (threadIdx.x == 0) (void)xb_add(&bar[XB_XCNT(b.x)], 1u);
  return b;
}
DI void xcd_barrier_complete(unsigned* bar, unsigned x, unsigned& nloc, unsigned& nx) {
  const unsigned G = gridDim.x * gridDim.y * gridDim.z;
  unsigned sum, cnt, mine, sp = 0u;
  for (;;) {
    sum = 0u; cnt = 0u; mine = 0u;
#pragma unroll
    for (unsigned j = 0; j < 16; ++j) { const unsigned c = xb_ld(&bar[XB_XCNT(j)]); sum += c; cnt += (c > 0u) ? 1u : 0u; mine = (j == x) ? c : mine; }
    if (sum == G) break;
    __builtin_amdgcn_s_sleep(1);
    if ((++sp & 255u) == 0u) { if (xb_ld(&bar[XB_TMO])) break; if (sp > XB_SPIN_CAP) { atomicAdd(&bar[XB_TMO], 1u); break; } }
  }
  nloc = mine > 0u ? mine : 1u; nx = cnt > 0u ? cnt : 1u;
}
DI void xcd_barrier(const XcdBarrier& b) {
  asm volatile("s_waitcnt vmcnt(0)" ::: "memory");
  __syncthreads();
  if (threadIdx.x == 0) {
    unsigned* bar = b.bar;
    __builtin_amdgcn_s_waitcnt(0);
    unsigned nloc = b.st[0], nx = b.st[1];
    if (nloc == 0u) { xcd_barrier_complete(bar, b.x, nloc, nx); b.st[0] = nloc; b.st[1] = nx; }
    const unsigned old = xb_add(&bar[XB_XSUB(b.x)], 1u);
    const unsigned gen = old / nloc;
    if (old + 1u == (gen + 1u) * nloc) {
      __builtin_amdgcn_fence(__ATOMIC_RELEASE, "agent");
      asm volatile("s_waitcnt vmcnt(0)" ::: "memory");
      const unsigned og = xb_add(&bar[XB_TOP], 1u);
      const unsigned tg = og / nx;
      if (og + 1u == (tg + 1u) * nx) xb_add(&bar[XB_TOPGEN], 1u);
      else XB_SPIN(xb_ld(&bar[XB_TOPGEN]) == tg, bar);
      __builtin_amdgcn_fence(__ATOMIC_ACQUIRE, "agent");
      xb_add(&bar[XB_XGEN(b.x)], 1u);
      asm volatile("s_waitcnt vmcnt(0)" ::: "memory");
    } else {
      XB_SPIN(xb_ld(&bar[XB_XGEN(b.x)]) == gen, bar);
      __builtin_amdgcn_fence(__ATOMIC_ACQUIRE, "agent");
      asm volatile("s_waitcnt vmcnt(0)" ::: "memory");
    }
  }
  __syncthreads();
}

struct SchedPe {
  const bf16_t* pb; const bf16_t* wPlT; int q, nidle; EpiPe e;
  DI bool next(int i, Item& it) const { const int t = q + i * nidle; if (q < 0 || t >= (M / BM) * (D / BM)) return false;
    it.brow = (t >> 2) * BM; it.bcol = (t & 3) * BM; it.cA = (const char*)(pb + (size_t)it.brow * PLE); it.cB = (const char*)(wPlT + (size_t)it.bcol * PLE); it.nt = PLE / BK; it.tag = 0; return true; }
  DI bool epi(acc_t& acc, const Item& it) const { epi_call(acc, it.brow, it.bcol, e); return false; }
};
struct SchedP3 {
  const bf16_t *attn, *convg, *wAoT, *wCoT; const bf16_t* proj4; bf16_t* merged;
  int nM, fixed_pm, fixed_pn;
  DI bool next(int i, Item& it) const { int pm, pn;
    if (fixed_pm >= 0) { if (i >= 2) return false; pm = fixed_pm; pn = fixed_pn; }
    else if (!tile_order(i >> 1, gridDim.x, blockIdx.x, nM, D / BM, pm, pn)) return false;
    it.brow = pm * BM; it.bcol = pn * BM; it.tag = i & 1; it.nt = SBW / BK;
    it.cA = (const char*)(((i & 1) ? convg : attn) + (size_t)it.brow * SBW); it.cB = (const char*)(((i & 1) ? wCoT : wAoT) + (size_t)it.bcol * SBW); return true; }
  DI bool epi(acc_t& acc, const Item& it) const {
    if (it.tag == 0) { const EpiGate<false> e{proj4, 2048, nullptr}; epi_call(acc, it.brow, it.bcol, e); return true; }
    const EpiGate<true> e{proj4, 3072, merged}; epi_call(acc, it.brow, it.bcol, e); return false; }
};
DI unsigned xb_ld(unsigned* p); DI unsigned xb_add(unsigned* p, unsigned v);
template <class Epi>
struct SchedOne {
  const bf16_t* A; const bf16_t* Bt; int K, brow, bcol; Epi e;
  DI bool next(int i, Item& it) const { if (i != 0) return false; it.brow = brow; it.bcol = bcol; it.nt = K / BK; it.tag = 0;
    it.cA = (const char*)(A + (size_t)brow * K); it.cB = (const char*)(Bt + (size_t)bcol * K); return true; }
  DI bool epi(acc_t& acc, const Item& it) const { epi_call(acc, it.brow, it.bcol, e); return false; }
};
DI void team_barrier(unsigned* ctr, const unsigned target) {
  asm volatile("s_waitcnt vmcnt(0)" ::: "memory");
  __syncthreads();
  if (threadIdx.x == 0) {
    __builtin_amdgcn_fence(__ATOMIC_RELEASE, "agent");
    asm volatile("s_waitcnt vmcnt(0)" ::: "memory");
    (void)xb_add(ctr, 1u);
    unsigned sp = 0u; while (xb_ld(ctr) < target) { __builtin_amdgcn_s_sleep(1); if (++sp > (1u << 22)) break; }
    __builtin_amdgcn_fence(__ATOMIC_ACQUIRE, "agent");
    asm volatile("s_waitcnt vmcnt(0)" ::: "memory");
  }
  __syncthreads();
}
struct SchedP6 {
  const bf16_t *u, *wDnT; float* part; EpiRes<1> e;
  DI bool next(int i, Item& it) const { const int G = gridDim.x, c = blockIdx.x; int pm, pn;
    if (tile_order(i, G, c, MP / BM, D / BM, pm, pn)) { it.brow = pm * BM; it.bcol = pn * BM; it.nt = DFF / BK; it.tag = 0;
      it.cA = (const char*)(u + (size_t)it.brow * DFF); it.cB = (const char*)(wDnT + (size_t)it.bcol * DFF); return true; }
    const int ntl = (MP / BM) * (D / BM), nmine = (c < ntl) ? (ntl - c + G - 1) / G : 0, j = c + (i - nmine) * G;
    if (j >= (MS / BM) * (D / BM) * 4) return false;
    const int kq = j & 3; it.brow = (j >> 4) * BM; it.bcol = ((j >> 2) & 3) * BM; it.nt = DFF / 4 / BK; it.tag = 1 + kq;
    it.cA = (const char*)(u + (size_t)(MP + it.brow) * DFF + kq * (DFF / 4)); it.cB = (const char*)(wDnT + (size_t)it.bcol * DFF + kq * (DFF / 4)); return true; }
  DI bool epi(acc_t& acc, const Item& it) const {
    if (it.tag == 0) { epi_call(acc, it.brow, it.bcol, e); return false; }
    const EpiPartial ep{part + (size_t)(it.tag - 1) * MS * D}; epi_call(acc, it.brow, it.bcol, ep); return false; }
};

struct SchedP7 {
  const bf16_t *x2b, *wPgT; float* part; EpiRes<2> e;
  DI bool next(int i, Item& it) const { const int G = gridDim.x, c = blockIdx.x; int pm, pn;
    if (tile_order(i, G, c, MP / BM, D / BM, pm, pn)) { it.brow = pm * BM; it.bcol = pn * BM; it.nt = D / BK; it.tag = 0;
      it.cA = (const char*)(x2b + (size_t)it.brow * D); it.cB = (const char*)(wPgT + (size_t)it.bcol * D); return true; }
    const int ntl = (MP / BM) * (D / BM), nmine = (c < ntl) ? (ntl - c + G - 1) / G : 0, j = c + (i - nmine) * G;
    if (j >= (MS / BM) * (D / BM) * 4) return false;
    const int kq = j & 3; it.brow = (j >> 4) * BM; it.bcol = ((j >> 2) & 3) * BM; it.nt = D / 4 / BK; it.tag = 1 + kq;
    it.cA = (const char*)(x2b + (size_t)(MP + it.brow) * D + kq * (D / 4)); it.cB = (const char*)(wPgT + (size_t)it.bcol * D + kq * (D / 4)); return true; }
  DI bool epi(acc_t& acc, const Item& it) const {
    if (it.tag == 0) { epi_call(acc, it.brow, it.bcol, e); return false; }
    const EpiPartial ep{part + (size_t)(it.tag - 1) * MS * D}; epi_call(acc, it.brow, it.bcol, ep); return false; }
};

__global__ void __launch_bounds__(512, 2) fwd_megakernel(Params p) {
  cg::grid_group grid = cg::this_grid();
  const int NGW = gridDim.x * 8, NT = gridDim.x * blockDim.x;
#define PHASE_IDS int tid_ = threadIdx.x; asm volatile("" : "+v"(tid_)); const int lane = tid_ & 63, wave = tid_ >> 6, gw = blockIdx.x * 8 + wave, gtid = blockIdx.x * 512 + tid_; (void)lane; (void)wave; (void)gw; (void)gtid;
  unsigned char* ws = p.ws;
  bf16_t *wInT = (bf16_t*)(ws + W_IN), *wAoT = (bf16_t*)(ws + W_AO), *wCoT = (bf16_t*)(ws + W_CO), *wOT = (bf16_t*)(ws + W_O),
         *wUpT = (bf16_t*)(ws + W_UP), *wDnT = (bf16_t*)(ws + W_DN), *wPgT = (bf16_t*)(ws + W_PG), *wPlT = (bf16_t*)(ws + W_PL);
  float* rs0 = (float*)(ws + W_RS0); float* ss = (float*)(ws + W_SS);
  bf16_t* PE = (bf16_t*)(ws + W_PE);
  bf16_t *pb = (bf16_t*)(ws + W_PB), *RA = (bf16_t*)(ws + W_RA), *RB = (bf16_t*)(ws + W_RB), *RC = (bf16_t*)(ws + W_RC);
  float* y = p.out + O_Y;
  constexpr int I0 = (D / 64) * (NPROJ / 32), I1 = (SBW / 64) * (D / 32), I2 = I1, I3 = (D / 64) * (D / 32), I4 = (D / 64) * (DFF / 32),
                  I5 = (DFF / 64) * (D / 32), I6 = I3, I7 = (PLE / 64) * (D / 32), NI = I0 + I1 + I2 + I3 + I4 + I5 + I6 + I7;
  __shared__ uint4 xb_words;
  if (threadIdx.x == 0) xb_words = make_uint4(0u, 0u, 0u, 0u);
  __syncthreads();
  const XcdBarrier xb = xcd_barrier_post((unsigned*)(ws + W_BAR), (volatile LAS unsigned*)&xb_words);

  {
    PHASE_IDS
    float* scr = (float*)dyn_lds + wave * (64 * 33);
    for (int it = gw; it < I0 + I1 + I2 + I7 + I3; it += NGW) {
      int r = it;
      if (r < I0) { transpose_item<true>(p.w_in, p.g_mix, D, NPROJ, wInT, scr, r, lane); continue; } r -= I0;
      if (r < I1) { transpose_item<false>(p.w_ao, nullptr, SBW, D, wAoT, scr, r, lane); continue; } r -= I1;
      if (r < I2) { transpose_item<false>(p.w_co, nullptr, CW, D, wCoT, scr, r, lane); continue; } r -= I2;
      if (r < I7) { transpose_item<false>(p.w_pl, nullptr, PLE, D, wPlT, scr, r, lane); continue; } r -= I7;
      transpose_item<false>(p.w_o, nullptr, D, D, wOT, scr, r, lane);
    }
    for (int row0 = gw * 4; row0 < M; row0 += NGW * 4) {
      f32x4 v[4][4];
#pragma unroll
      for (int q = 0; q < 4; ++q) { const int row = row0 + q;
        const float* xr = (row < MP) ? p.x_p + (size_t)row * D : p.x_s + (size_t)(row - MP) * D;
        const f32x4* x4 = (const f32x4*)xr + lane;
#pragma unroll
        for (int j = 0; j < 4; ++j) v[q][j] = x4[64 * j]; }
#pragma unroll
      for (int q = 0; q < 4; ++q) { const int row = row0 + q; float sq = 0.f;
#pragma unroll
        for (int j = 0; j < 4; ++j) sq += (v[q][j].x * v[q][j].x + v[q][j].y * v[q][j].y) + (v[q][j].z * v[q][j].z + v[q][j].w * v[q][j].w);
        sq = wave_sum(sq);
        if (lane == 0) rs0[row] = rsqrtf(sq * (1.f / D) + EPS);
        u32x2* o8 = (u32x2*)(RA + (size_t)row * D) + lane;
#pragma unroll
        for (int j = 0; j < 4; ++j) { u32x2 o = {pk2(v[q][j].x, v[q][j].y), pk2(v[q][j].z, v[q][j].w)}; o8[64 * j] = o; } }
    }
    for (int idx0 = gtid; idx0 < M * PLE / 4; idx0 += NT * 4) {
      f32x4 v[4];
#pragma unroll
      for (int q = 0; q < 4; ++q) { const int idx = idx0 + q * NT; if (idx < M * PLE / 4) { const size_t e = (size_t)idx * 4;
          v[q] = *(const f32x4*)((e < (size_t)MP * PLE) ? p.p_p + e : p.p_s + (e - (size_t)MP * PLE)); } }
#pragma unroll
      for (int q = 0; q < 4; ++q) { const int idx = idx0 + q * NT; if (idx < M * PLE / 4) st_bf16x4(pb + (size_t)idx * 4, v[q]); }
    }
    for (int idx = gtid; idx < 3 * M; idx += NT) ss[idx] = 0.f;
  }
  if (p.ws == nullptr) grid.sync();
  xcd_barrier(xb);
  { EpiIn e{rs0, RC, p.out}; gemm_phase(RA, wInT, M, NPROJ, D, e); }
  { const int G = gridDim.x, ntl = (M / BM) * (NPROJ / BM), rem = ntl % G, c = blockIdx.x;
    const int nidle = (rem == 0) ? G : G - rem, q = (rem == 0) ? c : c - rem;
    const SchedPe sp{pb, wPlT, q, nidle, EpiPe{PE}}; gemm_stream(PLE, sp); }
  xcd_barrier(xb);
  const bool team = (gridDim.x == 256);
  bf16_t* x1b_sv = team ? (bf16_t*)y - (size_t)MP * D : RB;
  { PHASE_IDS
    constexpr int NU = (MP / 32 / 8) * NH;
    constexpr int CI_P = (MP / 8) * (CW / 8), CI_ALL = (M / 8) * (CW / 8);
    if (!team) {
      const int upb = (NU + gridDim.x - 1) / gridDim.x;
      for (int j = 0; j < upb; ++j) { const int u = blockIdx.x * upb + j; if (u >= NU) break;
        const int bh = u >> 5, g = u & 31; attn_task(p, (bh >> 3) * (SEQ / 32) + g * 8 + wave, bh & 7, lane); }
      for (int sb = 0; sb < MS / DSEQ; ++sb) if (sb % gridDim.x == blockIdx.x) attn_task(p, MP / 32 + sb, wave, lane);
      conv_range(p, 0, CI_ALL, gtid, NT);
    } else if (blockIdx.x >= 32) {
      const int cb = blockIdx.x - 32;
      const int u0 = cb * 4 + (cb < 128 ? cb : 128), nu = 4 + (cb < 128 ? 1 : 0);
      for (int j = 0; j < nu; ++j) { const int u = u0 + j; const int bh = u >> 5, g = u & 31; attn_task(p, (bh >> 3) * (SEQ / 32) + g * 8 + wave, bh & 7, lane); }
      if (cb >= 128) conv_range(p, 0, CI_P, (cb - 128) * 512 + tid_, 96 * 512);
    } else {
      unsigned* tctr = (unsigned*)(ws + W_BAR);
      const int c = blockIdx.x;
      attn_task(p, MP / 32 + c, wave, lane);
      if (c < 16) conv_range(p, CI_P, CI_ALL, c * 512 + tid_, 16 * 512);
      team_barrier(tctr, 32u);
      if (c < 16) {
        const int pm = MP / BM + (c >> 2), pn = c & 3;
        { const SchedP3 s3{RB, RB + (size_t)M * SBW, wAoT, wCoT, RC, RA, 0, pm, pn}; gemm_stream(SBW, s3); }
        team_barrier(tctr + 64, 16u);
        { const SchedOne<EpiRes<0>> s4{RA, wOT, D, pm * BM, pn * BM, EpiRes<0>{p.x_p, p.x_s, nullptr, x1b_sv, ss, nullptr, nullptr}}; gemm_stream(D, s4); }
      } else {
        PHASE_IDS
        float* scr = (float*)dyn_lds + wave * (64 * 33);
        for (int it = (c - 16) * 8 + wave; it < I4; it += 16 * 8) transpose_item<false>(p.w_up, p.g_ffn, D, DFF, wUpT, scr, it, lane);
      }
    }
  }
  xcd_barrier(xb);
  {
    const int nM = team ? MP / BM : M / BM, nN = D / BM;
    { const SchedP3 s3{RB, RB + (size_t)M * SBW, wAoT, wCoT, RC, RA, nM, -1, 0}; gemm_stream(SBW, s3); }
    if (!team) { const int G = gridDim.x, rem = (nM * nN) % G, c = blockIdx.x; const int nidle = (rem == 0) ? G : G - rem, q = (rem == 0) ? c : c - rem;
      if (q >= 0) { PHASE_IDS
        float* scr = (float*)dyn_lds + wave * (64 * 33);
        for (int it = q * 8 + wave; it < I4; it += nidle * 8) transpose_item<false>(p.w_up, p.g_ffn, D, DFF, wUpT, scr, it, lane); } }
  }
  xcd_barrier(xb);
  { EpiRes<0> e{p.x_p, p.x_s, nullptr, RB, ss, nullptr, nullptr}; gemm_phase(RA, wOT, team ? MP : M, D, D, e); }
  xcd_barrier(xb);
  { EpiUp e{ss, RC}; gemm_phase(RB, wUpT, M, DFF, D, e, x1b_sv, MP); }
  { const int G = gridDim.x, rem = ((M / BM) * (DFF / BM)) % G, c = blockIdx.x; const int nidle = (rem == 0) ? G : G - rem, q = (rem == 0) ? c : c - rem;
    if (q >= 0) { PHASE_IDS
      float* scr = (float*)dyn_lds + wave * (64 * 33);
      for (int it = q * 8 + wave; it < I5 + I6; it += nidle * 8) {
        if (it < I5) transpose_item<false>(p.w_dn, nullptr, DFF, D, wDnT, scr, it, lane);
        else transpose_item<false>(p.w_pg, p.g_ple, D, D, wPgT, scr, it - I5, lane); } } }
  xcd_barrier(xb);
  { const SchedP6 s6{RC, wDnT, (float*)(ws + W_PB), EpiRes<1>{nullptr, nullptr, RB, RA, ss + M, nullptr, nullptr}}; gemm_stream(DFF, s6); }
  xcd_barrier(xb);
  { PHASE_IDS
    const float* part = (const float*)(ws + W_PB);
    for (int r = gw; r < MS; r += NGW) { const int row = MP + r; float sq = 0.f;
#pragma unroll
      for (int j = 0; j < 4; ++j) { const int col = j * 256 + lane * 4;
        f32x4 v = ld_bf16x4(x1b_sv + (size_t)row * D + col);
#pragma unroll
        for (int kq = 0; kq < 4; ++kq) v += *(const f32x4*)(part + ((size_t)kq * MS + r) * D + col);
        st_bf16x4(RA + (size_t)row * D + col, v); sq += (v.x * v.x + v.y * v.y) + (v.z * v.z + v.w * v.w); }
      sq = wave_sum(sq);
      if (lane == 0) ss[M + row] = sq; } }
  xcd_barrier(xb);
  { const SchedP7 s7{RA, wPgT, (float*)(ws + W_PB), EpiRes<2>{nullptr, nullptr, RA, RC, ss + 2 * M, ss + M, PE}}; gemm_stream(D, s7); }
  xcd_barrier(xb);
  { PHASE_IDS
  for (int idx0 = gtid; idx0 < MP * (D / 8); idx0 += NT * 4) {
    u32x4 xv[4]; float rv[4];
#pragma unroll
    for (int q = 0; q < 4; ++q) { const int idx = idx0 + q * NT; if (idx < MP * (D / 8)) { const int row = idx >> 7, c = (idx & 127) * 8;
        xv[q] = *(const u32x4*)(RC + (size_t)row * D + c); rv[q] = ss[2 * M + row]; } }
#pragma unroll
    for (int q = 0; q < 4; ++q) { const int idx = idx0 + q * NT; if (idx < MP * (D / 8)) { const int row = idx >> 7, c = (idx & 127) * 8;
        const float r = rsqrtf(rv[q] * (1.f / D) + EPS); f32x4 a0, a1; unpack8(xv[q], a0, a1);
        const f32x4 g0 = *(const f32x4*)(p.g_final + c), g1 = *(const f32x4*)(p.g_final + c + 4);
        *(f32x4*)(y + (size_t)row * D + c) = a0 * r * g0; *(f32x4*)(y + (size_t)row * D + c + 4) = a1 * r * g1; } }
  }
  { const float* part = (const float*)(ws + W_PB);
    for (int r = NGW - 1 - gw; r < MS; r += NGW) { const int row = MP + r; const float r2 = rsqrtf(ss[M + row] * (1.f / D) + EPS);
      f32x4 x3[4]; float sq = 0.f;
#pragma unroll
      for (int j = 0; j < 4; ++j) { const int col = j * 256 + lane * 4;
        f32x4 gsum = *(const f32x4*)(part + (size_t)r * D + col);
#pragma unroll
        for (int kq = 1; kq < 4; ++kq) gsum += *(const f32x4*)(part + ((size_t)kq * MS + r) * D + col);
        const f32x4 x2 = ld_bf16x4(RA + (size_t)row * D + col), pe4 = ld_bf16x4(PE + (size_t)row * D + col);
        gsum = gsum * r2;
        const f32x4 sg = {sigmoidf_(gsum.x), sigmoidf_(gsum.y), sigmoidf_(gsum.z), sigmoidf_(gsum.w)};
        x3[j] = x2 + sg * pe4; sq += (x3[j].x * x3[j].x + x3[j].y * x3[j].y) + (x3[j].z * x3[j].z + x3[j].w * x3[j].w); }
      sq = wave_sum(sq); const float r3 = rsqrtf(sq * (1.f / D) + EPS);
#pragma unroll
      for (int j = 0; j < 4; ++j) { const int col = j * 256 + lane * 4; const f32x4 g = *(const f32x4*)(p.g_final + col);
        *(f32x4*)(y + (size_t)row * D + col) = x3[j] * r3 * g; } } }
  }
}

extern "C" void kernel_launch(void* const* d_in, const int* in_sizes, int n_in, void* d_out, int out_size, void* d_ws, size_t ws_size, hipStream_t stream) {
  static int grid_blocks = 0;
  if (grid_blocks == 0) {
    if (ws_size < W_END) { fprintf(stderr, "kernel_launch: workspace too small (%zu < %zu)\n", ws_size, (size_t)W_END); grid_blocks = -1; return; }
    int dev = 0, cus = 0, per_cu = 0;
    hipGetDevice(&dev);
    hipDeviceGetAttribute(&cus, hipDeviceAttributeMultiprocessorCount, dev);
    hipFuncSetAttribute((const void*)fwd_megakernel, hipFuncAttributeMaxDynamicSharedMemorySize, SHM_B);
    hipOccupancyMaxActiveBlocksPerMultiprocessor(&per_cu, (const void*)fwd_megakernel, 512, SHM_B);
    if (per_cu < 1) { fprintf(stderr, "kernel_launch: occupancy query says %d blocks/CU\n", per_cu); per_cu = 1; }
    grid_blocks = cus;
  }
  if (grid_blocks < 0) return;
  Params p{};
  p.x_p = (const float*)d_in[0]; p.x_s = (const float*)d_in[1]; p.p_p = (const float*)d_in[2]; p.p_s = (const float*)d_in[3];
  p.cache_k = (const float*)d_in[4]; p.cache_v = (const float*)d_in[5]; p.cache_conv = (const float*)d_in[6];
  p.g_mix = (const float*)d_in[7]; p.w_in = (const float*)d_in[8]; p.conv_w = (const float*)d_in[9]; p.w_ao = (const float*)d_in[10];
  p.w_co = (const float*)d_in[11]; p.w_o = (const float*)d_in[12]; p.g_ffn = (const float*)d_in[13]; p.w_up = (const float*)d_in[14];
  p.w_dn = (const float*)d_in[15]; p.g_ple = (const float*)d_in[16]; p.w_pg = (const float*)d_in[17]; p.w_pl = (const float*)d_in[18];
  p.g_final = (const float*)d_in[19];
  p.out = (float*)d_out; p.ws = (unsigned char*)d_ws;
  (void)hipMemsetAsync((unsigned char*)d_ws + W_BAR, 0, XCD_BAR_WORDS * 4, stream);
  void* args[] = {&p};
  hipError_t e = hipLaunchCooperativeKernel((const void*)fwd_megakernel, dim3(grid_blocks), dim3(512), args, SHM_B, stream);
  if (e != hipSuccess) fprintf(stderr, "cooperative launch failed: %s (grid %d)\n", hipGetErrorString(e), grid_blocks);
}
```
